# Optimizing an MI355X kernel written in HIP

```python
import math
import jax
import jax.numpy as jnp
from jax import lax
import numpy as np

D_MODEL = 1024
BATCH = 8
SEQ = 4096
DEPTH = 4

HEAD_DIM = 64
ROPE_THETA = 10000.0
NORM_EPS = 1e-6
QBLK = 128

A_HEADS = 8
A_KV_HEADS = 2
A_GROUP = A_HEADS // A_KV_HEADS
A_WIDTH = A_HEADS * HEAD_DIM
NSA_BRANCHES = 3
CMP_LEN = 32
CMP_STRIDE = 16
CMP_HIDDEN = 2 * HEAD_DIM
SEL_LEN = 64
SEL_TOPK = 16
A_WINDOW = 512
FORCED_SCORE = 1e4

B_HEADS = 8
B_KV_HEADS = 1
B_GROUP = B_HEADS // B_KV_HEADS
B_WIDTH = B_HEADS * HEAD_DIM
B_WINDOW = 128

C_WIDTH = 512
C_GROUP_CH = 16
C_GROUPS = C_WIDTH // C_GROUP_CH
C_STATE = 64
DT_MIN = 1e-3
DT_MAX = 1e-1

D_FF = 4 * D_MODEL
N_BRANCH = 3

IN_WIDTHS = (A_WIDTH, NSA_BRANCHES * 2 * A_KV_HEADS * HEAD_DIM, NSA_BRANCHES * A_HEADS, B_WIDTH, 2 * B_KV_HEADS * HEAD_DIM, C_WIDTH, N_BRANCH * D_MODEL)
IN_COLS = sum(IN_WIDTHS)

kernel_name = 'hybrid_nsa_swa_s5_block'


def rmsnorm(x, gain):
    xf = x.astype(jnp.float32)
    y = xf * lax.rsqrt(jnp.mean(xf * xf, axis=-1, keepdims=True) + NORM_EPS)
    return (y * gain.astype(jnp.float32)).astype(x.dtype)


def rope(x, positions):
    half = x.shape[-1] // 2
    inv_freq = ROPE_THETA ** (-jnp.arange(half, dtype=jnp.float32) / half)
    ang = positions.astype(jnp.float32)[..., None] * inv_freq
    cos = jnp.cos(ang)[:, :, None, :]
    sin = jnp.sin(ang)[:, :, None, :]
    xf = x.astype(jnp.float32)
    x1, x2 = xf[..., :half], xf[..., half:]
    return jnp.concatenate([x1 * cos - x2 * sin, x2 * cos + x1 * sin], axis=-1).astype(x.dtype)


def masked_softmax(s, mask, axis=-1):
    s = jnp.where(mask, s.astype(jnp.float32), -jnp.inf)
    m = jnp.max(s, axis=axis, keepdims=True)
    m = jnp.where(jnp.isfinite(m), m, 0.0)
    e = jnp.exp(s - m)
    return e / jnp.maximum(jnp.sum(e, axis=axis, keepdims=True), 1e-30)


def banded_attention(q, k, v, window, sinks=None):
    bsz, seq, hkv, grp, dh = q.shape
    nblk = seq // QBLK
    pad = -(-window // QBLK) * QBLK
    span = pad + QBLK
    kp = jnp.pad(k, ((0, 0), (pad, 0), (0, 0), (0, 0)))
    vp = jnp.pad(v, ((0, 0), (pad, 0), (0, 0), (0, 0)))
    qb = jnp.moveaxis(q.reshape(bsz, nblk, QBLK, hkv, grp, dh), 1, 0)
    scale = dh ** -0.5

    def one_block(args):
        i, qi = args
        start = i * QBLK
        ki = lax.dynamic_slice_in_dim(kp, start, span, axis=1)
        vi = lax.dynamic_slice_in_dim(vp, start, span, axis=1)
        s = jnp.einsum('bqhgd,bkhd->bhgqk', qi, ki).astype(jnp.float32) * scale
        qpos = start + jnp.arange(QBLK)
        kpos = start - pad + jnp.arange(span)
        diff = qpos[:, None] - kpos[None, :]
        mask = (diff >= 0) & (diff < window) & (kpos[None, :] >= 0)
        s = jnp.where(mask, s, -jnp.inf)
        m = jnp.max(s, axis=-1, keepdims=True)
        if sinks is not None:
            sk = sinks.astype(jnp.float32).reshape(hkv, grp)[None, :, :, None, None]
            m = jnp.maximum(m, sk)
            e = jnp.exp(s - m)
            den = jnp.sum(e, axis=-1, keepdims=True) + jnp.exp(sk - m)
        else:
            e = jnp.exp(s - m)
            den = jnp.sum(e, axis=-1, keepdims=True)
        p = (e / den).astype(vi.dtype)
        return jnp.einsum('bhgqk,bkhd->bqhgd', p, vi)

    out = lax.map(one_block, (jnp.arange(nblk), qb))
    return jnp.moveaxis(out, 0, 1).reshape(bsz, seq, hkv, grp, dh)


def nsa_attention(q, k, v, gates, cmp_pos, cmp_w1, cmp_w2):
    bsz, seq, hkv, grp, dh = q.shape
    n_cmp = (seq - CMP_LEN) // CMP_STRIDE + 1
    n_sel = seq // SEL_LEN
    n_top = min(SEL_TOPK, n_sel)
    nblk = seq // QBLK
    scale = dh ** -0.5

    tok = jnp.arange(n_cmp)[:, None] * CMP_STRIDE + jnp.arange(CMP_LEN)[None, :]

    def compress(xb, j):
        blocks = xb[:, tok] + cmp_pos[j][None, None, :, None, :]
        blocks = jnp.moveaxis(blocks, 3, 2).reshape(bsz, n_cmp, hkv, CMP_LEN * dh)
        return jax.nn.gelu(blocks @ cmp_w1[j]) @ cmp_w2[j]

    kc = compress(k[:, :, 0], 0)
    vc = compress(v[:, :, 0], 1)
    cmp_end = jnp.arange(n_cmp) * CMP_STRIDE + CMP_LEN - 1

    c_start = jnp.arange(n_cmp) * CMP_STRIDE
    s_start = jnp.arange(n_sel) * SEL_LEN
    overlap = jnp.minimum(c_start[:, None] + CMP_LEN, s_start[None, :] + SEL_LEN) - jnp.maximum(c_start[:, None], s_start[None, :])
    cmp_to_sel = jnp.clip(overlap, 0, None).astype(jnp.float32) / CMP_LEN

    ks_blk = jnp.moveaxis(k[:, :, 1].reshape(bsz, n_sel, SEL_LEN, hkv, dh), 3, 1)
    vs_blk = jnp.moveaxis(v[:, :, 1].reshape(bsz, n_sel, SEL_LEN, hkv, dh), 3, 1)
    qc = q.reshape(bsz * nblk, QBLK, hkv, grp, dh)
    b_idx = jnp.repeat(jnp.arange(bsz), nblk)
    blk_idx = jnp.tile(jnp.arange(nblk), bsz)
    head_idx = jnp.arange(hkv)[None, :, None]
    sel_ids = jnp.arange(n_sel)

    def one_block(args):
        b, i, qi = args
        qpos = i * QBLK + jnp.arange(QBLK)
        s = jnp.einsum('qhgd,nhd->qhgn', qi, kc[b]).astype(jnp.float32) * scale
        p_c = masked_softmax(s, (cmp_end[None, :] <= qpos[:, None])[:, None, None, :])
        o_c = jnp.einsum('qhgn,nhd->qhgd', p_c.astype(qi.dtype), vc[b])
        imp = jnp.einsum('qhgn,nj->qhj', p_c, cmp_to_sel)
        cur = qpos // SEL_LEN
        valid = sel_ids[None, :] <= cur[:, None]
        forced = (sel_ids[None, :] == 0) | (sel_ids[None, :] == cur[:, None]) | (sel_ids[None, :] == cur[:, None] - 1)
        score = jnp.where(forced[:, None, :], FORCED_SCORE, imp)
        score = jnp.where(valid[:, None, :], score, -jnp.inf)
        _, top = lax.top_k(score, n_top)
        kg = ks_blk[b][head_idx, top]
        vg = vs_blk[b][head_idx, top]
        s = jnp.einsum('qhgd,qhnkd->qhgnk', qi, kg).astype(jnp.float32) * scale
        kpos = top[..., None] * SEL_LEN + jnp.arange(SEL_LEN)
        mask = (kpos <= qpos[:, None, None, None])[:, :, None]
        p_s = masked_softmax(s, mask, axis=(-2, -1))
        o_s = jnp.einsum('qhgnk,qhnkd->qhgd', p_s.astype(qi.dtype), vg)
        return o_c, o_s

    o_c, o_s = lax.map(one_block, (b_idx, blk_idx, qc))
    o_c = o_c.reshape(bsz, seq, hkv, grp, dh)
    o_s = o_s.reshape(bsz, seq, hkv, grp, dh)
    o_w = banded_attention(q, k[:, :, 2], v[:, :, 2], A_WINDOW)
    out = gates[:, :, 0][..., None] * o_c + gates[:, :, 1][..., None] * o_s + gates[:, :, 2][..., None] * o_w
    return out.reshape(bsz, seq, hkv * grp * dh)


def s5_layer(u, a_re, a_im, log_dt, b_re, b_im, c_re, c_im, d, glu_w, glu_b):
    bsz, seq, _ = u.shape
    uf = u.astype(jnp.float32)
    ug = uf.reshape(bsz, seq, C_GROUPS, C_GROUP_CH)
    dt = jnp.exp(log_dt.astype(jnp.float32))[:, None]
    ar, ai = a_re.astype(jnp.float32), a_im.astype(jnp.float32)
    mag = jnp.exp(dt * ar)
    abar_r, abar_i = mag * jnp.cos(dt * ai), mag * jnp.sin(dt * ai)
    den = ar * ar + ai * ai
    nr, ni = abar_r - 1.0, abar_i
    coef_r = (nr * ar + ni * ai) / den
    coef_i = (ni * ar - nr * ai) / den
    br, bi = b_re.astype(jnp.float32), b_im.astype(jnp.float32)
    bbar_r = coef_r[..., None] * br - coef_i[..., None] * bi
    bbar_i = coef_r[..., None] * bi + coef_i[..., None] * br
    bu_r = jnp.einsum('bsgh,gph->bsgp', ug, bbar_r)
    bu_i = jnp.einsum('bsgh,gph->bsgp', ug, bbar_i)
    el_r = jnp.broadcast_to(abar_r, bu_r.shape)
    el_i = jnp.broadcast_to(abar_i, bu_i.shape)

    def combine(e1, e2):
        a1r, a1i, b1r, b1i = e1
        a2r, a2i, b2r, b2i = e2
        return (a2r * a1r - a2i * a1i, a2r * a1i + a2i * a1r,
                a2r * b1r - a2i * b1i + b2r, a2r * b1i + a2i * b1r + b2i)

    _, _, xr, xi = lax.associative_scan(combine, (el_r, el_i, bu_r, bu_i), axis=1)
    y = jnp.einsum('bsgp,ghp->bsgh', xr, c_re.astype(jnp.float32)) - jnp.einsum('bsgp,ghp->bsgh', xi, c_im.astype(jnp.float32))
    y = y.reshape(bsz, seq, C_WIDTH) + d.astype(jnp.float32) * uf
    z = jax.nn.gelu(y)
    out = z * jax.nn.sigmoid(z @ glu_w.astype(jnp.float32) + glu_b.astype(jnp.float32))
    return out.astype(u.dtype)


def setup_inputs(seed: int = 0) -> dict:
    key = jax.random.key(seed)
    ks = jax.random.split(key, 32)
    f32 = jnp.float32
    L = DEPTH

    def nrm(k, shape, scale):
        return scale * jax.random.normal(k, shape, f32)

    x = jax.random.normal(ks[0], (BATCH, SEQ, D_MODEL), f32)
    offset = jax.random.randint(ks[1], (BATCH, 1), 0, 4096, jnp.int32)
    positions = offset + jnp.arange(SEQ, dtype=jnp.int32)[None, :]
    state_idx = jnp.arange(C_STATE, dtype=f32)
    return {
        'x': x,
        'positions': positions,
        'norm_mix': 1.0 + nrm(ks[2], (L, D_MODEL), 0.02),
        'w_in': nrm(ks[3], (L, D_MODEL, IN_COLS), D_MODEL ** -0.5),
        'nsa_cmp_pos': nrm(ks[4], (L, 2, CMP_LEN, HEAD_DIM), 0.02),
        'nsa_cmp_w1': nrm(ks[5], (L, 2, CMP_LEN * HEAD_DIM, CMP_HIDDEN), (CMP_LEN * HEAD_DIM) ** -0.5),
        'nsa_cmp_w2': nrm(ks[6], (L, 2, CMP_HIDDEN, HEAD_DIM), CMP_HIDDEN ** -0.5),
        'swa_sinks': nrm(ks[7], (L, B_HEADS), 0.5),
        's5_a_re': -0.5 + nrm(ks[8], (L, C_GROUPS, C_STATE), 0.01),
        's5_a_im': math.pi * state_idx + nrm(ks[9], (L, C_GROUPS, C_STATE), 0.01),
        's5_log_dt': jax.random.uniform(ks[10], (L, C_GROUPS), f32, math.log(DT_MIN), math.log(DT_MAX)),
        's5_b_re': nrm(ks[11], (L, C_GROUPS, C_STATE, C_GROUP_CH), (2 * C_GROUP_CH) ** -0.5),
        's5_b_im': nrm(ks[12], (L, C_GROUPS, C_STATE, C_GROUP_CH), (2 * C_GROUP_CH) ** -0.5),
        's5_c_re': nrm(ks[13], (L, C_GROUPS, C_GROUP_CH, C_STATE), 0.5 ** 0.5),
        's5_c_im': nrm(ks[14], (L, C_GROUPS, C_GROUP_CH, C_STATE), 0.5 ** 0.5),
        's5_d': nrm(ks[15], (L, C_WIDTH), 0.5),
        's5_glu_w': nrm(ks[16], (L, C_WIDTH, C_WIDTH), C_WIDTH ** -0.5),
        's5_glu_b': nrm(ks[17], (L, C_WIDTH), 0.01),
        'w_branch_a': nrm(ks[18], (L, A_WIDTH, D_MODEL), A_WIDTH ** -0.5),
        'w_branch_b': nrm(ks[19], (L, B_WIDTH, D_MODEL), B_WIDTH ** -0.5),
        'w_branch_c': nrm(ks[20], (L, C_WIDTH, D_MODEL), C_WIDTH ** -0.5),
        'w_out': nrm(ks[21], (L, D_MODEL, D_MODEL), D_MODEL ** -0.5),
        'norm_mlp': 1.0 + nrm(ks[22], (L, D_MODEL), 0.02),
        'w_mlp_up': nrm(ks[23], (L, D_MODEL, D_FF), D_MODEL ** -0.5),
        'w_mlp_down': nrm(ks[24], (L, D_FF, D_MODEL), D_FF ** -0.5),
        'norm_final': 1.0 + nrm(ks[25], (D_MODEL,), 0.02),
    }


def reference(x, positions, norm_mix, w_in, nsa_cmp_pos, nsa_cmp_w1, nsa_cmp_w2, swa_sinks,
              s5_a_re, s5_a_im, s5_log_dt, s5_b_re, s5_b_im, s5_c_re, s5_c_im, s5_d, s5_glu_w, s5_glu_b,
              w_branch_a, w_branch_b, w_branch_c, w_out, norm_mlp, w_mlp_up, w_mlp_down, norm_final):
    bsz, seq, _ = x.shape
    splits = []
    acc = 0
    for w in IN_WIDTHS[:-1]:
        acc += w
        splits.append(acc)

    for l in range(DEPTH):
        h = rmsnorm(x, norm_mix[l])
        proj = h @ w_in[l]
        q_a, kv_a, g_a, q_b, kv_b, u_c, g_m = jnp.split(proj, splits, axis=-1)

        q_a = rope(q_a.reshape(bsz, seq, A_HEADS, HEAD_DIM), positions).reshape(bsz, seq, A_KV_HEADS, A_GROUP, HEAD_DIM)
        kv_a = kv_a.reshape(bsz, seq, NSA_BRANCHES, 2, A_KV_HEADS, HEAD_DIM)
        k_a = rope(kv_a[:, :, :, 0].reshape(bsz, seq, NSA_BRANCHES * A_KV_HEADS, HEAD_DIM), positions).reshape(bsz, seq, NSA_BRANCHES, A_KV_HEADS, HEAD_DIM)
        v_a = kv_a[:, :, :, 1]
        gates_a = jax.nn.sigmoid(g_a.reshape(bsz, seq, NSA_BRANCHES, A_KV_HEADS, A_GROUP))
        y_a = nsa_attention(q_a, k_a, v_a, gates_a, nsa_cmp_pos[l], nsa_cmp_w1[l], nsa_cmp_w2[l])

        q_b = rope(q_b.reshape(bsz, seq, B_HEADS, HEAD_DIM), positions).reshape(bsz, seq, B_KV_HEADS, B_GROUP, HEAD_DIM)
        kv_b = kv_b.reshape(bsz, seq, 2, B_KV_HEADS, HEAD_DIM)
        k_b = rope(kv_b[:, :, 0], positions)
        y_b = banded_attention(q_b, k_b, kv_b[:, :, 1], B_WINDOW, swa_sinks[l]).reshape(bsz, seq, B_WIDTH)

        y_c = s5_layer(u_c, s5_a_re[l], s5_a_im[l], s5_log_dt[l], s5_b_re[l], s5_b_im[l],
                       s5_c_re[l], s5_c_im[l], s5_d[l], s5_glu_w[l], s5_glu_b[l])

        g_m = jax.nn.sigmoid(g_m.reshape(bsz, seq, N_BRANCH, D_MODEL))
        merged = (g_m[:, :, 0] * (y_a @ w_branch_a[l])
                  + g_m[:, :, 1] * (y_b @ w_branch_b[l])
                  + g_m[:, :, 2] * (y_c @ w_branch_c[l]))
        x = x + merged @ w_out[l]

        h = rmsnorm(x, norm_mlp[l])
        x = x + jnp.square(jax.nn.relu(h @ w_mlp_up[l])) @ w_mlp_down[l]

    return rmsnorm(x, norm_final)
```

```cpp
#include <hip/hip_runtime.h>
#include <hip/hip_cooperative_groups.h>
#include <cstdio>
#include <cstdint>
namespace cg = cooperative_groups;

typedef unsigned short bf16_t;
typedef short bf16x8 __attribute__((ext_vector_type(8)));
typedef short s16x4 __attribute__((ext_vector_type(4)));
typedef float f32x4 __attribute__((ext_vector_type(4)));
typedef float f32x16 __attribute__((ext_vector_type(16)));
typedef unsigned u32x4 __attribute__((ext_vector_type(4)));
typedef unsigned u32x2 __attribute__((ext_vector_type(2)));
typedef __bf16 bf16x2_t __attribute__((ext_vector_type(2)));
typedef float f32x2_t __attribute__((ext_vector_type(2)));
#define LAS __attribute__((address_space(3)))
#define DI __device__ __forceinline__

#ifndef MK_MULTI
#define MK_MULTI 0
#endif
#ifndef DBG_MASK
#define DBG_MASK 7
#endif

constexpr int T = 32768, SEQ = 4096, NBATCH = 8, DM = 1024, PP = 2560, NGM = 3072, NIN = 5632, DFF = 4096, DEPTH = 4;
constexpr int C_QA = 0, C_KVA = 512, C_QB = 1280, C_KB = 1792, C_VB = 1856, C_U = 1920, C_GA = 2432;
constexpr float NORM_EPS = 1e-6f;
constexpr float SC2 = 0.125f * 1.4426950408889634f;
constexpr float LOG2E = 1.4426950408889634f;

constexpr size_t OFF_WIN = 0;
constexpr size_t OFF_WUP = OFF_WIN + (size_t)NIN * DM * 2;
constexpr size_t OFF_WDN = OFF_WUP + (size_t)DFF * DM * 2;
constexpr size_t OFF_WOUT = OFF_WDN + (size_t)DFF * DM * 2;
constexpr size_t OFF_WBR = OFF_WOUT + (size_t)DM * DM * 2;
constexpr size_t OFF_WGLU = OFF_WBR + (size_t)3 * DM * 512 * 2;
constexpr size_t OFF_WC1 = OFF_WGLU + (size_t)512 * 512 * 2;
constexpr size_t OFF_WC2 = OFF_WC1 + (size_t)2 * 128 * 2048 * 2;
constexpr size_t OFF_CB = OFF_WC2 + (size_t)2 * 64 * 128 * 2;
constexpr size_t OFF_S5S = OFF_CB + 4096;
constexpr size_t OFF_KC = OFF_S5S + (size_t)8 * 32 * 8 * 64 * 8;
constexpr size_t OFF_VCT = OFF_KC + (size_t)8 * 2 * 256 * 64 * 2;
constexpr size_t OFF_ROPE = OFF_VCT + (size_t)8 * 2 * 256 * 64 * 2;
constexpr size_t OFF_HY = OFF_ROPE + (size_t)T * 32 * 8;
constexpr size_t YSZ = (size_t)T * 512 * 2;
constexpr size_t OFF_PROJ = OFF_HY + 3 * YSZ;
constexpr size_t OFF_G = OFF_PROJ + (size_t)T * PP * 2;
constexpr size_t WS_END = OFF_G + (size_t)T * NGM * 2;
constexpr size_t OFF_BAR = WS_END;
constexpr size_t BAR_BYTES = 3456 * 4;
static_assert(WS_END + BAR_BYTES <= (size_t)512 * 1024 * 1024, "workspace too large");
static_assert((size_t)T * DFF * 2 <= WS_END - OFF_PROJ, "hidden overlay");
constexpr int LDS_WAVE = 18688;
constexpr int LDS_XB = 8 * LDS_WAVE;
constexpr int LDS_BYTES = 8 * LDS_WAVE + 16;

template <class Tp> DI Tp* as_global(Tp* p) { return p; }
DI float bf2f(bf16_t v) { return __uint_as_float((unsigned)v << 16); }
DI unsigned pk2(float lo, float hi) { f32x2_t v = {lo, hi}; bf16x2_t b = __builtin_convertvector(v, bf16x2_t); return __builtin_bit_cast(unsigned, b); }
DI float sigmoidf_(float x) { return 1.0f / (1.0f + __expf(-x)); }
DI float gelu_tanh(float x) { const float u = 0.7978845608028654f * (x + 0.044715f * x * x * x); const float e = __expf(2.0f * u); const float th = 1.0f - 2.0f / (e + 1.0f); return 0.5f * x * (1.0f + th); }
DI int perm16(int x) { return (x & ~12) | ((x & 4) << 1) | ((x & 8) >> 1); }
DI int crow(int reg, int h) { return (reg & 3) + 8 * (reg >> 2) + 4 * h; }
DI float shx(float v, int m, int lane) { return __int_as_float(__builtin_amdgcn_ds_bpermute((lane ^ m) << 2, __float_as_int(v))); }
typedef unsigned u32x2s __attribute__((ext_vector_type(2)));
DI float xmax32(float v) { const u32x2s r = __builtin_amdgcn_permlane32_swap(__float_as_uint(v), __float_as_uint(v), false, false); return fmaxf(__uint_as_float(r[0]), __uint_as_float(r[1])); }
DI float xsum32(float v) { const u32x2s r = __builtin_amdgcn_permlane32_swap(__float_as_uint(v), __float_as_uint(v), false, false); return __uint_as_float(r[0]) + __uint_as_float(r[1]); }
DI float wave_sum(float v, int lane) {
#pragma unroll
    for (int o = 32; o >= 1; o >>= 1) v += shx(v, o, lane);
    return v;
}
#define MFMA32(a, b, c) __builtin_amdgcn_mfma_f32_32x32x16_bf16((a), (b), (c), 0, 0, 0)
#define MFMA16(a, b, c) __builtin_amdgcn_mfma_f32_16x16x32_bf16((a), (b), (c), 0, 0, 0)

namespace pg8 {
constexpr int BM = 256, BK = 64, HALF = 128, HTB = HALF * BK * 2, STAGE_BYTES = 8 * HTB, NXCD = 8, WGM = 8;
__host__ __device__ __forceinline__ int lds_byte(int r, int c) { const int st = (r >> 4) * 2 + (c >> 5), rr = r & 15, cc = c & 31, ob = rr * 64 + cc * 2; return st * 1024 + (ob ^ (((ob >> 9) & 1) << 5)); }
__host__ __device__ __forceinline__ void stage_rc(int b, int& R, int& C) { const int st = b / 1024, sb = b % 1024, swz = sb ^ (((sb >> 9) & 1) << 5); R = (st >> 1) * 16 + swz / 64; C = (st & 1) * 32 + (swz % 64) / 2; }
__host__ __device__ __forceinline__ int perm32(int rho) { const int n = rho >> 4, i = rho & 15; return 8 * (i >> 2) + 4 * n + (i & 3); }

struct Unit { int pm, pn, z; };
struct Gemm { const bf16_t* A; const bf16_t* Bt; int M, N, K, lda; size_t zA, zB; };

DI void tile_of(int wgid, int nwg, int nM, int nN, int& pm, int& pn) {
    { const int q = nwg / NXCD, r = nwg % NXCD, xcd = wgid % NXCD, off = wgid / NXCD; wgid = (xcd < r ? xcd * (q + 1) : r * (q + 1) + (xcd - r) * q) + off; }
    const int nig = WGM * nN, gid = wgid / nig, fm = gid * WGM, gsz = (nM - fm) < WGM ? (nM - fm) : WGM;
    pm = fm + ((wgid % nig) % gsz); pn = (wgid % nig) / gsz;
}
struct StaticOrder {
    int nM, nN, nwg, G, c;
    DI void init(int M, int N, int G_, int c_) { nM = M / BM; nN = N / BM; nwg = nM * nN; G = G_; c = c_; }
    DI bool next(int i, Unit& u) const { const long L = (long)i * G + c; if (L >= nwg) return false; tile_of((int)L, nwg, nM, nN, u.pm, u.pn); u.z = 0; return true; }
};
struct Z3Order {
    int nM, nN, nwg, G, c;
    DI void init(int M, int N, int G_, int c_) { nM = M / BM; nN = N / BM; nwg = nM * nN; G = G_; c = c_; }
    DI bool next(int i, Unit& u) const { const long L = (long)(i / 3) * G + c; if (L >= nwg) return false; tile_of((int)L, nwg, nM, nN, u.pm, u.pn); u.z = i % 3; return true; }
};

template <class Epi, class Sched>
DI void gemm_phase(LAS unsigned char* lds, const Gemm g, const Sched& S, const Epi& E, int tid_l) {
    asm volatile("" : "+v"(tid_l));
    const int tid = tid_l, wid = __builtin_amdgcn_readfirstlane(tid >> 6), lane = tid & 63, wr = wid >> 2, wc = wid & 3, fr = lane & 15, fq = lane >> 4;
    const int K = g.K, nt = K / BK;
    unsigned voffA[2], voffB[2];
#pragma unroll
    for (int i = 0; i < 2; ++i) { int R, C; stage_rc(tid * 16 + i * 8192, R, C); const int Rb = (R & ~31) + perm32(R & 31);
        voffA[i] = (unsigned)(R * g.lda + C) * 2u; voffB[i] = (unsigned)(Rb * K + C) * 2u; }
    const size_t kstep = (size_t)(BK * 2);
    const size_t hstepA = (size_t)HALF * g.lda * 2, hstepB = (size_t)HALF * K * 2;
    const size_t tstepA = 2 * hstepA, tstepB = 2 * hstepB;
    const unsigned ldsw = (unsigned)wid * 1024u;
    const int aoff = lds_byte(wr * 64 + fr, fq * 8), boff = lds_byte(wc * 32 + fr, fq * 8);
#define PG8_SA(b, h) (((b) * 2 + (h)) * HTB)
#define PG8_SB(b, h) ((4 + (b) * 2 + (h)) * HTB)
#define PG8_STAGE(bufoff, gbase, voff) do { _Pragma("unroll") for (int _i = 0; _i < 2; ++_i) \
        __builtin_amdgcn_global_load_lds((const unsigned*)((const char*)(gbase) + (voff)[_i]), (LAS unsigned*)(lds + (bufoff) + ldsw + _i * 8192), 16, 0, 0); } while (0)
#define PG8_LDA(dst, b, h) do { _Pragma("unroll") for (int m = 0; m < 4; ++m) _Pragma("unroll") for (int k = 0; k < 2; ++k) dst[m][k] = *(const LAS bf16x8*)(lds + PG8_SA(b, h) + aoff + m * 2048 + k * 1024); } while (0)
#define PG8_LDB(dst, b, h) do { _Pragma("unroll") for (int n = 0; n < 2; ++n) _Pragma("unroll") for (int k = 0; k < 2; ++k) dst[n][k] = *(const LAS bf16x8*)(lds + PG8_SB(b, h) + boff + n * 2048 + k * 1024); } while (0)
#define PG8_MMA(ai, bj, At, Bt) do { __builtin_amdgcn_s_setprio(1); _Pragma("unroll") for (int m = 0; m < 4; ++m) _Pragma("unroll") for (int n = 0; n < 2; ++n) _Pragma("unroll") for (int k = 0; k < 2; ++k) \
        acc[ai][bj][m][n] = __builtin_amdgcn_mfma_f32_16x16x32_bf16(Bt[n][k], At[m][k], acc[ai][bj][m][n], 0, 0, 0); __builtin_amdgcn_s_setprio(0); } while (0)
#define PG8_WAIT_V(n) asm volatile("s_waitcnt vmcnt(" #n ")" ::: "memory")
#define PG8_WAIT_L(n) asm volatile("s_waitcnt lgkmcnt(" #n ")" ::: "memory")
#define PG8_BAR __builtin_amdgcn_s_barrier()
#define PG8_SCHED __builtin_amdgcn_sched_barrier(0)
    Unit cur, nxt; int ui = 0;
    if (!S.next(0, cur)) return;
    f32x4 acc[2][2][4][2];
#pragma unroll
    for (int a = 0; a < 2; ++a)
#pragma unroll
        for (int b = 0; b < 2; ++b)
#pragma unroll
            for (int m = 0; m < 4; ++m)
#pragma unroll
                for (int n = 0; n < 2; ++n) acc[a][b][m][n] = (f32x4){0.f, 0.f, 0.f, 0.f};
    bf16x8 At[4][2], B0[2][2], B1[2][2];
    const char* cA = (const char*)g.A + (size_t)cur.z * g.zA + (size_t)cur.pm * tstepA; const char* cB = (const char*)g.Bt + (size_t)cur.z * g.zB + (size_t)cur.pn * tstepB;
    PG8_STAGE(PG8_SB(0, 0), cB, voffB); PG8_STAGE(PG8_SB(0, 1), cB + hstepB, voffB); PG8_STAGE(PG8_SA(0, 0), cA, voffA); PG8_STAGE(PG8_SA(0, 1), cA + hstepA, voffA);
    if (wr == 1) PG8_BAR;
    PG8_WAIT_V(2); PG8_BAR;
    PG8_STAGE(PG8_SB(1, 0), cB + kstep, voffB); PG8_STAGE(PG8_SA(1, 0), cA + kstep, voffA); PG8_STAGE(PG8_SB(1, 1), cB + hstepB + kstep, voffB);
    PG8_WAIT_V(6); PG8_BAR;
    for (;;) {
        const bool has_next = S.next(ui + 1, nxt);
        const char* nA = has_next ? (const char*)g.A + (size_t)nxt.z * g.zA + (size_t)nxt.pm * tstepA : cA; const char* nB = has_next ? (const char*)g.Bt + (size_t)nxt.z * g.zB + (size_t)nxt.pn * tstepB : cB;
        for (int t = 0; t < nt; t += 2) {
            const bool last = (t == nt - 2);
            const char* a1 = cA + (size_t)(t + 1) * kstep;
            const char* a2 = last ? nA : cA + (size_t)(t + 2) * kstep; const char* b2 = last ? nB : cB + (size_t)(t + 2) * kstep;
            const char* a3 = a2 + kstep; const char* b3 = b2 + kstep;
            PG8_LDB(B0, 0, 0); PG8_LDB(B1, 0, 1); PG8_SCHED; PG8_LDA(At, 0, 0); PG8_STAGE(PG8_SA(1, 1), a1 + hstepA, voffA);
            PG8_WAIT_V(8); PG8_WAIT_L(0); PG8_BAR; PG8_MMA(0, 0, At, B0); PG8_MMA(0, 1, At, B1); PG8_BAR; PG8_SCHED;
            PG8_LDA(At, 0, 1); PG8_STAGE(PG8_SB(0, 0), b2, voffB); PG8_STAGE(PG8_SB(0, 1), b2 + hstepB, voffB); PG8_STAGE(PG8_SA(0, 0), a2, voffA);
            PG8_WAIT_V(8); PG8_WAIT_L(0); PG8_BAR; PG8_MMA(1, 0, At, B0); PG8_MMA(1, 1, At, B1); PG8_BAR; PG8_SCHED;
            PG8_LDB(B0, 1, 0); PG8_LDB(B1, 1, 1); PG8_SCHED; PG8_LDA(At, 1, 0); PG8_STAGE(PG8_SA(0, 1), a2 + hstepA, voffA);
            PG8_WAIT_V(8); PG8_WAIT_L(0); PG8_BAR; PG8_MMA(0, 0, At, B0); PG8_MMA(0, 1, At, B1); PG8_BAR; PG8_SCHED;
            PG8_LDA(At, 1, 1); PG8_STAGE(PG8_SB(1, 0), b3, voffB); PG8_STAGE(PG8_SB(1, 1), b3 + hstepB, voffB); PG8_STAGE(PG8_SA(1, 0), a3, voffA);
            PG8_WAIT_V(8); PG8_WAIT_L(0); PG8_BAR; PG8_MMA(1, 0, At, B0); PG8_MMA(1, 1, At, B1); PG8_BAR; PG8_SCHED;
        }
        if (wr == 0) PG8_BAR;
        E(acc, cur, wr, wc, fr, fq);
        if (!has_next) break;
#pragma unroll
        for (int a = 0; a < 2; ++a)
#pragma unroll
            for (int b = 0; b < 2; ++b)
#pragma unroll
                for (int m = 0; m < 4; ++m)
#pragma unroll
                    for (int n = 0; n < 2; ++n) acc[a][b][m][n] = (f32x4){0.f, 0.f, 0.f, 0.f};
        cur = nxt; cA = nA; cB = nB; ++ui;
        if (wr == 1) PG8_BAR;
    }
    PG8_WAIT_V(0);
    PG8_BAR;
#undef PG8_SA
#undef PG8_SB
#undef PG8_STAGE
#undef PG8_LDA
#undef PG8_LDB
#undef PG8_MMA
#undef PG8_WAIT_V
#undef PG8_WAIT_L
#undef PG8_BAR
#undef PG8_SCHED
}

#define EPI_LOOP_BEGIN \
    const int row0 = u.pm * BM + wr * 64 + fr; \
    _Pragma("unroll") for (int ai = 0; ai < 2; ++ai) _Pragma("unroll") for (int m = 0; m < 4; ++m) { const size_t row = (size_t)(row0 + ai * HALF + m * 16); \
    _Pragma("unroll") for (int bj = 0; bj < 2; ++bj) { const int col = u.pn * BM + bj * HALF + wc * 32 + 8 * fq; f32x4 v0 = acc[ai][bj][m][0], v1 = acc[ai][bj][m][1];
#define EPI_LOOP_END } }
DI u32x4 pack8(f32x4 v0, f32x4 v1) { u32x4 w; w.x = pk2(v0[0], v0[1]); w.y = pk2(v0[2], v0[3]); w.z = pk2(v1[0], v1[1]); w.w = pk2(v1[2], v1[3]); return w; }
DI void unpack8(u32x4 w, f32x4& a, f32x4& b) {
    a[0] = __uint_as_float(w.x << 16); a[1] = __uint_as_float(w.x & 0xffff0000u); a[2] = __uint_as_float(w.y << 16); a[3] = __uint_as_float(w.y & 0xffff0000u);
    b[0] = __uint_as_float(w.z << 16); b[1] = __uint_as_float(w.z & 0xffff0000u); b[2] = __uint_as_float(w.w << 16); b[3] = __uint_as_float(w.w & 0xffff0000u);
}
struct EpiIn {
    bf16_t* proj; bf16_t* G;
    DI void operator()(const f32x4 (&acc)[2][2][4][2], const Unit& u, int wr, int wc, int fr, int fq) const {
        EPI_LOOP_BEGIN
            if (col >= C_GA) {
#pragma unroll
                for (int j = 0; j < 4; ++j) { v0[j] = sigmoidf_(v0[j]); v1[j] = sigmoidf_(v1[j]); }
            }
            bf16_t* dst = (col < PP) ? proj + row * PP + col : G + row * NGM + (col - PP);
            *(u32x4*)dst = pack8(v0, v1);
        EPI_LOOP_END
    }
};
struct EpiGlu {
    const bf16_t* z; const float* bias; bf16_t* yc;
    DI void operator()(const f32x4 (&acc)[2][2][4][2], const Unit& u, int wr, int wc, int fr, int fq) const {
        const int row0 = u.pm * BM + wr * 64 + fr; const int colb = u.pn * BM + wc * 32 + 8 * fq;
        f32x4 b0[2], b1[2];
#pragma unroll
        for (int bj = 0; bj < 2; ++bj) { b0[bj] = *(const f32x4*)(bias + colb + bj * HALF); b1[bj] = *(const f32x4*)(bias + colb + bj * HALF + 4); }
#pragma unroll
        for (int ai = 0; ai < 2; ++ai) {
            u32x4 zq[4][2];
#pragma unroll
            for (int m = 0; m < 4; ++m)
#pragma unroll
                for (int bj = 0; bj < 2; ++bj) zq[m][bj] = *(const u32x4*)(z + (size_t)(row0 + ai * HALF + m * 16) * PP + colb + bj * HALF);
#pragma unroll
            for (int m = 0; m < 4; ++m)
#pragma unroll
                for (int bj = 0; bj < 2; ++bj) {
                    f32x4 z0, z1; unpack8(zq[m][bj], z0, z1); f32x4 v0 = acc[ai][bj][m][0], v1 = acc[ai][bj][m][1];
#pragma unroll
                    for (int j = 0; j < 4; ++j) { v0[j] = z0[j] * sigmoidf_(v0[j] + b0[bj][j]); v1[j] = z1[j] * sigmoidf_(v1[j] + b1[bj][j]); }
                    *(u32x4*)(yc + (size_t)(row0 + ai * HALF + m * 16) * 512 + colb + bj * HALF) = pack8(v0, v1);
                }
        }
    }
};
struct EpiMerge {
    const bf16_t* G; bf16_t* mg;
    DI void operator()(const f32x4 (&acc)[2][2][4][2], const Unit& u, int wr, int wc, int fr, int fq) const {
        const int row0 = u.pm * BM + wr * 64 + fr; const int colb = u.pn * BM + wc * 32 + 8 * fq;
#pragma unroll
        for (int ai = 0; ai < 2; ++ai) {
            u32x4 gq[4][2], pq[4][2];
#pragma unroll
            for (int m = 0; m < 4; ++m)
#pragma unroll
                for (int bj = 0; bj < 2; ++bj) {
                    const size_t row = (size_t)(row0 + ai * HALF + m * 16); const int col = colb + bj * HALF;
                    gq[m][bj] = *(const u32x4*)(G + row * NGM + u.z * DM + col);
                    pq[m][bj] = (u.z > 0) ? *(const u32x4*)(mg + row * DM + col) : (u32x4){0u, 0u, 0u, 0u};
                }
#pragma unroll
            for (int m = 0; m < 4; ++m)
#pragma unroll
                for (int bj = 0; bj < 2; ++bj) {
                    const size_t row = (size_t)(row0 + ai * HALF + m * 16); const int col = colb + bj * HALF;
                    f32x4 g0, g1, p0, p1; unpack8(gq[m][bj], g0, g1); unpack8(pq[m][bj], p0, p1);
                    const f32x4 v0 = acc[ai][bj][m][0] * g0 + p0, v1 = acc[ai][bj][m][1] * g1 + p1;
                    *(u32x4*)(mg + row * DM + col) = pack8(v0, v1);
                }
        }
    }
};
struct EpiResid {
    float* x;
    DI void operator()(const f32x4 (&acc)[2][2][4][2], const Unit& u, int wr, int wc, int fr, int fq) const {
        const int row0 = u.pm * BM + wr * 64 + fr; const int colb = u.pn * BM + wc * 32 + 8 * fq;
#pragma unroll
        for (int ai = 0; ai < 2; ++ai) {
            f32x4 xa[4][2], xb[4][2];
#pragma unroll
            for (int m = 0; m < 4; ++m)
#pragma unroll
                for (int bj = 0; bj < 2; ++bj) {
                    const float* p = x + (size_t)(row0 + ai * HALF + m * 16) * DM + colb + bj * HALF;
                    xa[m][bj] = *(const f32x4*)p; xb[m][bj] = *(const f32x4*)(p + 4);
                }
#pragma unroll
            for (int m = 0; m < 4; ++m)
#pragma unroll
                for (int bj = 0; bj < 2; ++bj) {
                    float* p = x + (size_t)(row0 + ai * HALF + m * 16) * DM + colb + bj * HALF;
                    *(f32x4*)p = xa[m][bj] + acc[ai][bj][m][0]; *(f32x4*)(p + 4) = xb[m][bj] + acc[ai][bj][m][1];
                }
        }
    }
};
struct EpiUp {
    bf16_t* hid;
    DI void operator()(const f32x4 (&acc)[2][2][4][2], const Unit& u, int wr, int wc, int fr, int fq) const {
        EPI_LOOP_BEGIN
#pragma unroll
            for (int j = 0; j < 4; ++j) { const float a = fmaxf(v0[j], 0.f), b = fmaxf(v1[j], 0.f); v0[j] = a * a; v1[j] = b * b; }
            *(u32x4*)(hid + row * DFF + col) = pack8(v0, v1);
        EPI_LOOP_END
    }
};
}

enum { MODE_WIN = 0, MODE_CMP = 1, MODE_SEL = 2 };
template <int MODE>
DI void fa_tile(f32x16 (&o)[2][2], float (&m)[2], float (&ls)[2], const bf16x8 (&qf)[2][4],
                bf16x8 (&kf)[4], const bf16_t* knext, const bf16_t* VTb, int vpitch, int vks, int kbase, int r, int h,
                const int (&qpos)[2], int W, bool rs0, bool rs1, int qlo, int qhi) {
    bool fullw;
    if (MODE == MODE_WIN) fullw = (kbase + 31 <= qlo) && (kbase > qhi - W);
    else if (MODE == MODE_CMP) fullw = (16 * (kbase + 31) + 31 <= qlo);
    else fullw = (kbase + 31 <= qlo) && (__builtin_amdgcn_ballot_w64(rs0 && rs1) == ~0ull);
    bf16x8 vf[2][2];
#pragma unroll
    for (int dt = 0; dt < 2; ++dt)
#pragma unroll
        for (int s = 0; s < 2; ++s) {
            vf[dt][s] = *(const bf16x8*)(VTb + (size_t)(32 * dt + r) * vpitch + (size_t)(kbase + 16 * s) * vks + 8 * h);
        }
#pragma unroll
    for (int rt = 0; rt < 2; ++rt) {
        f32x16 st;
#pragma unroll
        for (int i = 0; i < 16; ++i) st[i] = 0.f;
#pragma unroll
        for (int ks = 0; ks < 4; ++ks) st = MFMA32(kf[ks], qf[rt][ks], st);
        if (rt == 1) {
#pragma unroll
            for (int ks = 0; ks < 4; ++ks) kf[ks] = *(const bf16x8*)(knext + 16 * ks);
        }
        const int qp = qpos[rt]; const bool rs = rt == 0 ? rs0 : rs1;
        if (!fullw) {
#pragma unroll
            for (int i = 0; i < 16; ++i) {
                const int kpos = kbase + crow(i, h);
                bool valid;
                if (MODE == MODE_WIN) valid = (kpos <= qp) && (kpos > qp - W);
                else if (MODE == MODE_CMP) valid = (16 * kpos + 31 <= qp);
                else valid = rs && (kpos <= qp);
                st[i] = valid ? st[i] : -INFINITY;
            }
        }
        float mx = st[0];
#pragma unroll
        for (int i = 1; i < 16; ++i) mx = fmaxf(mx, st[i]);
        mx = xmax32(mx);
        const float cand = fmaxf(m[rt], mx * SC2);
        if (__builtin_amdgcn_ballot_w64((cand - m[rt]) > 8.0f) != 0ull) {
            const float alpha = __builtin_amdgcn_exp2f(m[rt] - cand);
            m[rt] = cand; ls[rt] *= alpha;
#pragma unroll
            for (int dt = 0; dt < 2; ++dt)
#pragma unroll
                for (int i = 0; i < 16; ++i) o[rt][dt][i] *= alpha;
        }
        const float mref = m[rt];
        float sum = 0.f;
#pragma unroll
        for (int i = 0; i < 16; ++i) { const float p = __builtin_amdgcn_exp2f(__builtin_fmaf(st[i], SC2, -mref)); st[i] = p; sum += p; }
        ls[rt] += sum;
        bf16x8 pf[2];
#pragma unroll
        for (int s = 0; s < 2; ++s) {
            u32x4 w; w.x = pk2(st[8 * s + 0], st[8 * s + 1]); w.y = pk2(st[8 * s + 2], st[8 * s + 3]); w.z = pk2(st[8 * s + 4], st[8 * s + 5]); w.w = pk2(st[8 * s + 6], st[8 * s + 7]);
            pf[s] = __builtin_bit_cast(bf16x8, w);
        }
#pragma unroll
        for (int dt = 0; dt < 2; ++dt)
#pragma unroll
            for (int s = 0; s < 2; ++s) o[rt][dt] = MFMA32(vf[dt][s], pf[s], o[rt][dt]);
    }
}
DI void kf_load(bf16x8 (&kf)[4], const bf16_t* kp) {
#pragma unroll
    for (int ks = 0; ks < 4; ++ks) kf[ks] = *(const bf16x8*)(kp + 16 * ks);
}
DI void fa_zero(f32x16 (&o)[2][2]) {
#pragma unroll
    for (int a = 0; a < 2; ++a)
#pragma unroll
        for (int b = 0; b < 2; ++b)
#pragma unroll
            for (int i = 0; i < 16; ++i) o[a][b][i] = 0.f;
}

DI unsigned long long topk_mask(float impv, int lane, int cur) {
    const bool valid = lane <= cur; const bool forced = (lane == 0) | (lane == cur) | (lane == cur - 1);
    if (cur + 1 <= 16) return __ballot(valid);
    const unsigned key = valid ? (forced ? 0x7f000000u : (__float_as_uint(fmaxf(impv, 0.f)) + 1u)) : 0u;
    unsigned t = 0;
    for (int bit = 30; bit >= 0; --bit) {
        const unsigned cand = t | (1u << bit);
        const int cnt = __popcll(__ballot(key >= cand));
        if (cnt >= 16) t = cand;
    }
    const unsigned long long gt = __ballot(key > t), eq = __ballot(key == t);
    const int need = 16 - __popcll(gt);
    const int below = __popcll(eq & ((1ull << lane) - 1ull));
    const bool sel = (key > t) || ((key == t) && (below < need));
    return __ballot(sel);
}

DI void attnA_unit(const bf16_t* proj, const bf16_t* kc, const bf16_t* vct, const bf16_t* VT, bf16_t* ya,
                   int b, int hkv, int q0, LAS unsigned char* wl, int lane) {
    asm volatile("" : "+v"(lane));
    int r = lane & 31, h = lane >> 5;
#define RELAUNDER() do { asm volatile("" : "+v"(lane)); r = lane & 31; h = lane >> 5; } while (0)
    const size_t tokbase = (size_t)b * SEQ;
    LAS float* ytot = (LAS float*)wl;
    LAS float* impscr = (LAS float*)(wl + 16384);
    LAS unsigned* mskscr = (LAS unsigned*)(wl + 16384 + 2048);
    int qpos[2]; bf16x8 qf[2][4];
#pragma unroll
    for (int rt = 0; rt < 2; ++rt) {
        const int R = 32 * rt + r, qi = R >> 2, gi = R & 3; qpos[rt] = q0 + qi;
        const bf16_t* qp = proj + (tokbase + qpos[rt]) * PP + C_QA + (hkv * 4 + gi) * 64 + 8 * h;
#pragma unroll
        for (int ks = 0; ks < 4; ++ks) qf[rt][ks] = *(const bf16x8*)(qp + 16 * ks);
    }
    f32x16 o[2][2]; float m[2], ls[2];
    const bf16_t* Kc = kc + (size_t)(b * 2 + hkv) * 256 * 64; const bf16_t* Vc = vct + (size_t)(b * 2 + hkv) * 64 * 256;
    const int nmax = (q0 + 15 - 31) >> 4; const int ntile = nmax >= 0 ? (nmax >> 5) + 1 : 0;
    fa_zero(o); m[0] = m[1] = -1e30f; ls[0] = ls[1] = 0.f;
    {
        bf16x8 kf[4]; const bf16_t* kl = Kc + (size_t)r * 64 + 8 * h; kf_load(kf, kl);
#pragma unroll 1
        for (int t = 0; t < ntile; ++t) { const int nb = (t + 1 < ntile) ? 32 * (t + 1) : 32 * t; fa_tile<MODE_CMP>(o, m, ls, qf, kf, kl + (size_t)nb * 64, Vc, 16, 64, 32 * t, r, h, qpos, 0, false, false, q0, q0 + 15); }
    }
    float mc[2], invc[2];
#pragma unroll
    for (int rt = 0; rt < 2; ++rt) {
        const float lt = xsum32(ls[rt]); const float inv = lt > 0.f ? 1.0f / lt : 0.f; mc[rt] = m[rt]; invc[rt] = inv;
        const float gsc = bf2f(proj[(tokbase + qpos[rt]) * PP + C_GA + 0 + hkv * 4 + ((32 * rt + r) & 3)]) * inv;
#pragma unroll
        for (int dt = 0; dt < 2; ++dt)
#pragma unroll
            for (int i = 0; i < 16; ++i) ytot[((rt * 2 + dt) * 16 + i) * 64 + lane] = o[rt][dt][i] * gsc;
    }
    RELAUNDER();
    fa_zero(o);
#pragma unroll 1
    for (int t = 0; t < ntile; ++t) {
        const int kbase = 32 * t;
        const bf16_t* kp = Kc + (size_t)(kbase + r) * 64 + 8 * h;
        bf16x8 kf[4];
#pragma unroll
        for (int ks = 0; ks < 4; ++ks) kf[ks] = *(const bf16x8*)(kp + 16 * ks);
        bf16x8 cf[2][2];
#pragma unroll
        for (int jt = 0; jt < 2; ++jt)
#pragma unroll
            for (int s = 0; s < 2; ++s) {
                const int jj = 32 * jt + r;
#pragma unroll
                for (int j = 0; j < 8; ++j) {
                    const int n = kbase + 16 * s + 8 * (j >> 2) + 4 * h + (j & 3);
                    const int jn = n >> 2; const bool edge = (n & 3) == 3;
                    const unsigned short w = (jj == jn) ? (edge ? 0x3F00 : 0x3F80) : ((edge && jj == jn + 1) ? 0x3F00 : 0);
                    cf[jt][s][j] = (short)w;
                }
            }
#pragma unroll
        for (int rt = 0; rt < 2; ++rt) {
            f32x16 st;
#pragma unroll
            for (int i = 0; i < 16; ++i) st[i] = 0.f;
#pragma unroll
            for (int ks = 0; ks < 4; ++ks) st = MFMA32(kf[ks], qf[rt][ks], st);
#pragma unroll
            for (int i = 0; i < 16; ++i) {
                const int kpos = kbase + crow(i, h);
                const bool valid = (16 * kpos + 31 <= qpos[rt]);
                st[i] = valid ? __builtin_amdgcn_exp2f(st[i] * SC2 - mc[rt]) * invc[rt] : 0.f;
            }
            bf16x8 pf[2];
#pragma unroll
            for (int s = 0; s < 2; ++s) {
                u32x4 w; w.x = pk2(st[8 * s + 0], st[8 * s + 1]); w.y = pk2(st[8 * s + 2], st[8 * s + 3]); w.z = pk2(st[8 * s + 4], st[8 * s + 5]); w.w = pk2(st[8 * s + 6], st[8 * s + 7]);
                pf[s] = __builtin_bit_cast(bf16x8, w);
            }
#pragma unroll
            for (int jt = 0; jt < 2; ++jt)
#pragma unroll
                for (int s = 0; s < 2; ++s) o[rt][jt] = MFMA32(cf[jt][s], pf[s], o[rt][jt]);
        }
    }
    RELAUNDER();
    const int cur = q0 >> 6;
    unsigned long long uni = 0ull; unsigned mlo[2], mhi[2];
#pragma unroll
    for (int rt = 0; rt < 2; ++rt) {
#pragma unroll
        for (int jt = 0; jt < 2; ++jt)
#pragma unroll
            for (int i = 0; i < 16; ++i) {
                float v = o[rt][jt][i]; v += shx(v, 1, lane); v += shx(v, 2, lane);
                if ((r & 3) == 0) impscr[(r >> 2) * 64 + 32 * jt + crow(i, h)] = v;
            }
        asm volatile("s_waitcnt lgkmcnt(0)" ::: "memory");
        for (int qi = 0; qi < 8; ++qi) {
            const float v = impscr[qi * 64 + lane];
            const unsigned long long mk = topk_mask(v, lane, cur);
            uni |= mk;
            if (lane == 0) { mskscr[qi * 2] = (unsigned)mk; mskscr[qi * 2 + 1] = (unsigned)(mk >> 32); }
        }
        asm volatile("s_waitcnt lgkmcnt(0)" ::: "memory");
        mlo[rt] = mskscr[(r >> 2) * 2]; mhi[rt] = mskscr[(r >> 2) * 2 + 1];
        asm volatile("s_waitcnt lgkmcnt(0)" ::: "memory");
    }
    RELAUNDER();
    {
        const bf16_t* Ks = proj + tokbase * PP + C_KVA + 256 + hkv * 64;
        const bf16_t* Vs = VT + (size_t)((0 + hkv) * 8 + b) * 64 * SEQ;
        fa_zero(o); m[0] = m[1] = -1e30f; ls[0] = ls[1] = 0.f;
        {
            const unsigned long long vm = uni & ((2ull << cur) - 1ull);
            const bf16_t* kl = Ks + (size_t)r * PP + 8 * h;
            int j = __builtin_ctzll(vm), hf = 0; bool has = true;
            bf16x8 kf[4]; kf_load(kf, kl + (size_t)(64 * j) * PP);
#pragma unroll 1
            while (has) {
                int nj = j, nhf = hf; bool hasn = false;
                if (hf == 0 && 64 * j + 32 <= q0 + 15) { nhf = 1; hasn = true; }
                else { const unsigned long long rem = (j < 63) ? (vm & (~0ull << (j + 1))) : 0ull; if (rem) { nj = __builtin_ctzll(rem); nhf = 0; hasn = true; } }
                const bool rs0 = ((j < 32 ? mlo[0] : mhi[0]) >> (j & 31)) & 1u, rs1 = ((j < 32 ? mlo[1] : mhi[1]) >> (j & 31)) & 1u;
                fa_tile<MODE_SEL>(o, m, ls, qf, kf, kl + (size_t)(64 * nj + 32 * nhf) * PP, Vs, 16, 64, 64 * j + 32 * hf, r, h, qpos, 0, rs0, rs1, q0, q0 + 15);
                j = nj; hf = nhf; has = hasn;
            }
        }
#pragma unroll
        for (int rt = 0; rt < 2; ++rt) {
            const float lt = xsum32(ls[rt]); const float inv = lt > 0.f ? 1.0f / lt : 0.f;
            const float gsc = bf2f(proj[(tokbase + qpos[rt]) * PP + C_GA + 8 + hkv * 4 + ((32 * rt + r) & 3)]) * inv;
#pragma unroll
            for (int dt = 0; dt < 2; ++dt)
#pragma unroll
                for (int i = 0; i < 16; ++i) ytot[((rt * 2 + dt) * 16 + i) * 64 + lane] += o[rt][dt][i] * gsc;
        }
    }
    RELAUNDER();
    {
        const bf16_t* Kw = proj + tokbase * PP + C_KVA + 512 + hkv * 64;
        const bf16_t* Vw = VT + (size_t)((2 + hkv) * 8 + b) * 64 * SEQ;
        fa_zero(o); m[0] = m[1] = -1e30f; ls[0] = ls[1] = 0.f;
        int kb0 = (q0 - 511) & ~31; if (kb0 < 0) kb0 = 0;
        {
            const bf16_t* kl = Kw + (size_t)r * PP + 8 * h; bf16x8 kf[4]; kf_load(kf, kl + (size_t)kb0 * PP);
#pragma unroll 1
            for (int kbase = kb0; kbase <= q0 + 15; kbase += 32) { const int nb = (kbase + 32 <= q0 + 15) ? kbase + 32 : kbase; fa_tile<MODE_WIN>(o, m, ls, qf, kf, kl + (size_t)nb * PP, Vw, 16, 64, kbase, r, h, qpos, 512, false, false, q0, q0 + 15); }
        }
#pragma unroll
        for (int rt = 0; rt < 2; ++rt) {
            const float lt = xsum32(ls[rt]); const float inv = lt > 0.f ? 1.0f / lt : 0.f;
            const float gsc = bf2f(proj[(tokbase + qpos[rt]) * PP + C_GA + 16 + hkv * 4 + ((32 * rt + r) & 3)]) * inv;
            const int R = 32 * rt + r, gi = R & 3;
            bf16_t* yp = ya + (tokbase + qpos[rt]) * 512 + (hkv * 4 + gi) * 64;
#pragma unroll
            for (int dt = 0; dt < 2; ++dt)
#pragma unroll
                for (int a = 0; a < 4; ++a) {
                    float v[4];
#pragma unroll
                    for (int bb = 0; bb < 4; ++bb) { const int i = 4 * a + bb; v[bb] = ytot[((rt * 2 + dt) * 16 + i) * 64 + lane] + o[rt][dt][i] * gsc; }
                    u32x2 w; w.x = pk2(v[0], v[1]); w.y = pk2(v[2], v[3]);
                    *(u32x2*)(yp + 32 * dt + 8 * a + 4 * h) = w;
                }
        }
    }
    asm volatile("s_waitcnt lgkmcnt(0)" ::: "memory");
}

DI void attnB_unit(const bf16_t* proj, const bf16_t* VT, const float* sinks, bf16_t* yb, int b, int q0, int lane) {
    asm volatile("" : "+v"(lane));
    const int r = lane & 31, h = lane >> 5;
    const size_t tokbase = (size_t)b * SEQ;
    int qpos[2]; bf16x8 qf[2][4]; f32x16 o[2][2]; float m[2], ls[2];
#pragma unroll
    for (int rt = 0; rt < 2; ++rt) {
        const int R = 32 * rt + r, qi = R >> 3, gi = R & 7; qpos[rt] = q0 + qi;
        const bf16_t* qp = proj + (tokbase + qpos[rt]) * PP + C_QB + gi * 64 + 8 * h;
#pragma unroll
        for (int ks = 0; ks < 4; ++ks) qf[rt][ks] = *(const bf16x8*)(qp + 16 * ks);
        m[rt] = sinks[gi] * LOG2E; ls[rt] = (h == 0) ? 1.0f : 0.f;
    }
    fa_zero(o);
    const bf16_t* Kb = proj + tokbase * PP + C_KB;
    const bf16_t* Vb = VT + (size_t)(4 * 8 + b) * 64 * SEQ;
    int kb0 = (q0 - 127) & ~31; if (kb0 < 0) kb0 = 0;
    {
        const bf16_t* kl = Kb + (size_t)r * PP + 8 * h; bf16x8 kf[4]; kf_load(kf, kl + (size_t)kb0 * PP);
#pragma unroll 1
        for (int kbase = kb0; kbase <= q0 + 7; kbase += 32) { const int nb = (kbase + 32 <= q0 + 7) ? kbase + 32 : kbase; fa_tile<MODE_WIN>(o, m, ls, qf, kf, kl + (size_t)nb * PP, Vb, 16, 64, kbase, r, h, qpos, 128, false, false, q0, q0 + 7); }
    }
#pragma unroll
    for (int rt = 0; rt < 2; ++rt) {
        const float lt = xsum32(ls[rt]); const float inv = 1.0f / lt;
        const int R = 32 * rt + r, gi = R & 7;
        bf16_t* yp = yb + (tokbase + qpos[rt]) * 512 + gi * 64;
#pragma unroll
        for (int dt = 0; dt < 2; ++dt)
#pragma unroll
            for (int a = 0; a < 4; ++a) {
                u32x2 w; w.x = pk2(o[rt][dt][4 * a] * inv, o[rt][dt][4 * a + 1] * inv); w.y = pk2(o[rt][dt][4 * a + 2] * inv, o[rt][dt][4 * a + 3] * inv);
                *(u32x2*)(yp + 32 * dt + 8 * a + 4 * h) = w;
            }
    }
}

DI void compress_unit(const bf16_t* proj, const bf16_t* W1T, const bf16_t* W2T, const float* cb, const float* rope, bf16_t* kc, bf16_t* vct,
                      int j, int b, int hkv, int nch, int kpart, LAS unsigned char* ldsb, int wave, int lane) {
    asm volatile("" : "+v"(lane));
    const int fr = lane & 15, fq = lane >> 4;
    const int n0 = nch * 16; const int n = n0 + fr; const int nl = n > 254 ? 254 : n;
    const bf16_t* src = proj + ((size_t)b * SEQ + (size_t)nl * 16) * PP + C_KVA + j * 128 + hkv * 64 + fq * 8;
    const bf16_t* w1 = W1T + (size_t)j * 128 * 2048 + (size_t)fr * 2048 + fq * 8;
    f32x4 acc1[8];
#pragma unroll
    for (int ht = 0; ht < 8; ++ht) acc1[ht] = (f32x4){0.f, 0.f, 0.f, 0.f};
    const float* rp = rope + (((size_t)b * SEQ + (size_t)nl * 16) * 32 + fq * 8) * 2;
#pragma unroll 2
    for (int l = kpart * 8; l < kpart * 8 + 8; ++l) {
        bf16x8 b0 = *(const bf16x8*)(src + (size_t)l * PP), b1 = *(const bf16x8*)(src + (size_t)l * PP + 32);
        if (j == 0) {
            f32x4 x0, x1, y0, y1; pg8::unpack8(__builtin_bit_cast(u32x4, b0), x0, x1); pg8::unpack8(__builtin_bit_cast(u32x4, b1), y0, y1);
            const f32x4 cs0 = *(const f32x4*)(rp + (size_t)l * 64), cs1 = *(const f32x4*)(rp + (size_t)l * 64 + 4), cs2 = *(const f32x4*)(rp + (size_t)l * 64 + 8), cs3 = *(const f32x4*)(rp + (size_t)l * 64 + 12);
            f32x4 o0, o1, q0, q1;
            o0[0] = x0[0] * cs0[0] - y0[0] * cs0[1]; q0[0] = y0[0] * cs0[0] + x0[0] * cs0[1];
            o0[1] = x0[1] * cs0[2] - y0[1] * cs0[3]; q0[1] = y0[1] * cs0[2] + x0[1] * cs0[3];
            o0[2] = x0[2] * cs1[0] - y0[2] * cs1[1]; q0[2] = y0[2] * cs1[0] + x0[2] * cs1[1];
            o0[3] = x0[3] * cs1[2] - y0[3] * cs1[3]; q0[3] = y0[3] * cs1[2] + x0[3] * cs1[3];
            o1[0] = x1[0] * cs2[0] - y1[0] * cs2[1]; q1[0] = y1[0] * cs2[0] + x1[0] * cs2[1];
            o1[1] = x1[1] * cs2[2] - y1[1] * cs2[3]; q1[1] = y1[1] * cs2[2] + x1[1] * cs2[3];
            o1[2] = x1[2] * cs3[0] - y1[2] * cs3[1]; q1[2] = y1[2] * cs3[0] + x1[2] * cs3[1];
            o1[3] = x1[3] * cs3[2] - y1[3] * cs3[3]; q1[3] = y1[3] * cs3[2] + x1[3] * cs3[3];
            b0 = __builtin_bit_cast(bf16x8, pg8::pack8(o0, o1)); b1 = __builtin_bit_cast(bf16x8, pg8::pack8(q0, q1));
        }
#pragma unroll
        for (int ht = 0; ht < 8; ++ht) {
            const bf16x8 a0 = *(const bf16x8*)(w1 + (size_t)ht * 16 * 2048 + (2 * l) * 32);
            const bf16x8 a1 = *(const bf16x8*)(w1 + (size_t)ht * 16 * 2048 + (2 * l + 1) * 32);
            acc1[ht] = MFMA16(a0, b0, acc1[ht]);
            acc1[ht] = MFMA16(a1, b1, acc1[ht]);
        }
    }
    {
        LAS float* mine = (LAS float*)(ldsb + wave * LDS_WAVE);
#pragma unroll
        for (int ht = 0; ht < 8; ++ht)
#pragma unroll
            for (int i = 0; i < 4; ++i) mine[(ht * 4 + i) * 64 + lane] = acc1[ht][i];
    }
    __syncthreads();
    if (kpart == 0) {
#pragma unroll
    for (int p = 1; p < 4; ++p) {
        const LAS float* oth = (const LAS float*)(ldsb + (wave + p) * LDS_WAVE);
#pragma unroll
        for (int ht = 0; ht < 8; ++ht)
#pragma unroll
            for (int i = 0; i < 4; ++i) acc1[ht][i] += oth[(ht * 4 + i) * 64 + lane];
    }
    const float* cbj = cb + j * 128;
#pragma unroll
    for (int ht = 0; ht < 8; ++ht)
#pragma unroll
        for (int i = 0; i < 4; ++i) acc1[ht][i] = gelu_tanh(acc1[ht][i] + cbj[16 * ht + 4 * fq + i]);
    f32x4 acc2[4];
#pragma unroll
    for (int ot = 0; ot < 4; ++ot) acc2[ot] = (f32x4){0.f, 0.f, 0.f, 0.f};
    const bf16_t* w2 = W2T + (size_t)j * 64 * 128;
#pragma unroll
    for (int s = 0; s < 4; ++s) {
        u32x4 w; w.x = pk2(acc1[2 * s][0], acc1[2 * s][1]); w.y = pk2(acc1[2 * s][2], acc1[2 * s][3]); w.z = pk2(acc1[2 * s + 1][0], acc1[2 * s + 1][1]); w.w = pk2(acc1[2 * s + 1][2], acc1[2 * s + 1][3]);
        const bf16x8 bfr = __builtin_bit_cast(bf16x8, w);
#pragma unroll
        for (int ot = 0; ot < 4; ++ot) {
            const bf16_t* ap = w2 + (size_t)(ot * 16 + fr) * 128 + 32 * s + 4 * fq;
            const s16x4 lo = *(const s16x4*)ap, hi = *(const s16x4*)(ap + 16);
            const bf16x8 afr = (bf16x8){lo[0], lo[1], lo[2], lo[3], hi[0], hi[1], hi[2], hi[3]};
            acc2[ot] = MFMA16(afr, bfr, acc2[ot]);
        }
    }
    const bool live = n <= 254;
    if (j == 0) {
        bf16_t* dst = kc + ((size_t)(b * 2 + hkv) * 256 + n) * 64;
#pragma unroll
        for (int ot = 0; ot < 4; ++ot) { u32x2 w; w.x = live ? pk2(acc2[ot][0], acc2[ot][1]) : 0u; w.y = live ? pk2(acc2[ot][2], acc2[ot][3]) : 0u; *(u32x2*)(dst + 16 * ot + 4 * fq) = w; }
    } else {
        bf16_t* dst = vct + (size_t)(b * 2 + hkv) * 64 * 256 + (size_t)nch * 1024 + perm16(fr);
#pragma unroll
        for (int ot = 0; ot < 4; ++ot)
#pragma unroll
            for (int i = 0; i < 4; ++i) dst[(16 * ot + 4 * fq + i) * 16] = live ? (bf16_t)(pk2(acc2[ot][i], 0.f) & 0xffffu) : (bf16_t)0;
    }
    }
    __syncthreads();
}

struct S5In { const float *a_re, *a_im, *log_dt, *b_re, *b_im, *c_re, *c_im, *d; };
DI void cplx_abar(const S5In& P, int g, int p, float dt, float& abr, float& abi, float& cfr, float& cfi) {
    const float ar = P.a_re[g * 64 + p], ai = P.a_im[g * 64 + p];
    const float mag = expf(dt * ar); abr = mag * cosf(dt * ai); abi = mag * sinf(dt * ai);
    const float den = ar * ar + ai * ai, nr = abr - 1.0f, ni = abi;
    cfr = (nr * ar + ni * ai) / den; cfi = (ni * ar - nr * ai) / den;
}
template <bool OUT>
DI void s5_unit(const S5In& P, bf16_t* proj, float* states, int b, int g, int c, int nsc, LAS unsigned char* wl, int lane) {
    asm volatile("" : "+v"(lane));
    const int r = lane & 31, h = lane >> 5, fr = lane & 15, fq = lane >> 4;
    const float dt = expf(P.log_dt[g]);
    float abr, abi, t0, t1; cplx_abar(P, g, lane, dt, abr, abi, t0, t1);
    bf16x8 bfrag[4];
#pragma unroll
    for (int hs = 0; hs < 2; ++hs) {
        const int p = r + 32 * hs; float a0, a1, cr, ci; cplx_abar(P, g, p, dt, a0, a1, cr, ci);
        const float* br = P.b_re + ((size_t)g * 64 + p) * 16 + 8 * h; const float* bi = P.b_im + ((size_t)g * 64 + p) * 16 + 8 * h;
        float re[8], im[8];
#pragma unroll
        for (int j = 0; j < 8; ++j) { re[j] = cr * br[j] - ci * bi[j]; im[j] = cr * bi[j] + ci * br[j]; }
        u32x4 wr_, wi_; wr_.x = pk2(re[0], re[1]); wr_.y = pk2(re[2], re[3]); wr_.z = pk2(re[4], re[5]); wr_.w = pk2(re[6], re[7]);
        wi_.x = pk2(im[0], im[1]); wi_.y = pk2(im[2], im[3]); wi_.z = pk2(im[4], im[5]); wi_.w = pk2(im[6], im[7]);
        bfrag[hs] = __builtin_bit_cast(bf16x8, wr_); bfrag[2 + hs] = __builtin_bit_cast(bf16x8, wi_);
    }
    bf16x8 cfrag[4]; float dch = 0.f;
    if (OUT) {
#pragma unroll
        for (int ks = 0; ks < 4; ++ks) {
            const float* cr = P.c_re + ((size_t)g * 16 + fr) * 64 + 16 * ks + 4 * fq; const float* ci = P.c_im + ((size_t)g * 16 + fr) * 64 + 16 * ks + 4 * fq;
            u32x4 w; w.x = pk2(cr[0], -ci[0]); w.y = pk2(cr[1], -ci[1]); w.z = pk2(cr[2], -ci[2]); w.w = pk2(cr[3], -ci[3]);
            cfrag[ks] = __builtin_bit_cast(bf16x8, w);
        }
        dch = P.d[g * 16 + fr];
    }
    float xr = 0.f, xi = 0.f;
    if (OUT) {
        float pr = abr, pi = abi;
#pragma unroll
        for (int q = 0; q < 9; ++q) { const float nr = pr * pr - pi * pi, ni = 2.0f * pr * pi; pr = nr; pi = ni; }
#ifndef DBG_NOSTATE
        for (int cc = 0; cc < c; ++cc) {
            const float* sp = states + ((((size_t)b * 32 + g) * 8 + cc) * 64 + lane) * 2;
            const float sr = sp[0], si = sp[1];
            const float nr = pr * xr - pi * xi + sr, ni = pr * xi + pi * xr + si; xr = nr; xi = ni;
        }
#endif
    }
    LAS float* bu = (LAS float*)wl;
    bf16_t* ucol = proj + ((size_t)b * SEQ + (size_t)c * 512) * PP + C_U + g * 16;
    bf16x8 ufr_n = *(const bf16x8*)(ucol + (size_t)r * PP + 8 * h);
    LAS bf16_t* uimg = (LAS bf16_t*)(wl + 16896);
#pragma unroll 1
    for (int sc = 0; sc < nsc; ++sc) {
        bf16_t* ub = ucol + (size_t)sc * 32 * PP;
        const bf16x8 ufr = ufr_n;
        if (OUT) *(LAS bf16x8*)(uimg + r * 16 + 8 * h) = ufr;
        {
            const bf16_t* un = ucol + (size_t)(sc + 1 < nsc ? sc + 1 : sc) * 32 * PP;
            ufr_n = *(const bf16x8*)(un + (size_t)r * PP + 8 * h);
        }
#pragma unroll
        for (int nt = 0; nt < 4; ++nt) {
            f32x16 d;
#pragma unroll
            for (int i = 0; i < 16; ++i) d[i] = 0.f;
            d = MFMA32(ufr, bfrag[nt], d);
#pragma unroll
            for (int i = 0; i < 16; ++i) bu[crow(i, h) * 132 + 32 * nt + r] = d[i];
        }
        asm volatile("s_waitcnt lgkmcnt(0)" ::: "memory");
#pragma unroll 8
        for (int t = 0; t < 32; ++t) {
            const float br_ = bu[t * 132 + lane], bi_ = bu[t * 132 + 64 + lane];
            const float nr = abr * xr - abi * xi + br_, ni = abr * xi + abi * xr + bi_; xr = nr; xi = ni;
            if (OUT) {
                ((LAS unsigned*)(bu + t * 132))[lane] = pk2(xr, xi);
            }
        }
        if (OUT) {
            asm volatile("s_waitcnt lgkmcnt(0)" ::: "memory");
#pragma unroll
            for (int mt = 0; mt < 2; ++mt) {
                f32x4 y = (f32x4){0.f, 0.f, 0.f, 0.f};
#pragma unroll
                for (int ks = 0; ks < 4; ++ks) {
                    const bf16x8 xa = *(const LAS bf16x8*)((LAS unsigned char*)bu + (mt * 16 + fr) * 528 + ks * 64 + fq * 16);
                    y = MFMA16(xa, cfrag[ks], y);
                }
#pragma unroll
                for (int i = 0; i < 4; ++i) {
                    LAS bf16_t* e = uimg + (mt * 16 + 4 * fq + i) * 16 + fr;
                    const float yy = y[i] + dch * bf2f(*e);
                    *e = (bf16_t)(pk2(gelu_tanh(yy), 0.f) & 0xffffu);
                }
            }
            asm volatile("s_waitcnt lgkmcnt(0)" ::: "memory");
            {
                const bf16x8 zv = *(const LAS bf16x8*)(uimg + lane * 8);
                *(bf16x8*)(ub + (size_t)(lane >> 1) * PP + 8 * (lane & 1)) = zv;
            }
            asm volatile("s_waitcnt lgkmcnt(0)" ::: "memory");
        }
    }
    if (!OUT) { float* sp = states + ((((size_t)b * 32 + g) * 8 + c) * 64 + lane) * 2; sp[0] = xr; sp[1] = xi; }
}

template <bool OUT_F32>
DI void rmsnorm_rows(const float* src, const float* gain, bf16_t* dstb, float* dstf, float* copy, int gw, int nw, int lane) {
    f32x4 gv[4];
#pragma unroll
    for (int i = 0; i < 4; ++i) gv[i] = *(const f32x4*)(gain + 256 * i + 4 * lane);
#pragma unroll 2
    for (int row = gw; row < T; row += nw) {
        const float* xp = src + (size_t)row * DM + 4 * lane;
        f32x4 v[4]; float ss = 0.f;
#pragma unroll
        for (int i = 0; i < 4; ++i) { v[i] = *(const f32x4*)(xp + 256 * i); ss += v[i][0] * v[i][0] + v[i][1] * v[i][1] + v[i][2] * v[i][2] + v[i][3] * v[i][3]; }
        ss = wave_sum(ss, lane);
        const float rs = rsqrtf(ss * (1.0f / 1024.0f) + NORM_EPS);
#pragma unroll
        for (int i = 0; i < 4; ++i) {
            if (copy) *(f32x4*)(copy + (size_t)row * DM + 256 * i + 4 * lane) = v[i];
            const f32x4 y = v[i] * rs * gv[i];
            if (OUT_F32) *(f32x4*)(dstf + (size_t)row * DM + 256 * i + 4 * lane) = y;
            else { u32x2 w; w.x = pk2(y[0], y[1]); w.y = pk2(y[2], y[3]); *(u32x2*)(dstb + (size_t)row * DM + 256 * i + 4 * lane) = w; }
        }
    }
}

DI int in_srccol(int n) { return n < 1280 ? n : (n < 2432 ? n + 24 : (n < 2456 ? n - 1152 : (n < 2560 ? -1 : n - 104))); }

#define XB_TMO      128
#define XB_XCNT(j)  (256  + 64 * (j))
#define XB_XSUB(j)  (1280 + 64 * (j))
#define XB_XGEN(j)  (2304 + 64 * (j))
#define XB_TOP      3328
#define XB_TOPGEN   3392
#define XB_SPIN_CAP (1u << 18)
DI unsigned xb_ld(unsigned* p)              { return __hip_atomic_load(p, __ATOMIC_RELAXED, __HIP_MEMORY_SCOPE_AGENT); }
DI unsigned xb_add(unsigned* p, unsigned v) { return __hip_atomic_fetch_add(p, v, __ATOMIC_RELAXED, __HIP_MEMORY_SCOPE_AGENT); }
DI unsigned xb_xcc_id() { return (unsigned)__builtin_amdgcn_s_getreg((3 << 11) | 20) & 0xFu; }
#define XB_SPIN(cond, bar) do { unsigned _sp = 0; while (cond) { __builtin_amdgcn_s_sleep(1); \
    if ((++_sp & 255u) == 0u) { if (xb_ld(&(bar)[XB_TMO])) break; if (_sp > XB_SPIN_CAP) { atomicAdd(&(bar)[XB_TMO], 1u); break; } } } } while (0)
DI void xcd_barrier_complete(unsigned* bar, unsigned x, unsigned G, unsigned& nloc, unsigned& nx) {
    unsigned sum, cnt, mine, sp = 0u;
    for (;;) {
        sum = 0u; cnt = 0u; mine = 0u;
#pragma unroll
        for (unsigned j = 0; j < 16; ++j) { const unsigned c = xb_ld(&bar[XB_XCNT(j)]); sum += c; cnt += (c > 0u) ? 1u : 0u; mine = (j == x) ? c : mine; }
        if (sum == G) break;
        __builtin_amdgcn_s_sleep(1);
        if ((++sp & 255u) == 0u) { if (xb_ld(&bar[XB_TMO])) break; if (sp > XB_SPIN_CAP) { atomicAdd(&bar[XB_TMO], 1u); break; } }
    }
    nloc = mine > 0u ? mine : 1u; nx = cnt > 0u ? cnt : 1u;
}
DI void xcd_barrier(unsigned* bar, volatile LAS unsigned* st, bool t0, unsigned G) {
    asm volatile("s_waitcnt vmcnt(0)" ::: "memory");
    __syncthreads();
    if (t0) {
        const unsigned x = xb_xcc_id();
        __builtin_amdgcn_s_waitcnt(0);
        unsigned nloc = st[0], nx = st[1];
        if (nloc == 0u) { xcd_barrier_complete(bar, x, G, nloc, nx); st[0] = nloc; st[1] = nx; }
        const unsigned old = xb_add(&bar[XB_XSUB(x)], 1u);
        const unsigned gen = old / nloc;
        if (old + 1u == (gen + 1u) * nloc) {
            __builtin_amdgcn_fence(__ATOMIC_RELEASE, "agent");
            asm volatile("s_waitcnt vmcnt(0)" ::: "memory");
            const unsigned og = xb_add(&bar[XB_TOP], 1u);
            const unsigned tg = og / nx;
            if (og + 1u == (tg + 1u) * nx) xb_add(&bar[XB_TOPGEN], 1u);
            else XB_SPIN(xb_ld(&bar[XB_TOPGEN]) == tg, bar);
            __builtin_amdgcn_fence(__ATOMIC_ACQUIRE, "agent");
            xb_add(&bar[XB_XGEN(x)], 1u);
            asm volatile("s_waitcnt vmcnt(0)" ::: "memory");
        } else {
            XB_SPIN(xb_ld(&bar[XB_XGEN(x)]) == gen, bar);
            __builtin_amdgcn_fence(__ATOMIC_ACQUIRE, "agent");
            asm volatile("s_waitcnt vmcnt(0)" ::: "memory");
        }
    }
    __syncthreads();
}

struct Args { const float* in[26]; float* out; unsigned char* ws; int ph_lo, ph_hi; };
constexpr int NPH = DEPTH * 11 + 1;

__global__ void __launch_bounds__(512, 2) mega_fwd(Args a) {
    extern __shared__ __attribute__((aligned(16))) unsigned char lds_raw[];
    LAS unsigned char* lds = (LAS unsigned char*)lds_raw;
    cg::grid_group grid = cg::this_grid();
    const int G = gridDim.x, bx = blockIdx.x;
    const int ph_lo = a.ph_lo, ph_hi = a.ph_hi;
    const int wave0 = __builtin_amdgcn_readfirstlane(threadIdx.x >> 6);
    {
        int ln0; asm volatile("v_mbcnt_lo_u32_b32 %0, -1, 0\n\tv_mbcnt_hi_u32_b32 %0, -1, %0" : "=v"(ln0));
        if (wave0 == 0 && ln0 == 0) {
            volatile LAS unsigned* xst = (volatile LAS unsigned*)(lds + LDS_XB); xst[0] = 0u; xst[1] = 0u;
            (void)xb_add(&((unsigned*)(a.ws + OFF_BAR))[XB_XCNT(xb_xcc_id())], 1u);
        }
        __syncthreads();
    }
#define PH_LOCALS \
    int lane_v; asm volatile("v_mbcnt_lo_u32_b32 %0, -1, 0\n\tv_mbcnt_hi_u32_b32 %0, -1, %0" : "=v"(lane_v)); int wave_s = wave0; asm volatile("" : "+s"(wave_s)); \
    const int lane = lane_v, wave = wave_s, tid = wave * 64 + lane; \
    const int gw = bx * 8 + wave, nw = G * 8; (void)gw; (void)nw; (void)lane; \
    const Args* ap = (const Args*)__builtin_amdgcn_kernarg_segment_ptr(); asm volatile("" : "+s"(ap)); \
    unsigned char* ws = as_global(ap->ws); float* X = as_global(ap->out); (void)X; \
    bf16_t* WIN = (bf16_t*)(ws + OFF_WIN); bf16_t* WUP = (bf16_t*)(ws + OFF_WUP); bf16_t* WDN = (bf16_t*)(ws + OFF_WDN); bf16_t* WOUT = (bf16_t*)(ws + OFF_WOUT); \
    bf16_t* WBR = (bf16_t*)(ws + OFF_WBR); bf16_t* WGLU = (bf16_t*)(ws + OFF_WGLU); bf16_t* WC1 = (bf16_t*)(ws + OFF_WC1); bf16_t* WC2 = (bf16_t*)(ws + OFF_WC2); \
    float* CB = (float*)(ws + OFF_CB); float* S5S = (float*)(ws + OFF_S5S); bf16_t* KC = (bf16_t*)(ws + OFF_KC); bf16_t* VCT = (bf16_t*)(ws + OFF_VCT); \
    float* ROPE = (float*)(ws + OFF_ROPE); \
    bf16_t* Hb = (bf16_t*)(ws + OFF_HY); bf16_t* YA = (bf16_t*)(ws + OFF_HY); bf16_t* YB = (bf16_t*)(ws + OFF_HY + YSZ); bf16_t* YC = (bf16_t*)(ws + OFF_HY + 2 * YSZ); \
    bf16_t* VT = YC; bf16_t* PROJ = (bf16_t*)(ws + OFF_PROJ); bf16_t* GG = (bf16_t*)(ws + OFF_G); bf16_t* MG = PROJ; bf16_t* HID = PROJ; \
    LAS unsigned char* wl = lds + wave * LDS_WAVE; \
    (void)WIN; (void)WUP; (void)WDN; (void)WOUT; (void)WBR; (void)WGLU; (void)WC1; (void)WC2; (void)CB; (void)S5S; (void)KC; (void)VCT; (void)ROPE; (void)Hb; (void)YA; (void)YB; (void)YC; (void)VT; (void)PROJ; (void)GG; (void)MG; (void)HID; (void)wl;

#define INP(k) as_global(ap->in[k])
#define PH_BEGIN(p) if (ph_lo <= (p) && (p) < ph_hi) { PH_LOCALS
#define PH_SYNC_CG do { asm volatile("s_waitcnt vmcnt(0)" ::: "memory"); __syncthreads(); if (wave0 == 0) { __builtin_amdgcn_fence(__ATOMIC_RELEASE, "agent"); asm volatile("s_waitcnt vmcnt(0)" ::: "memory"); } __syncthreads(); grid.sync(); if (wave0 == 0) { __builtin_amdgcn_fence(__ATOMIC_ACQUIRE, "agent"); asm volatile("s_waitcnt vmcnt(0)" ::: "memory"); } __syncthreads(); } while (0)
#define PH_SYNC_XCD do { int ln_; asm volatile("v_mbcnt_lo_u32_b32 %0, -1, 0\n\tv_mbcnt_hi_u32_b32 %0, -1, %0" : "=v"(ln_)); const Args* ap_ = (const Args*)__builtin_amdgcn_kernarg_segment_ptr(); asm volatile("" : "+s"(ap_)); \
    xcd_barrier((unsigned*)(ap_->ws + OFF_BAR), (volatile LAS unsigned*)(lds + LDS_XB), wave0 == 0 && ln_ == 0, (unsigned)G); } while (0)
#define PH_END(p) } if (ph_lo <= (p) && (p) + 1 < ph_hi) { PH_SYNC_XCD; }

    if (ph_hi - ph_lo > 1) grid.sync();
#pragma unroll 1
    for (int l = 0; l < DEPTH; ++l) {
        const int pb = l * 11;
        PH_BEGIN(pb + 0)
            LAS float* scr = (LAS float*)lds;
            for (int it = bx; it < 4294; it += G) {
                if (it >= 4292) {
                    const int j = it - 4292; const int hid = tid & 127, part = tid >> 7;
                    const float* pos = INP(4) + (size_t)(l * 2 + j) * 2048; const float* w1 = INP(5) + (size_t)(l * 2 + j) * 2048 * 128;
                    float s = 0.f;
                    for (int kk = part * 512; kk < part * 512 + 512; ++kk) s += pos[kk] * w1[(size_t)kk * 128 + hid];
                    scr[part * 128 + hid] = s;
                    __syncthreads();
                    if (tid < 128) CB[j * 128 + tid] = scr[tid] + scr[128 + tid] + scr[256 + tid] + scr[384 + tid];
                    __syncthreads();
                    continue;
                }
                int rr = it; const float* W; bf16_t* WT; int K, N, tn; bool remap = false;
                if (rr < 1408) { W = INP(3) + (size_t)l * 1024 * 5528; WT = WIN; K = 1024; N = 5528; tn = 88; remap = true; }
                else if ((rr -= 1408) < 1024) { W = INP(23) + (size_t)l * 1024 * 4096; WT = WUP; K = 1024; N = 4096; tn = 64; }
                else if ((rr -= 1024) < 1024) { W = INP(24) + (size_t)l * 4096 * 1024; WT = WDN; K = 4096; N = 1024; tn = 16; }
                else if ((rr -= 1024) < 256) { W = INP(21) + (size_t)l * 1024 * 1024; WT = WOUT; K = 1024; N = 1024; tn = 16; }
                else if ((rr -= 256) < 384) { const int br = rr / 128; rr %= 128; W = INP(18 + br) + (size_t)l * 512 * 1024; WT = WBR + (size_t)br * 1024 * 512; K = 512; N = 1024; tn = 16; }
                else if ((rr -= 384) < 64) { W = INP(16) + (size_t)l * 512 * 512; WT = WGLU; K = 512; N = 512; tn = 8; }
                else if ((rr -= 64) < 128) { const int j = rr / 64; rr %= 64; W = INP(5) + (size_t)(l * 2 + j) * 2048 * 128; WT = WC1 + (size_t)j * 128 * 2048; K = 2048; N = 128; tn = 2; }
                else { rr -= 128; const int j = rr / 2; rr %= 2; W = INP(6) + (size_t)(l * 2 + j) * 128 * 64; WT = WC2 + (size_t)j * 64 * 128; K = 128; N = 64; tn = 1; }
                const int k0 = (rr / tn) * 64, n0 = (rr % tn) * 64;
                {
                    const int tx = tid & 63, ty = tid >> 6; const int nn = n0 + tx; const int sc = remap ? in_srccol(nn) : nn;
#pragma unroll
                    for (int q = 0; q < 8; ++q) { const int k = k0 + ty * 8 + q; scr[(ty * 8 + q) * 65 + tx] = sc >= 0 ? W[(size_t)k * N + sc] : 0.f; }
                }
                __syncthreads();
                {
                    const int nn = tid >> 3, kc = (tid & 7) * 8;
                    f32x4 v0, v1;
#pragma unroll
                    for (int q = 0; q < 4; ++q) { v0[q] = scr[(kc + q) * 65 + nn]; v1[q] = scr[(kc + 4 + q) * 65 + nn]; }
                    *(u32x4*)(WT + (size_t)(n0 + nn) * K + k0 + kc) = pg8::pack8(v0, v1);
                }
                __syncthreads();
            }
            if (l == 0 && bx == 0 && tid < 64) ((unsigned*)(ws + OFF_CB + 2048))[tid] = 0u;
            if (l == 0) {
                const int* positions = (const int*)INP(1);
                for (int idx = bx * 512 + tid; idx < T * 32; idx += 131072) {
                    const int t = idx >> 5, i = idx & 31;
                    const float invf = exp2f(-(float)i * 0.41524101186092029f);
                    const float ang = (float)positions[t] * invf;
                    ROPE[2 * idx] = cosf(ang); ROPE[2 * idx + 1] = sinf(ang);
                }
                rmsnorm_rows<false>(INP(0), INP(2), Hb, nullptr, X, gw, nw, lane);
            } else {
                rmsnorm_rows<false>(X, INP(2) + (size_t)l * DM, Hb, nullptr, nullptr, gw, nw, lane);
            }
        PH_END(pb + 0)
        PH_BEGIN(pb + 1)
            pg8::Gemm g{Hb, WIN, T, NIN, DM, DM, 0, 0}; pg8::StaticOrder S; S.init(T, NIN, G, bx);
            pg8::EpiIn E{PROJ, GG};
            pg8::gemm_phase(lds, g, S, E, tid);
        PH_END(pb + 1)
        PH_BEGIN(pb + 2)
            { const int u = bx * 2 + (wave >> 2); compress_unit(PROJ, WC1, WC2, CB, ROPE, KC, VCT, u >> 8, (u >> 5) & 7, (u >> 4) & 1, u & 15, wave & 3, lds, wave, lane); }
            {
                LAS bf16_t* tile = (LAS bf16_t*)lds;
                for (int it = bx; it < 5 * 8 * 64; it += G) {
                    const int slot = it / 512, b = (it / 64) % 8, st = it % 64;
                    const int vcol = slot < 4 ? C_KVA + (1 + (slot >> 1)) * 256 + 128 + (slot & 1) * 64 : C_VB;
                    {
                        const int tok = tid >> 3, dc = (tid & 7) * 8;
                        const bf16x8 v = *(const bf16x8*)(PROJ + ((size_t)b * SEQ + st * 64 + tok) * PP + vcol + dc);
#pragma unroll
                        for (int j = 0; j < 8; ++j) tile[(dc + j) * 72 + perm16(tok)] = (bf16_t)v[j];
                    }
                    __syncthreads();
                    {
                        const int d = tid >> 3, tc = (tid & 7) * 8;
                        const bf16x8 v = *(const LAS bf16x8*)(tile + d * 72 + tc);
                        *(bf16x8*)(VT + (size_t)(slot * 8 + b) * 64 * SEQ + (size_t)(st * 4 + (tc >> 4)) * 1024 + d * 16 + (tc & 8)) = v;
                    }
                    __syncthreads();
                }
            }
            for (int idx = bx * 512 + tid; idx < T * 84; idx += 131072) {
                const int t = idx / 84, rem = idx % 84, head = rem >> 2, ch = rem & 3;
                int col;
                if (head < 8) col = C_QA + head * 64; else if (head < 12) { const int hh = head - 8; col = C_KVA + (1 + (hh >> 1)) * 256 + (hh & 1) * 64; }
                else if (head < 20) col = C_QB + (head - 12) * 64; else col = C_KB;
                bf16_t* p = PROJ + (size_t)t * PP + col + 8 * ch;
                f32x4 a0, a1, b0, b1; pg8::unpack8(*(const u32x4*)p, a0, a1); pg8::unpack8(*(const u32x4*)(p + 32), b0, b1);
                const float* cs = ROPE + ((size_t)t * 32 + 8 * ch) * 2;
                f32x4 o0, o1, q0, q1;
#pragma unroll
                for (int j = 0; j < 4; ++j) {
                    const float c0 = cs[2 * j], s0 = cs[2 * j + 1], c1 = cs[2 * (j + 4)], s1 = cs[2 * (j + 4) + 1];
                    o0[j] = a0[j] * c0 - b0[j] * s0; q0[j] = b0[j] * c0 + a0[j] * s0;
                    o1[j] = a1[j] * c1 - b1[j] * s1; q1[j] = b1[j] * c1 + a1[j] * s1;
                }
                *(u32x4*)p = pg8::pack8(o0, o1); *(u32x4*)(p + 32) = pg8::pack8(q0, q1);
            }
            {
                const S5In P{INP(8) + (size_t)l * 2048, INP(9) + (size_t)l * 2048, INP(10) + (size_t)l * 32, INP(11) + (size_t)l * 32768, INP(12) + (size_t)l * 32768,
                             INP(13) + (size_t)l * 32768, INP(14) + (size_t)l * 32768, INP(15) + (size_t)l * 512};
            }
        PH_END(pb + 2)
        PH_BEGIN(pb + 4)
            {
                const S5In P{INP(8) + (size_t)l * 2048, INP(9) + (size_t)l * 2048, INP(10) + (size_t)l * 32, INP(11) + (size_t)l * 32768, INP(12) + (size_t)l * 32768,
                             INP(13) + (size_t)l * 32768, INP(14) + (size_t)l * 32768, INP(15) + (size_t)l * 512};
                if (bx < 64 && wave < 4) s5_unit<true>(P, PROJ, S5S, bx >> 3, 4 * (bx & 7) + wave, 0, 128, wl, lane);
            }
            {
                unsigned* xbw = (unsigned*)(ws + OFF_BAR);
                const unsigned xme = xb_xcc_id(); unsigned rk = 0, nx = 0;
#pragma unroll
                for (unsigned j = 0; j < 16; ++j) { const unsigned c = xb_ld(&xbw[XB_XCNT(j)]); if (c) { rk += (j < xme) ? 1u : 0u; ++nx; } }
                rk = __builtin_amdgcn_readfirstlane(rk); nx = __builtin_amdgcn_readfirstlane(nx); if (nx == 0u) nx = 1u;
                const unsigned nbA = rk < 16u ? (16u - rk + nx - 1u) / nx : 0u, nbB = rk < 8u ? (8u - rk + nx - 1u) / nx : 0u;
                const unsigned totA = nbA * 256u, totB = nbB * 512u;
                unsigned* ctr = (unsigned*)(ws + OFF_CB + 2048) + l * 16 + rk;
                for (;;) {
                    unsigned i = 0;
                    if (lane == 0) i = atomicAdd(ctr, 1u);
                    i = __builtin_amdgcn_readfirstlane(i);
                    if (i >= totA + totB) break;
                    if (i < totA) {
                        const unsigned g8 = i >> 3, bl = g8 % nbA, q8 = g8 / nbA;
                        const int bh = (int)(rk + nx * bl), qt = (31 - (int)q8) * 8 + (int)(i & 7u);
                        attnA_unit(PROJ, KC, VCT, VT, YA, bh >> 1, bh & 1, qt * 16, wl, lane);
                    } else {
                        const unsigned u = i - totA; const int b = (int)(rk + nx * (u >> 9));
                        attnB_unit(PROJ, VT, INP(7) + (size_t)l * 8, YB, b, (int)(u & 511u) * 8, lane);
                    }
                }
            }
        PH_END(pb + 4)
        PH_BEGIN(pb + 5)
            pg8::Gemm g{PROJ + C_U, WGLU, T, 512, 512, PP, 0, 0}; pg8::StaticOrder S; S.init(T, 512, G, bx);
            pg8::EpiGlu E{PROJ + C_U, INP(17) + (size_t)l * 512, YC};
            pg8::gemm_phase(lds, g, S, E, tid);
        PH_END(pb + 5)
        PH_BEGIN(pb + 6)
            pg8::Gemm g{YA, WBR, T, DM, 512, 512, YSZ, (size_t)DM * 512 * 2}; pg8::Z3Order S; S.init(T, DM, G, bx);
            pg8::EpiMerge E{GG, MG};
            pg8::gemm_phase(lds, g, S, E, tid);
        PH_END(pb + 6)
        PH_BEGIN(pb + 7)
            pg8::Gemm g{MG, WOUT, T, DM, DM, DM, 0, 0}; pg8::StaticOrder S; S.init(T, DM, G, bx);
            pg8::EpiResid E{X};
            pg8::gemm_phase(lds, g, S, E, tid);
        PH_END(pb + 7)
        PH_BEGIN(pb + 8)
            rmsnorm_rows<false>(X, INP(22) + (size_t)l * DM, Hb, nullptr, nullptr, gw, nw, lane);
        PH_END(pb + 8)
        PH_BEGIN(pb + 9)
            pg8::Gemm g{Hb, WUP, T, DFF, DM, DM, 0, 0}; pg8::StaticOrder S; S.init(T, DFF, G, bx);
            pg8::EpiUp E{HID};
            pg8::gemm_phase(lds, g, S, E, tid);
        PH_END(pb + 9)
        PH_BEGIN(pb + 10)
            pg8::Gemm g{HID, WDN, T, DM, DFF, DFF, 0, 0}; pg8::StaticOrder S; S.init(T, DM, G, bx);
            pg8::EpiResid E{X};
            pg8::gemm_phase(lds, g, S, E, tid);
        PH_END(pb + 10)
    }
    PH_BEGIN(NPH - 1)
        rmsnorm_rows<true>(X, INP(25), nullptr, X, nullptr, gw, nw, lane);
    }
}

extern "C" void kernel_launch(void* const* d_in, const int* in_sizes, int n_in, void* d_out, int out_size, void* d_ws, size_t ws_size, hipStream_t stream) {
    static int ready = 0;
    if (ready == 0) {
        if (n_in != 26 || out_size != T * DM || ws_size < WS_END + BAR_BYTES) { fprintf(stderr, "kernel_launch: unexpected shapes (n_in %d out %d ws %zu need %zu)\n", n_in, out_size, ws_size, (size_t)WS_END); ready = -1; return; }
        if (hipFuncSetAttribute((const void*)mega_fwd, hipFuncAttributeMaxDynamicSharedMemorySize, LDS_BYTES) != hipSuccess) { fprintf(stderr, "kernel_launch: hipFuncSetAttribute failed\n"); ready = -1; return; }
        ready = 1;
    }
    if (ready < 0) return;
#ifdef DBG_MEMSET
    hipMemsetAsync(d_ws, 0xAA, WS_END, stream); hipMemsetAsync(d_out, 0xAA, (size_t)T * DM * 4, stream);
#endif
    if (hipMemsetAsync((unsigned char*)d_ws + OFF_BAR, 0, BAR_BYTES, stream) != hipSuccess) { fprintf(stderr, "kernel_launch: barrier memset failed\n"); return; }
    Args a{};
    for (int i = 0; i < 26; ++i) a.in[i] = (const float*)d_in[i];
    a.out = (float*)d_out; a.ws = (unsigned char*)d_ws;
#if MK_MULTI
    for (int p = 0; p < NPH; ++p) { a.ph_lo = p; a.ph_hi = p + 1; hipLaunchKernelGGL(mega_fwd, dim3(256), dim3(512), LDS_BYTES, stream, a); }
#else
    a.ph_lo = 0; a.ph_hi = NPH;
    void* args[] = {&a};
    hipError_t e = hipLaunchCooperativeKernel((const void*)mega_fwd, dim3(256), dim3(512), args, LDS_BYTES, stream);
    if (e != hipSuccess) fprintf(stderr, "cooperative launch failed: %s\n", hipGetErrorString(e));
#endif
}
```

```cpp
#include <hip/hip_runtime.h>
#include <hip/hip_cooperative_groups.h>
#include <cstdio>
#include <cstdint>
namespace cg = cooperative_groups;

typedef unsigned short bf16_t;
typedef short bf16x8 __attribute__((ext_vector_type(8)));
typedef short s16x4 __attribute__((ext_vector_type(4)));
typedef float f32x4 __attribute__((ext_vector_type(4)));
typedef float f32x16 __attribute__((ext_vector_type(16)));
typedef unsigned u32x4 __attribute__((ext_vector_type(4)));
typedef unsigned u32x2 __attribute__((ext_vector_type(2)));
typedef __bf16 bf16x2_t __attribute__((ext_vector_type(2)));
typedef float f32x2_t __attribute__((ext_vector_type(2)));
#define LAS __attribute__((address_space(3)))
#define DI __device__ __forceinline__

#ifndef MK_MULTI
#define MK_MULTI 0
#endif
#ifndef DBG_MASK
#define DBG_MASK 7
#endif

constexpr int T = 32768, SEQ = 4096, NBATCH = 8, DM = 1024, PP = 2560, NGM = 3072, NIN = 5632, DFF = 4096, DEPTH = 4;
constexpr int C_QA = 0, C_KVA = 512, C_QB = 1280, C_KB = 1792, C_VB = 1856, C_U = 1920, C_GA = 2432;
constexpr float NORM_EPS = 1e-6f;
constexpr float SC2 = 0.125f * 1.4426950408889634f;
constexpr float LOG2E = 1.4426950408889634f;

constexpr size_t OFF_WIN = 0;
constexpr size_t OFF_WUP = OFF_WIN + (size_t)NIN * DM * 2;
constexpr size_t OFF_WDN = OFF_WUP + (size_t)DFF * DM * 2;
constexpr size_t OFF_WOUT = OFF_WDN + (size_t)DFF * DM * 2;
constexpr size_t OFF_WBR = OFF_WOUT + (size_t)DM * DM * 2;
constexpr size_t OFF_WGLU = OFF_WBR + (size_t)3 * DM * 512 * 2;
constexpr size_t OFF_WC1 = OFF_WGLU + (size_t)512 * 512 * 2;
constexpr size_t OFF_WC2 = OFF_WC1 + (size_t)2 * 128 * 2048 * 2;
constexpr size_t OFF_CB = OFF_WC2 + (size_t)2 * 64 * 128 * 2;
constexpr size_t OFF_S5S = OFF_CB + 4096;
constexpr size_t OFF_KC = OFF_S5S + (size_t)8 * 32 * 8 * 64 * 8;
constexpr size_t OFF_VCT = OFF_KC + (size_t)8 * 2 * 256 * 64 * 2;
constexpr size_t OFF_ROPE = OFF_VCT + (size_t)8 * 2 * 256 * 64 * 2;
constexpr size_t OFF_HY = OFF_ROPE + (size_t)T * 32 * 8;
constexpr size_t YSZ = (size_t)T * 512 * 2;
constexpr size_t OFF_PROJ = OFF_HY + 3 * YSZ;
constexpr size_t OFF_G = OFF_PROJ + (size_t)T * PP * 2;
constexpr size_t WS_END = OFF_G + (size_t)T * NGM * 2;
constexpr size_t OFF_BAR = WS_END;
constexpr size_t BAR_BYTES = 3456 * 4;
static_assert(WS_END + BAR_BYTES <= (size_t)512 * 1024 * 1024, "workspace too large");
static_assert((size_t)T * DFF * 2 <= WS_END - OFF_PROJ, "hidden overlay");
constexpr int LDS_WAVE = 18688;
constexpr int LDS_XB = 8 * LDS_WAVE;
constexpr int LDS_BYTES = 8 * LDS_WAVE + 16;

template <class Tp> DI Tp* as_global(Tp* p) { return p; }
DI float bf2f(bf16_t v) { return __uint_as_float((unsigned)v << 16); }
DI unsigned pk2(float lo, float hi) { f32x2_t v = {lo, hi}; bf16x2_t b = __builtin_convertvector(v, bf16x2_t); return __builtin_bit_cast(unsigned, b); }
DI float sigmoidf_(float x) { return __builtin_amdgcn_rcpf(1.0f + __expf(-x)); }
DI float gelu_tanh(float x) { const float u = 0.7978845608028654f * (x + 0.044715f * x * x * x); const float e = __expf(2.0f * u); const float th = 1.0f - 2.0f * __builtin_amdgcn_rcpf(e + 1.0f); return 0.5f * x * (1.0f + th); }
DI int perm16(int x) { return (x & ~12) | ((x & 4) << 1) | ((x & 8) >> 1); }
DI int crow(int reg, int h) { return (reg & 3) + 8 * (reg >> 2) + 4 * h; }
DI float shx(float v, int m, int lane) { return __int_as_float(__builtin_amdgcn_ds_bpermute((lane ^ m) << 2, __float_as_int(v))); }
typedef unsigned u32x2s __attribute__((ext_vector_type(2)));
DI float xmax32(float v) { const u32x2s r = __builtin_amdgcn_permlane32_swap(__float_as_uint(v), __float_as_uint(v), false, false); return fmaxf(__uint_as_float(r[0]), __uint_as_float(r[1])); }
DI float xsum32(float v) { const u32x2s r = __builtin_amdgcn_permlane32_swap(__float_as_uint(v), __float_as_uint(v), false, false); return __uint_as_float(r[0]) + __uint_as_float(r[1]); }
DI float wave_sum(float v, int lane) {
#pragma unroll
    for (int o = 32; o >= 1; o >>= 1) v += shx(v, o, lane);
    return v;
}
#define MFMA32(a, b, c) __builtin_amdgcn_mfma_f32_32x32x16_bf16((a), (b), (c), 0, 0, 0)
#define MFMA16(a, b, c) __builtin_amdgcn_mfma_f32_16x16x32_bf16((a), (b), (c), 0, 0, 0)

namespace pg8 {
constexpr int BM = 256, BK = 64, HALF = 128, HTB = HALF * BK * 2, STAGE_BYTES = 8 * HTB, NXCD = 8, WGM = 8;
__host__ __device__ __forceinline__ int lds_byte(int r, int c) { const int st = (r >> 4) * 2 + (c >> 5), rr = r & 15, cc = c & 31, ob = rr * 64 + cc * 2; return st * 1024 + (ob ^ (((ob >> 9) & 1) << 5)); }
__host__ __device__ __forceinline__ void stage_rc(int b, int& R, int& C) { const int st = b / 1024, sb = b % 1024, swz = sb ^ (((sb >> 9) & 1) << 5); R = (st >> 1) * 16 + swz / 64; C = (st & 1) * 32 + (swz % 64) / 2; }
__host__ __device__ __forceinline__ int perm32(int rho) { const int n = rho >> 4, i = rho & 15; return 8 * (i >> 2) + 4 * n + (i & 3); }

struct Unit { int pm, pn, z; };
struct Gemm { const bf16_t* A; const bf16_t* Bt; int M, N, K, lda; size_t zA, zB; };

DI void tile_of(int wgid, int nwg, int nM, int nN, int& pm, int& pn) {
    { const int q = nwg / NXCD, r = nwg % NXCD, xcd = wgid % NXCD, off = wgid / NXCD; wgid = (xcd < r ? xcd * (q + 1) : r * (q + 1) + (xcd - r) * q) + off; }
    const int nig = WGM * nN, gid = wgid / nig, fm = gid * WGM, gsz = (nM - fm) < WGM ? (nM - fm) : WGM;
    pm = fm + ((wgid % nig) % gsz); pn = (wgid % nig) / gsz;
}
struct StaticOrder {
    int nM, nN, nwg, G, c;
    DI void init(int M, int N, int G_, int c_) { nM = M / BM; nN = N / BM; nwg = nM * nN; G = G_; c = c_; }
    DI bool next(int i, Unit& u) const { const long L = (long)i * G + c; if (L >= nwg) return false; tile_of((int)L, nwg, nM, nN, u.pm, u.pn); u.z = 0; return true; }
};
struct Z3Order {
    int nM, nN, nwg, G, c;
    DI void init(int M, int N, int G_, int c_) { nM = M / BM; nN = N / BM; nwg = nM * nN; G = G_; c = c_; }
    DI bool next(int i, Unit& u) const { const long L = (long)(i / 3) * G + c; if (L >= nwg) return false; tile_of((int)L, nwg, nM, nN, u.pm, u.pn); u.z = i % 3; return true; }
};

template <class Epi, class Sched>
DI void gemm_phase(LAS unsigned char* lds, const Gemm g, const Sched& S, const Epi& E, int tid_l) {
    asm volatile("" : "+v"(tid_l));
    const int tid = tid_l, wid = __builtin_amdgcn_readfirstlane(tid >> 6), lane = tid & 63, wr = wid >> 2, wc = wid & 3, fr = lane & 15, fq = lane >> 4;
    const int K = g.K, nt = K / BK;
    unsigned voffA[2], voffB[2];
#pragma unroll
    for (int i = 0; i < 2; ++i) { int R, C; stage_rc(tid * 16 + i * 8192, R, C); const int Rb = (R & ~31) + perm32(R & 31);
        voffA[i] = (unsigned)(R * g.lda + C) * 2u; voffB[i] = (unsigned)(Rb * K + C) * 2u; }
    const size_t kstep = (size_t)(BK * 2);
    const size_t hstepA = (size_t)HALF * g.lda * 2, hstepB = (size_t)HALF * K * 2;
    const size_t tstepA = 2 * hstepA, tstepB = 2 * hstepB;
    const unsigned ldsw = (unsigned)wid * 1024u;
    const int aoff = lds_byte(wr * 64 + fr, fq * 8), boff = lds_byte(wc * 32 + fr, fq * 8);
#define PG8_SA(b, h) (((b) * 2 + (h)) * HTB)
#define PG8_SB(b, h) ((4 + (b) * 2 + (h)) * HTB)
#define PG8_STAGE(bufoff, gbase, voff) do { _Pragma("unroll") for (int _i = 0; _i < 2; ++_i) \
        __builtin_amdgcn_global_load_lds((const unsigned*)((const char*)(gbase) + (voff)[_i]), (LAS unsigned*)(lds + (bufoff) + ldsw + _i * 8192), 16, 0, 0); } while (0)
#define PG8_LDA(dst, b, h) do { _Pragma("unroll") for (int m = 0; m < 4; ++m) _Pragma("unroll") for (int k = 0; k < 2; ++k) dst[m][k] = *(const LAS bf16x8*)(lds + PG8_SA(b, h) + aoff + m * 2048 + k * 1024); } while (0)
#define PG8_LDB(dst, b, h) do { _Pragma("unroll") for (int n = 0; n < 2; ++n) _Pragma("unroll") for (int k = 0; k < 2; ++k) dst[n][k] = *(const LAS bf16x8*)(lds + PG8_SB(b, h) + boff + n * 2048 + k * 1024); } while (0)
#define PG8_MMA(ai, bj, At, Bt) do { __builtin_amdgcn_s_setprio(1); _Pragma("unroll") for (int m = 0; m < 4; ++m) _Pragma("unroll") for (int n = 0; n < 2; ++n) _Pragma("unroll") for (int k = 0; k < 2; ++k) \
        acc[ai][bj][m][n] = __builtin_amdgcn_mfma_f32_16x16x32_bf16(Bt[n][k], At[m][k], acc[ai][bj][m][n], 0, 0, 0); __builtin_amdgcn_s_setprio(0); } while (0)
#define PG8_WAIT_V(n) asm volatile("s_waitcnt vmcnt(" #n ")" ::: "memory")
#define PG8_WAIT_L(n) asm volatile("s_waitcnt lgkmcnt(" #n ")" ::: "memory")
#define PG8_BAR __builtin_amdgcn_s_barrier()
#define PG8_SCHED __builtin_amdgcn_sched_barrier(0)
    Unit cur, nxt; int ui = 0;
    if (!S.next(0, cur)) return;
    f32x4 acc[2][2][4][2];
#pragma unroll
    for (int a = 0; a < 2; ++a)
#pragma unroll
        for (int b = 0; b < 2; ++b)
#pragma unroll
            for (int m = 0; m < 4; ++m)
#pragma unroll
                for (int n = 0; n < 2; ++n) acc[a][b][m][n] = (f32x4){0.f, 0.f, 0.f, 0.f};
    bf16x8 At[4][2], B0[2][2], B1[2][2];
    const char* cA = (const char*)g.A + (size_t)cur.z * g.zA + (size_t)cur.pm * tstepA; const char* cB = (const char*)g.Bt + (size_t)cur.z * g.zB + (size_t)cur.pn * tstepB;
    PG8_STAGE(PG8_SB(0, 0), cB, voffB); PG8_STAGE(PG8_SB(0, 1), cB + hstepB, voffB); PG8_STAGE(PG8_SA(0, 0), cA, voffA); PG8_STAGE(PG8_SA(0, 1), cA + hstepA, voffA);
    if (wr == 1) PG8_BAR;
    PG8_WAIT_V(2); PG8_BAR;
    PG8_STAGE(PG8_SB(1, 0), cB + kstep, voffB); PG8_STAGE(PG8_SA(1, 0), cA + kstep, voffA); PG8_STAGE(PG8_SB(1, 1), cB + hstepB + kstep, voffB);
    PG8_WAIT_V(6); PG8_BAR;
    for (;;) {
        const bool has_next = S.next(ui + 1, nxt);
        const char* nA = has_next ? (const char*)g.A + (size_t)nxt.z * g.zA + (size_t)nxt.pm * tstepA : cA; const char* nB = has_next ? (const char*)g.Bt + (size_t)nxt.z * g.zB + (size_t)nxt.pn * tstepB : cB;
        for (int t = 0; t < nt; t += 2) {
            const bool last = (t == nt - 2);
            const char* a1 = cA + (size_t)(t + 1) * kstep;
            const char* a2 = last ? nA : cA + (size_t)(t + 2) * kstep; const char* b2 = last ? nB : cB + (size_t)(t + 2) * kstep;
            const char* a3 = a2 + kstep; const char* b3 = b2 + kstep;
            PG8_LDB(B0, 0, 0); PG8_LDB(B1, 0, 1); PG8_SCHED; PG8_LDA(At, 0, 0); PG8_STAGE(PG8_SA(1, 1), a1 + hstepA, voffA);
            PG8_WAIT_V(8); PG8_WAIT_L(0); PG8_BAR; PG8_MMA(0, 0, At, B0); PG8_MMA(0, 1, At, B1); PG8_BAR; PG8_SCHED;
            PG8_LDA(At, 0, 1); PG8_STAGE(PG8_SB(0, 0), b2, voffB); PG8_STAGE(PG8_SB(0, 1), b2 + hstepB, voffB); PG8_STAGE(PG8_SA(0, 0), a2, voffA);
            PG8_WAIT_V(8); PG8_WAIT_L(0); PG8_BAR; PG8_MMA(1, 0, At, B0); PG8_MMA(1, 1, At, B1); PG8_BAR; PG8_SCHED;
            PG8_LDB(B0, 1, 0); PG8_LDB(B1, 1, 1); PG8_SCHED; PG8_LDA(At, 1, 0); PG8_STAGE(PG8_SA(0, 1), a2 + hstepA, voffA);
            PG8_WAIT_V(8); PG8_WAIT_L(0); PG8_BAR; PG8_MMA(0, 0, At, B0); PG8_MMA(0, 1, At, B1); PG8_BAR; PG8_SCHED;
            PG8_LDA(At, 1, 1); PG8_STAGE(PG8_SB(1, 0), b3, voffB); PG8_STAGE(PG8_SB(1, 1), b3 + hstepB, voffB); PG8_STAGE(PG8_SA(1, 0), a3, voffA);
            PG8_WAIT_V(8); PG8_WAIT_L(0); PG8_BAR; PG8_MMA(1, 0, At, B0); PG8_MMA(1, 1, At, B1); PG8_BAR; PG8_SCHED;
        }
        if (wr == 0) PG8_BAR;
        E(acc, cur, wr, wc, fr, fq);
        if (!has_next) break;
#pragma unroll
        for (int a = 0; a < 2; ++a)
#pragma unroll
            for (int b = 0; b < 2; ++b)
#pragma unroll
                for (int m = 0; m < 4; ++m)
#pragma unroll
                    for (int n = 0; n < 2; ++n) acc[a][b][m][n] = (f32x4){0.f, 0.f, 0.f, 0.f};
        cur = nxt; cA = nA; cB = nB; ++ui;
        if (wr == 1) PG8_BAR;
    }
    PG8_WAIT_V(0);
    PG8_BAR;
#undef PG8_SA
#undef PG8_SB
#undef PG8_STAGE
#undef PG8_LDA
#undef PG8_LDB
#undef PG8_MMA
#undef PG8_WAIT_V
#undef PG8_WAIT_L
#undef PG8_BAR
#undef PG8_SCHED
}

#define EPI_LOOP_BEGIN \
    const int row0 = u.pm * BM + wr * 64 + fr; \
    _Pragma("unroll") for (int ai = 0; ai < 2; ++ai) _Pragma("unroll") for (int m = 0; m < 4; ++m) { const size_t row = (size_t)(row0 + ai * HALF + m * 16); \
    _Pragma("unroll") for (int bj = 0; bj < 2; ++bj) { const int col = u.pn * BM + bj * HALF + wc * 32 + 8 * fq; f32x4 v0 = acc[ai][bj][m][0], v1 = acc[ai][bj][m][1];
#define EPI_LOOP_END } }
DI u32x4 pack8(f32x4 v0, f32x4 v1) { u32x4 w; w.x = pk2(v0[0], v0[1]); w.y = pk2(v0[2], v0[3]); w.z = pk2(v1[0], v1[1]); w.w = pk2(v1[2], v1[3]); return w; }
DI void unpack8(u32x4 w, f32x4& a, f32x4& b) {
    a[0] = __uint_as_float(w.x << 16); a[1] = __uint_as_float(w.x & 0xffff0000u); a[2] = __uint_as_float(w.y << 16); a[3] = __uint_as_float(w.y & 0xffff0000u);
    b[0] = __uint_as_float(w.z << 16); b[1] = __uint_as_float(w.z & 0xffff0000u); b[2] = __uint_as_float(w.w << 16); b[3] = __uint_as_float(w.w & 0xffff0000u);
}
struct EpiIn {
    bf16_t* proj; bf16_t* G;
    DI void operator()(const f32x4 (&acc)[2][2][4][2], const Unit& u, int wr, int wc, int fr, int fq) const {
        EPI_LOOP_BEGIN
            if (col >= C_GA) {
#pragma unroll
                for (int j = 0; j < 4; ++j) { v0[j] = sigmoidf_(v0[j]); v1[j] = sigmoidf_(v1[j]); }
            }
            bf16_t* dst = (col < PP) ? proj + row * PP + col : G + row * NGM + (col - PP);
            *(u32x4*)dst = pack8(v0, v1);
        EPI_LOOP_END
    }
};
struct EpiGlu {
    const bf16_t* z; const float* bias; bf16_t* yc;
    DI void operator()(const f32x4 (&acc)[2][2][4][2], const Unit& u, int wr, int wc, int fr, int fq) const {
        const int row0 = u.pm * BM + wr * 64 + fr; const int colb = u.pn * BM + wc * 32 + 8 * fq;
        f32x4 b0[2], b1[2];
#pragma unroll
        for (int bj = 0; bj < 2; ++bj) { b0[bj] = *(const f32x4*)(bias + colb + bj * HALF); b1[bj] = *(const f32x4*)(bias + colb + bj * HALF + 4); }
#pragma unroll
        for (int ai = 0; ai < 2; ++ai) {
            u32x4 zq[4][2];
#pragma unroll
            for (int m = 0; m < 4; ++m)
#pragma unroll
                for (int bj = 0; bj < 2; ++bj) zq[m][bj] = *(const u32x4*)(z + (size_t)(row0 + ai * HALF + m * 16) * PP + colb + bj * HALF);
#pragma unroll
            for (int m = 0; m < 4; ++m)
#pragma unroll
                for (int bj = 0; bj < 2; ++bj) {
                    f32x4 z0, z1; unpack8(zq[m][bj], z0, z1); f32x4 v0 = acc[ai][bj][m][0], v1 = acc[ai][bj][m][1];
#pragma unroll
                    for (int j = 0; j < 4; ++j) { v0[j] = z0[j] * sigmoidf_(v0[j] + b0[bj][j]); v1[j] = z1[j] * sigmoidf_(v1[j] + b1[bj][j]); }
                    *(u32x4*)(yc + (size_t)(row0 + ai * HALF + m * 16) * 512 + colb + bj * HALF) = pack8(v0, v1);
                }
        }
    }
};
struct EpiMerge {
    const bf16_t* G; bf16_t* mg;
    DI void operator()(const f32x4 (&acc)[2][2][4][2], const Unit& u, int wr, int wc, int fr, int fq) const {
        const int row0 = u.pm * BM + wr * 64 + fr; const int colb = u.pn * BM + wc * 32 + 8 * fq;
#pragma unroll
        for (int ai = 0; ai < 2; ++ai) {
            u32x4 gq[4][2], pq[4][2];
#pragma unroll
            for (int m = 0; m < 4; ++m)
#pragma unroll
                for (int bj = 0; bj < 2; ++bj) {
                    const size_t row = (size_t)(row0 + ai * HALF + m * 16); const int col = colb + bj * HALF;
                    gq[m][bj] = *(const u32x4*)(G + row * NGM + u.z * DM + col);
                    pq[m][bj] = (u.z > 0) ? *(const u32x4*)(mg + row * DM + col) : (u32x4){0u, 0u, 0u, 0u};
                }
#pragma unroll
            for (int m = 0; m < 4; ++m)
#pragma unroll
                for (int bj = 0; bj < 2; ++bj) {
                    const size_t row = (size_t)(row0 + ai * HALF + m * 16); const int col = colb + bj * HALF;
                    f32x4 g0, g1, p0, p1; unpack8(gq[m][bj], g0, g1); unpack8(pq[m][bj], p0, p1);
                    const f32x4 v0 = acc[ai][bj][m][0] * g0 + p0, v1 = acc[ai][bj][m][1] * g1 + p1;
                    *(u32x4*)(mg + row * DM + col) = pack8(v0, v1);
                }
        }
    }
};
struct EpiResid {
    float* x;
    DI void operator()(const f32x4 (&acc)[2][2][4][2], const Unit& u, int wr, int wc, int fr, int fq) const {
        const int row0 = u.pm * BM + wr * 64 + fr; const int colb = u.pn * BM + wc * 32 + 8 * fq;
#pragma unroll
        for (int ai = 0; ai < 2; ++ai) {
            f32x4 xa[4][2], xb[4][2];
#pragma unroll
            for (int m = 0; m < 4; ++m)
#pragma unroll
                for (int bj = 0; bj < 2; ++bj) {
                    const float* p = x + (size_t)(row0 + ai * HALF + m * 16) * DM + colb + bj * HALF;
                    xa[m][bj] = *(const f32x4*)p; xb[m][bj] = *(const f32x4*)(p + 4);
                }
#pragma unroll
            for (int m = 0; m < 4; ++m)
#pragma unroll
                for (int bj = 0; bj < 2; ++bj) {
                    float* p = x + (size_t)(row0 + ai * HALF + m * 16) * DM + colb + bj * HALF;
                    *(f32x4*)p = xa[m][bj] + acc[ai][bj][m][0]; *(f32x4*)(p + 4) = xb[m][bj] + acc[ai][bj][m][1];
                }
        }
    }
};
struct EpiUp {
    bf16_t* hid;
    DI void operator()(const f32x4 (&acc)[2][2][4][2], const Unit& u, int wr, int wc, int fr, int fq) const {
        EPI_LOOP_BEGIN
#pragma unroll
            for (int j = 0; j < 4; ++j) { const float a = fmaxf(v0[j], 0.f), b = fmaxf(v1[j], 0.f); v0[j] = a * a; v1[j] = b * b; }
            *(u32x4*)(hid + row * DFF + col) = pack8(v0, v1);
        EPI_LOOP_END
    }
};
}

enum { MODE_WIN = 0, MODE_CMP = 1, MODE_SEL = 2 };
template <int MODE>
DI void fa_tile(f32x16 (&o)[2][2], float (&m)[2], float (&ls)[2], const bf16x8 (&qf)[2][4],
                bf16x8 (&kf)[4], const bf16_t* knext, const bf16_t* VTb, int vpitch, int vks, int kbase, int r, int h,
                const int (&qpos)[2], int W, bool rs0, bool rs1, int qlo, int qhi) {
    bool fullw;
    if (MODE == MODE_WIN) fullw = (kbase + 31 <= qlo) && (kbase > qhi - W);
    else if (MODE == MODE_CMP) fullw = (16 * (kbase + 31) + 31 <= qlo);
    else fullw = (kbase + 31 <= qlo) && (__builtin_amdgcn_ballot_w64(rs0 && rs1) == ~0ull);
    bf16x8 vf[2][2];
#pragma unroll
    for (int dt = 0; dt < 2; ++dt)
#pragma unroll
        for (int s = 0; s < 2; ++s) {
            vf[dt][s] = *(const bf16x8*)(VTb + (size_t)(32 * dt + r) * vpitch + (size_t)(kbase + 16 * s) * vks + 8 * h);
        }
#pragma unroll
    for (int rt = 0; rt < 2; ++rt) {
        f32x16 st;
#pragma unroll
        for (int i = 0; i < 16; ++i) st[i] = 0.f;
#pragma unroll
        for (int ks = 0; ks < 4; ++ks) st = MFMA32(kf[ks], qf[rt][ks], st);
        if (rt == 1) {
#pragma unroll
            for (int ks = 0; ks < 4; ++ks) kf[ks] = *(const bf16x8*)(knext + 16 * ks);
        }
        const int qp = qpos[rt]; const bool rs = rt == 0 ? rs0 : rs1;
        if (!fullw) {
#pragma unroll
            for (int i = 0; i < 16; ++i) {
                const int kpos = kbase + crow(i, h);
                bool valid;
                if (MODE == MODE_WIN) valid = (kpos <= qp) && (kpos > qp - W);
                else if (MODE == MODE_CMP) valid = (16 * kpos + 31 <= qp);
                else valid = rs && (kpos <= qp);
                st[i] = valid ? st[i] : -INFINITY;
            }
        }
        float mx = st[0];
#pragma unroll
        for (int i = 1; i < 16; ++i) mx = fmaxf(mx, st[i]);
        mx = xmax32(mx);
        const float cand = fmaxf(m[rt], mx * SC2);
        if (__builtin_amdgcn_ballot_w64((cand - m[rt]) > 8.0f) != 0ull) {
            const float alpha = __builtin_amdgcn_exp2f(m[rt] - cand);
            m[rt] = cand; ls[rt] *= alpha;
#pragma unroll
            for (int dt = 0; dt < 2; ++dt)
#pragma unroll
                for (int i = 0; i < 16; ++i) o[rt][dt][i] *= alpha;
        }
        const float mref = m[rt];
        float sum = 0.f;
#pragma unroll
        for (int i = 0; i < 16; ++i) { const float p = __builtin_amdgcn_exp2f(__builtin_fmaf(st[i], SC2, -mref)); st[i] = p; sum += p; }
        ls[rt] += sum;
        bf16x8 pf[2];
#pragma unroll
        for (int s = 0; s < 2; ++s) {
            u32x4 w; w.x = pk2(st[8 * s + 0], st[8 * s + 1]); w.y = pk2(st[8 * s + 2], st[8 * s + 3]); w.z = pk2(st[8 * s + 4], st[8 * s + 5]); w.w = pk2(st[8 * s + 6], st[8 * s + 7]);
            pf[s] = __builtin_bit_cast(bf16x8, w);
        }
#pragma unroll
        for (int dt = 0; dt < 2; ++dt)
#pragma unroll
            for (int s = 0; s < 2; ++s) o[rt][dt] = MFMA32(vf[dt][s], pf[s], o[rt][dt]);
    }
}
DI void kf_load(bf16x8 (&kf)[4], const bf16_t* kp) {
#pragma unroll
    for (int ks = 0; ks < 4; ++ks) kf[ks] = *(const bf16x8*)(kp + 16 * ks);
}
DI void fa_zero(f32x16 (&o)[2][2]) {
#pragma unroll
    for (int a = 0; a < 2; ++a)
#pragma unroll
        for (int b = 0; b < 2; ++b)
#pragma unroll
            for (int i = 0; i < 16; ++i) o[a][b][i] = 0.f;
}

DI unsigned long long topk_mask(float impv, int lane, int cur) {
    const bool valid = lane <= cur; const bool forced = (lane == 0) | (lane == cur) | (lane == cur - 1);
    if (cur + 1 <= 16) return __ballot(valid);
    const unsigned key = valid ? (forced ? 0x7f000000u : (__float_as_uint(fmaxf(impv, 0.f)) + 1u)) : 0u;
    unsigned t = 0;
    for (int bit = 30; bit >= 0; --bit) {
        const unsigned cand = t | (1u << bit);
        const int cnt = __popcll(__ballot(key >= cand));
        if (cnt >= 16) t = cand;
    }
    const unsigned long long gt = __ballot(key > t), eq = __ballot(key == t);
    const int need = 16 - __popcll(gt);
    const int below = __popcll(eq & ((1ull << lane) - 1ull));
    const bool sel = (key > t) || ((key == t) && (below < need));
    return __ballot(sel);
}

DI void attnA_unit(const bf16_t* proj, const bf16_t* kc, const bf16_t* vct, const bf16_t* VT, bf16_t* ya,
                   int b, int hkv, int q0, LAS unsigned char* wl, int lane) {
    asm volatile("" : "+v"(lane));
    int r = lane & 31, h = lane >> 5;
#define RELAUNDER() do { asm volatile("" : "+v"(lane)); r = lane & 31; h = lane >> 5; } while (0)
    const size_t tokbase = (size_t)b * SEQ;
    LAS float* ytot = (LAS float*)wl;
    LAS float* impscr = (LAS float*)(wl + 16384);
    LAS unsigned* mskscr = (LAS unsigned*)(wl + 16384 + 2048);
    int qpos[2]; bf16x8 qf[2][4];
#pragma unroll
    for (int rt = 0; rt < 2; ++rt) {
        const int R = 32 * rt + r, qi = R >> 2, gi = R & 3; qpos[rt] = q0 + qi;
        const bf16_t* qp = proj + (tokbase + qpos[rt]) * PP + C_QA + (hkv * 4 + gi) * 64 + 8 * h;
#pragma unroll
        for (int ks = 0; ks < 4; ++ks) qf[rt][ks] = *(const bf16x8*)(qp + 16 * ks);
    }
    f32x16 o[2][2]; float m[2], ls[2];
    const bf16_t* Kc = kc + (size_t)(b * 2 + hkv) * 256 * 64; const bf16_t* Vc = vct + (size_t)(b * 2 + hkv) * 64 * 256;
    const int nmax = (q0 + 15 - 31) >> 4; const int ntile = nmax >= 0 ? (nmax >> 5) + 1 : 0;
    fa_zero(o); m[0] = m[1] = -1e30f; ls[0] = ls[1] = 0.f;
    {
        bf16x8 kf[4]; const bf16_t* kl = Kc + (size_t)r * 64 + 8 * h; kf_load(kf, kl);
#pragma unroll 1
        for (int t = 0; t < ntile; ++t) { const int nb = (t + 1 < ntile) ? 32 * (t + 1) : 32 * t; fa_tile<MODE_CMP>(o, m, ls, qf, kf, kl + (size_t)nb * 64, Vc, 16, 64, 32 * t, r, h, qpos, 0, false, false, q0, q0 + 15); }
    }
    float mc[2], invc[2];
#pragma unroll
    for (int rt = 0; rt < 2; ++rt) {
        const float lt = xsum32(ls[rt]); const float inv = lt > 0.f ? 1.0f / lt : 0.f; mc[rt] = m[rt]; invc[rt] = inv;
        const float gsc = bf2f(proj[(tokbase + qpos[rt]) * PP + C_GA + 0 + hkv * 4 + ((32 * rt + r) & 3)]) * inv;
#pragma unroll
        for (int dt = 0; dt < 2; ++dt)
#pragma unroll
            for (int i = 0; i < 16; ++i) ytot[((rt * 2 + dt) * 16 + i) * 64 + lane] = o[rt][dt][i] * gsc;
    }
    RELAUNDER();
    fa_zero(o);
#pragma unroll 1
    for (int t = 0; t < ntile; ++t) {
        const int kbase = 32 * t;
        const bf16_t* kp = Kc + (size_t)(kbase + r) * 64 + 8 * h;
        bf16x8 kf[4];
#pragma unroll
        for (int ks = 0; ks < 4; ++ks) kf[ks] = *(const bf16x8*)(kp + 16 * ks);
        bf16x8 cf[2][2];
#pragma unroll
        for (int jt = 0; jt < 2; ++jt)
#pragma unroll
            for (int s = 0; s < 2; ++s) {
                const int jj = 32 * jt + r;
#pragma unroll
                for (int j = 0; j < 8; ++j) {
                    const int n = kbase + 16 * s + 8 * (j >> 2) + 4 * h + (j & 3);
                    const int jn = n >> 2; const bool edge = (n & 3) == 3;
                    const unsigned short w = (jj == jn) ? (edge ? 0x3F00 : 0x3F80) : ((edge && jj == jn + 1) ? 0x3F00 : 0);
                    cf[jt][s][j] = (short)w;
                }
            }
#pragma unroll
        for (int rt = 0; rt < 2; ++rt) {
            f32x16 st;
#pragma unroll
            for (int i = 0; i < 16; ++i) st[i] = 0.f;
#pragma unroll
            for (int ks = 0; ks < 4; ++ks) st = MFMA32(kf[ks], qf[rt][ks], st);
#pragma unroll
            for (int i = 0; i < 16; ++i) {
                const int kpos = kbase + crow(i, h);
                const bool valid = (16 * kpos + 31 <= qpos[rt]);
                st[i] = valid ? __builtin_amdgcn_exp2f(st[i] * SC2 - mc[rt]) * invc[rt] : 0.f;
            }
            bf16x8 pf[2];
#pragma unroll
            for (int s = 0; s < 2; ++s) {
                u32x4 w; w.x = pk2(st[8 * s + 0], st[8 * s + 1]); w.y = pk2(st[8 * s + 2], st[8 * s + 3]); w.z = pk2(st[8 * s + 4], st[8 * s + 5]); w.w = pk2(st[8 * s + 6], st[8 * s + 7]);
                pf[s] = __builtin_bit_cast(bf16x8, w);
            }
#pragma unroll
            for (int jt = 0; jt < 2; ++jt)
#pragma unroll
                for (int s = 0; s < 2; ++s) o[rt][jt] = MFMA32(cf[jt][s], pf[s], o[rt][jt]);
        }
    }
    RELAUNDER();
    const int cur = q0 >> 6;
    unsigned long long uni = 0ull; unsigned mlo[2], mhi[2];
#pragma unroll
    for (int rt = 0; rt < 2; ++rt) {
#pragma unroll
        for (int jt = 0; jt < 2; ++jt)
#pragma unroll
            for (int i = 0; i < 16; ++i) {
                float v = o[rt][jt][i]; v += shx(v, 1, lane); v += shx(v, 2, lane);
                if ((r & 3) == 0) impscr[(r >> 2) * 64 + 32 * jt + crow(i, h)] = v;
            }
        asm volatile("s_waitcnt lgkmcnt(0)" ::: "memory");
        for (int qi = 0; qi < 8; ++qi) {
            const float v = impscr[qi * 64 + lane];
            const unsigned long long mk = topk_mask(v, lane, cur);
            uni |= mk;
            if (lane == 0) { mskscr[qi * 2] = (unsigned)mk; mskscr[qi * 2 + 1] = (unsigned)(mk >> 32); }
        }
        asm volatile("s_waitcnt lgkmcnt(0)" ::: "memory");
        mlo[rt] = mskscr[(r >> 2) * 2]; mhi[rt] = mskscr[(r >> 2) * 2 + 1];
        asm volatile("s_waitcnt lgkmcnt(0)" ::: "memory");
    }
    RELAUNDER();
    {
        const bf16_t* Ks = proj + tokbase * PP + C_KVA + 256 + hkv * 64;
        const bf16_t* Vs = VT + (size_t)((0 + hkv) * 8 + b) * 64 * SEQ;
        fa_zero(o); m[0] = m[1] = -1e30f; ls[0] = ls[1] = 0.f;
        {
            const unsigned long long vm = uni & ((2ull << cur) - 1ull);
            const bf16_t* kl = Ks + (size_t)r * PP + 8 * h;
            int j = __builtin_ctzll(vm), hf = 0; bool has = true;
            bf16x8 kf[4]; kf_load(kf, kl + (size_t)(64 * j) * PP);
#pragma unroll 1
            while (has) {
                int nj = j, nhf = hf; bool hasn = false;
                if (hf == 0 && 64 * j + 32 <= q0 + 15) { nhf = 1; hasn = true; }
                else { const unsigned long long rem = (j < 63) ? (vm & (~0ull << (j + 1))) : 0ull; if (rem) { nj = __builtin_ctzll(rem); nhf = 0; hasn = true; } }
                const bool rs0 = ((j < 32 ? mlo[0] : mhi[0]) >> (j & 31)) & 1u, rs1 = ((j < 32 ? mlo[1] : mhi[1]) >> (j & 31)) & 1u;
                fa_tile<MODE_SEL>(o, m, ls, qf, kf, kl + (size_t)(64 * nj + 32 * nhf) * PP, Vs, 16, 64, 64 * j + 32 * hf, r, h, qpos, 0, rs0, rs1, q0, q0 + 15);
                j = nj; hf = nhf; has = hasn;
            }
        }
#pragma unroll
        for (int rt = 0; rt < 2; ++rt) {
            const float lt = xsum32(ls[rt]); const float inv = lt > 0.f ? 1.0f / lt : 0.f;
            const float gsc = bf2f(proj[(tokbase + qpos[rt]) * PP + C_GA + 8 + hkv * 4 + ((32 * rt + r) & 3)]) * inv;
#pragma unroll
            for (int dt = 0; dt < 2; ++dt)
#pragma unroll
                for (int i = 0; i < 16; ++i) ytot[((rt * 2 + dt) * 16 + i) * 64 + lane] += o[rt][dt][i] * gsc;
        }
    }
    RELAUNDER();
    {
        const bf16_t* Kw = proj + tokbase * PP + C_KVA + 512 + hkv * 64;
        const bf16_t* Vw = VT + (size_t)((2 + hkv) * 8 + b) * 64 * SEQ;
        fa_zero(o); m[0] = m[1] = -1e30f; ls[0] = ls[1] = 0.f;
        int kb0 = (q0 - 511) & ~31; if (kb0 < 0) kb0 = 0;
        {
            const bf16_t* kl = Kw + (size_t)r * PP + 8 * h; bf16x8 kf[4]; kf_load(kf, kl + (size_t)kb0 * PP);
#pragma unroll 1
            for (int kbase = kb0; kbase <= q0 + 15; kbase += 32) { const int nb = (kbase + 32 <= q0 + 15) ? kbase + 32 : kbase; fa_tile<MODE_WIN>(o, m, ls, qf, kf, kl + (size_t)nb * PP, Vw, 16, 64, kbase, r, h, qpos, 512, false, false, q0, q0 + 15); }
        }
#pragma unroll
        for (int rt = 0; rt < 2; ++rt) {
            const float lt = xsum32(ls[rt]); const float inv = lt > 0.f ? 1.0f / lt : 0.f;
            const float gsc = bf2f(proj[(tokbase + qpos[rt]) * PP + C_GA + 16 + hkv * 4 + ((32 * rt + r) & 3)]) * inv;
            const int R = 32 * rt + r, gi = R & 3;
            bf16_t* yp = ya + (tokbase + qpos[rt]) * 512 + (hkv * 4 + gi) * 64;
#pragma unroll
            for (int dt = 0; dt < 2; ++dt)
#pragma unroll
                for (int a = 0; a < 4; ++a) {
                    float v[4];
#pragma unroll
                    for (int bb = 0; bb < 4; ++bb) { const int i = 4 * a + bb; v[bb] = ytot[((rt * 2 + dt) * 16 + i) * 64 + lane] + o[rt][dt][i] * gsc; }
                    u32x2 w; w.x = pk2(v[0], v[1]); w.y = pk2(v[2], v[3]);
                    *(u32x2*)(yp + 32 * dt + 8 * a + 4 * h) = w;
                }
        }
    }
    asm volatile("s_waitcnt lgkmcnt(0)" ::: "memory");
}

DI void attnB_unit(const bf16_t* proj, const bf16_t* VT, const float* sinks, bf16_t* yb, int b, int q0, int lane) {
    asm volatile("" : "+v"(lane));
    const int r = lane & 31, h = lane >> 5;
    const size_t tokbase = (size_t)b * SEQ;
    int qpos[2]; bf16x8 qf[2][4]; f32x16 o[2][2]; float m[2], ls[2];
#pragma unroll
    for (int rt = 0; rt < 2; ++rt) {
        const int R = 32 * rt + r, qi = R >> 3, gi = R & 7; qpos[rt] = q0 + qi;
        const bf16_t* qp = proj + (tokbase + qpos[rt]) * PP + C_QB + gi * 64 + 8 * h;
#pragma unroll
        for (int ks = 0; ks < 4; ++ks) qf[rt][ks] = *(const bf16x8*)(qp + 16 * ks);
        m[rt] = sinks[gi] * LOG2E; ls[rt] = (h == 0) ? 1.0f : 0.f;
    }
    fa_zero(o);
    const bf16_t* Kb = proj + tokbase * PP + C_KB;
    const bf16_t* Vb = VT + (size_t)(4 * 8 + b) * 64 * SEQ;
    int kb0 = (q0 - 127) & ~31; if (kb0 < 0) kb0 = 0;
    {
        const bf16_t* kl = Kb + (size_t)r * PP + 8 * h; bf16x8 kf[4]; kf_load(kf, kl + (size_t)kb0 * PP);
#pragma unroll 1
        for (int kbase = kb0; kbase <= q0 + 7; kbase += 32) { const int nb = (kbase + 32 <= q0 + 7) ? kbase + 32 : kbase; fa_tile<MODE_WIN>(o, m, ls, qf, kf, kl + (size_t)nb * PP, Vb, 16, 64, kbase, r, h, qpos, 128, false, false, q0, q0 + 7); }
    }
#pragma unroll
    for (int rt = 0; rt < 2; ++rt) {
        const float lt = xsum32(ls[rt]); const float inv = 1.0f / lt;
        const int R = 32 * rt + r, gi = R & 7;
        bf16_t* yp = yb + (tokbase + qpos[rt]) * 512 + gi * 64;
#pragma unroll
        for (int dt = 0; dt < 2; ++dt)
#pragma unroll
            for (int a = 0; a < 4; ++a) {
                u32x2 w; w.x = pk2(o[rt][dt][4 * a] * inv, o[rt][dt][4 * a + 1] * inv); w.y = pk2(o[rt][dt][4 * a + 2] * inv, o[rt][dt][4 * a + 3] * inv);
                *(u32x2*)(yp + 32 * dt + 8 * a + 4 * h) = w;
            }
    }
}

DI void compress_unit(const bf16_t* proj, const bf16_t* W1T, const bf16_t* W2T, const float* cb, const float* rope, bf16_t* kc, bf16_t* vct,
                      int j, int b, int hkv, int nch, int kpart, LAS unsigned char* ldsb, int wave, int lane) {
    asm volatile("" : "+v"(lane));
    const int fr = lane & 15, fq = lane >> 4;
    const int n0 = nch * 16; const int n = n0 + fr; const int nl = n > 254 ? 254 : n;
    const bf16_t* src = proj + ((size_t)b * SEQ + (size_t)nl * 16) * PP + C_KVA + j * 128 + hkv * 64 + fq * 8;
    const bf16_t* w1 = W1T + (size_t)j * 128 * 2048 + (size_t)fr * 2048 + fq * 8;
    f32x4 acc1[8];
#pragma unroll
    for (int ht = 0; ht < 8; ++ht) acc1[ht] = (f32x4){0.f, 0.f, 0.f, 0.f};
    const float* rp = rope + (((size_t)b * SEQ + (size_t)nl * 16) * 32 + fq * 8) * 2;
#pragma unroll 2
    for (int l = kpart * 8; l < kpart * 8 + 8; ++l) {
        bf16x8 b0 = *(const bf16x8*)(src + (size_t)l * PP), b1 = *(const bf16x8*)(src + (size_t)l * PP + 32);
        if (j == 0) {
            f32x4 x0, x1, y0, y1; pg8::unpack8(__builtin_bit_cast(u32x4, b0), x0, x1); pg8::unpack8(__builtin_bit_cast(u32x4, b1), y0, y1);
            const f32x4 cs0 = *(const f32x4*)(rp + (size_t)l * 64), cs1 = *(const f32x4*)(rp + (size_t)l * 64 + 4), cs2 = *(const f32x4*)(rp + (size_t)l * 64 + 8), cs3 = *(const f32x4*)(rp + (size_t)l * 64 + 12);
            f32x4 o0, o1, q0, q1;
            o0[0] = x0[0] * cs0[0] - y0[0] * cs0[1]; q0[0] = y0[0] * cs0[0] + x0[0] * cs0[1];
            o0[1] = x0[1] * cs0[2] - y0[1] * cs0[3]; q0[1] = y0[1] * cs0[2] + x0[1] * cs0[3];
            o0[2] = x0[2] * cs1[0] - y0[2] * cs1[1]; q0[2] = y0[2] * cs1[0] + x0[2] * cs1[1];
            o0[3] = x0[3] * cs1[2] - y0[3] * cs1[3]; q0[3] = y0[3] * cs1[2] + x0[3] * cs1[3];
            o1[0] = x1[0] * cs2[0] - y1[0] * cs2[1]; q1[0] = y1[0] * cs2[0] + x1[0] * cs2[1];
            o1[1] = x1[1] * cs2[2] - y1[1] * cs2[3]; q1[1] = y1[1] * cs2[2] + x1[1] * cs2[3];
            o1[2] = x1[2] * cs3[0] - y1[2] * cs3[1]; q1[2] = y1[2] * cs3[0] + x1[2] * cs3[1];
            o1[3] = x1[3] * cs3[2] - y1[3] * cs3[3]; q1[3] = y1[3] * cs3[2] + x1[3] * cs3[3];
            b0 = __builtin_bit_cast(bf16x8, pg8::pack8(o0, o1)); b1 = __builtin_bit_cast(bf16x8, pg8::pack8(q0, q1));
        }
#pragma unroll
        for (int ht = 0; ht < 8; ++ht) {
            const bf16x8 a0 = *(const bf16x8*)(w1 + (size_t)ht * 16 * 2048 + (2 * l) * 32);
            const bf16x8 a1 = *(const bf16x8*)(w1 + (size_t)ht * 16 * 2048 + (2 * l + 1) * 32);
            acc1[ht] = MFMA16(a0, b0, acc1[ht]);
            acc1[ht] = MFMA16(a1, b1, acc1[ht]);
        }
    }
    {
        LAS float* mine = (LAS float*)(ldsb + wave * LDS_WAVE);
#pragma unroll
        for (int ht = 0; ht < 8; ++ht)
#pragma unroll
            for (int i = 0; i < 4; ++i) mine[(ht * 4 + i) * 64 + lane] = acc1[ht][i];
    }
    __syncthreads();
    if (kpart == 0) {
#pragma unroll
    for (int p = 1; p < 4; ++p) {
        const LAS float* oth = (const LAS float*)(ldsb + (wave + p) * LDS_WAVE);
#pragma unroll
        for (int ht = 0; ht < 8; ++ht)
#pragma unroll
            for (int i = 0; i < 4; ++i) acc1[ht][i] += oth[(ht * 4 + i) * 64 + lane];
    }
    const float* cbj = cb + j * 128;
#pragma unroll
    for (int ht = 0; ht < 8; ++ht)
#pragma unroll
        for (int i = 0; i < 4; ++i) acc1[ht][i] = gelu_tanh(acc1[ht][i] + cbj[16 * ht + 4 * fq + i]);
    f32x4 acc2[4];
#pragma unroll
    for (int ot = 0; ot < 4; ++ot) acc2[ot] = (f32x4){0.f, 0.f, 0.f, 0.f};
    const bf16_t* w2 = W2T + (size_t)j * 64 * 128;
#pragma unroll
    for (int s = 0; s < 4; ++s) {
        u32x4 w; w.x = pk2(acc1[2 * s][0], acc1[2 * s][1]); w.y = pk2(acc1[2 * s][2], acc1[2 * s][3]); w.z = pk2(acc1[2 * s + 1][0], acc1[2 * s + 1][1]); w.w = pk2(acc1[2 * s + 1][2], acc1[2 * s + 1][3]);
        const bf16x8 bfr = __builtin_bit_cast(bf16x8, w);
#pragma unroll
        for (int ot = 0; ot < 4; ++ot) {
            const bf16_t* ap = w2 + (size_t)(ot * 16 + fr) * 128 + 32 * s + 4 * fq;
            const s16x4 lo = *(const s16x4*)ap, hi = *(const s16x4*)(ap + 16);
            const bf16x8 afr = (bf16x8){lo[0], lo[1], lo[2], lo[3], hi[0], hi[1], hi[2], hi[3]};
            acc2[ot] = MFMA16(afr, bfr, acc2[ot]);
        }
    }
    const bool live = n <= 254;
    if (j == 0) {
        bf16_t* dst = kc + ((size_t)(b * 2 + hkv) * 256 + n) * 64;
#pragma unroll
        for (int ot = 0; ot < 4; ++ot) { u32x2 w; w.x = live ? pk2(acc2[ot][0], acc2[ot][1]) : 0u; w.y = live ? pk2(acc2[ot][2], acc2[ot][3]) : 0u; *(u32x2*)(dst + 16 * ot + 4 * fq) = w; }
    } else {
        bf16_t* dst = vct + (size_t)(b * 2 + hkv) * 64 * 256 + (size_t)nch * 1024 + perm16(fr);
#pragma unroll
        for (int ot = 0; ot < 4; ++ot)
#pragma unroll
            for (int i = 0; i < 4; ++i) dst[(16 * ot + 4 * fq + i) * 16] = live ? (bf16_t)(pk2(acc2[ot][i], 0.f) & 0xffffu) : (bf16_t)0;
    }
    }
    __syncthreads();
}

struct S5In { const float *a_re, *a_im, *log_dt, *b_re, *b_im, *c_re, *c_im, *d; };
DI void cplx_abar(const S5In& P, int g, int p, float dt, float& abr, float& abi, float& cfr, float& cfi) {
    const float ar = P.a_re[g * 64 + p], ai = P.a_im[g * 64 + p];
    const float mag = expf(dt * ar); abr = mag * cosf(dt * ai); abi = mag * sinf(dt * ai);
    const float den = ar * ar + ai * ai, nr = abr - 1.0f, ni = abi;
    cfr = (nr * ar + ni * ai) / den; cfi = (ni * ar - nr * ai) / den;
}
template <bool OUT>
DI void s5_unit(const S5In& P, bf16_t* proj, float* states, int b, int g, int c, int nsc, LAS unsigned char* wl, int lane) {
    asm volatile("" : "+v"(lane));
    const int r = lane & 31, h = lane >> 5, fr = lane & 15, fq = lane >> 4;
    const float dt = expf(P.log_dt[g]);
    float abr, abi, t0, t1; cplx_abar(P, g, lane, dt, abr, abi, t0, t1);
    bf16x8 bfrag[4];
#pragma unroll
    for (int hs = 0; hs < 2; ++hs) {
        const int p = r + 32 * hs; float a0, a1, cr, ci; cplx_abar(P, g, p, dt, a0, a1, cr, ci);
        const float* br = P.b_re + ((size_t)g * 64 + p) * 16 + 8 * h; const float* bi = P.b_im + ((size_t)g * 64 + p) * 16 + 8 * h;
        float re[8], im[8];
#pragma unroll
        for (int j = 0; j < 8; ++j) { re[j] = cr * br[j] - ci * bi[j]; im[j] = cr * bi[j] + ci * br[j]; }
        u32x4 wr_, wi_; wr_.x = pk2(re[0], re[1]); wr_.y = pk2(re[2], re[3]); wr_.z = pk2(re[4], re[5]); wr_.w = pk2(re[6], re[7]);
        wi_.x = pk2(im[0], im[1]); wi_.y = pk2(im[2], im[3]); wi_.z = pk2(im[4], im[5]); wi_.w = pk2(im[6], im[7]);
        bfrag[hs] = __builtin_bit_cast(bf16x8, wr_); bfrag[2 + hs] = __builtin_bit_cast(bf16x8, wi_);
    }
    bf16x8 cfrag[4]; float dch = 0.f;
    if (OUT) {
#pragma unroll
        for (int ks = 0; ks < 4; ++ks) {
            const float* cr = P.c_re + ((size_t)g * 16 + fr) * 64 + 16 * ks + 4 * fq; const float* ci = P.c_im + ((size_t)g * 16 + fr) * 64 + 16 * ks + 4 * fq;
            u32x4 w; w.x = pk2(cr[0], -ci[0]); w.y = pk2(cr[1], -ci[1]); w.z = pk2(cr[2], -ci[2]); w.w = pk2(cr[3], -ci[3]);
            cfrag[ks] = __builtin_bit_cast(bf16x8, w);
        }
        dch = P.d[g * 16 + fr];
    }
    float xr = 0.f, xi = 0.f;
    if (OUT) {
        float pr = abr, pi = abi;
#pragma unroll
        for (int q = 0; q < 9; ++q) { const float nr = pr * pr - pi * pi, ni = 2.0f * pr * pi; pr = nr; pi = ni; }
#ifndef DBG_NOSTATE
        for (int cc = 0; cc < c; ++cc) {
            const float* sp = states + ((((size_t)b * 32 + g) * 8 + cc) * 64 + lane) * 2;
            const float sr = sp[0], si = sp[1];
            const float nr = pr * xr - pi * xi + sr, ni = pr * xi + pi * xr + si; xr = nr; xi = ni;
        }
#endif
    }
    LAS float* bu = (LAS float*)wl;
    bf16_t* ucol = proj + ((size_t)b * SEQ + (size_t)c * 512) * PP + C_U + g * 16;
    bf16x8 ufr_n = *(const bf16x8*)(ucol + (size_t)r * PP + 8 * h);
    bf16_t uown_n[2][4];
    if (OUT) {
#pragma unroll
        for (int mt = 0; mt < 2; ++mt)
#pragma unroll
            for (int i = 0; i < 4; ++i) uown_n[mt][i] = ucol[(size_t)(mt * 16 + 4 * fq + i) * PP + fr];
    }
#pragma unroll 1
    for (int sc = 0; sc < nsc; ++sc) {
        bf16_t* ub = ucol + (size_t)sc * 32 * PP;
        const bf16x8 ufr = ufr_n;
        float uown[2][4];
        if (OUT) {
#pragma unroll
            for (int mt = 0; mt < 2; ++mt)
#pragma unroll
                for (int i = 0; i < 4; ++i) uown[mt][i] = bf2f(uown_n[mt][i]);
        }
        {
            const bf16_t* un = ucol + (size_t)(sc + 1 < nsc ? sc + 1 : sc) * 32 * PP;
            ufr_n = *(const bf16x8*)(un + (size_t)r * PP + 8 * h);
            if (OUT) {
#pragma unroll
                for (int mt = 0; mt < 2; ++mt)
#pragma unroll
                    for (int i = 0; i < 4; ++i) uown_n[mt][i] = un[(size_t)(mt * 16 + 4 * fq + i) * PP + fr];
            }
        }
#pragma unroll
        for (int nt = 0; nt < 4; ++nt) {
            f32x16 d;
#pragma unroll
            for (int i = 0; i < 16; ++i) d[i] = 0.f;
            d = MFMA32(ufr, bfrag[nt], d);
#pragma unroll
            for (int i = 0; i < 16; ++i) bu[crow(i, h) * 132 + 32 * nt + r] = d[i];
        }
        asm volatile("s_waitcnt lgkmcnt(0)" ::: "memory");
#pragma unroll 8
        for (int t = 0; t < 32; ++t) {
            const float br_ = bu[t * 132 + lane], bi_ = bu[t * 132 + 64 + lane];
            const float nr = abr * xr - abi * xi + br_, ni = abr * xi + abi * xr + bi_; xr = nr; xi = ni;
            if (OUT) {
                ((LAS unsigned*)(bu + t * 132))[lane] = pk2(xr, xi);
            }
        }
        if (OUT) {
            asm volatile("s_waitcnt lgkmcnt(0)" ::: "memory");
#pragma unroll
            for (int mt = 0; mt < 2; ++mt) {
                f32x4 y = (f32x4){0.f, 0.f, 0.f, 0.f};
#pragma unroll
                for (int ks = 0; ks < 4; ++ks) {
                    const bf16x8 xa = *(const LAS bf16x8*)((LAS unsigned char*)bu + (mt * 16 + fr) * 528 + ks * 64 + fq * 16);
                    y = MFMA16(xa, cfrag[ks], y);
                }
#pragma unroll
                for (int i = 0; i < 4; ++i) {
                    const float yy = y[i] + dch * uown[mt][i];
                    ub[(size_t)(mt * 16 + 4 * fq + i) * PP + fr] = (bf16_t)(pk2(gelu_tanh(yy), 0.f) & 0xffffu);
                }
            }
            asm volatile("s_waitcnt lgkmcnt(0)" ::: "memory");
        }
    }
    if (!OUT) { float* sp = states + ((((size_t)b * 32 + g) * 8 + c) * 64 + lane) * 2; sp[0] = xr; sp[1] = xi; }
}

template <bool OUT_F32>
DI void rmsnorm_rows(const float* src, const float* gain, bf16_t* dstb, float* dstf, float* copy, int gw, int nw, int lane) {
    f32x4 gv[4];
#pragma unroll
    for (int i = 0; i < 4; ++i) gv[i] = *(const f32x4*)(gain + 256 * i + 4 * lane);
#pragma unroll 2
    for (int row = gw; row < T; row += nw) {
        const float* xp = src + (size_t)row * DM + 4 * lane;
        f32x4 v[4]; float ss = 0.f;
#pragma unroll
        for (int i = 0; i < 4; ++i) { v[i] = *(const f32x4*)(xp + 256 * i); ss += v[i][0] * v[i][0] + v[i][1] * v[i][1] + v[i][2] * v[i][2] + v[i][3] * v[i][3]; }
        ss = wave_sum(ss, lane);
        const float rs = rsqrtf(ss * (1.0f / 1024.0f) + NORM_EPS);
#pragma unroll
        for (int i = 0; i < 4; ++i) {
            if (copy) *(f32x4*)(copy + (size_t)row * DM + 256 * i + 4 * lane) = v[i];
            const f32x4 y = v[i] * rs * gv[i];
            if (OUT_F32) *(f32x4*)(dstf + (size_t)row * DM + 256 * i + 4 * lane) = y;
            else { u32x2 w; w.x = pk2(y[0], y[1]); w.y = pk2(y[2], y[3]); *(u32x2*)(dstb + (size_t)row * DM + 256 * i + 4 * lane) = w; }
        }
    }
}

DI int in_srccol(int n) { return n < 1280 ? n : (n < 2432 ? n + 24 : (n < 2456 ? n - 1152 : (n < 2560 ? -1 : n - 104))); }

#define XB_TMO      128
#define XB_XCNT(j)  (256  + 64 * (j))
#define XB_XSUB(j)  (1280 + 64 * (j))
#define XB_XGEN(j)  (2304 + 64 * (j))
#define XB_TOP      3328
#define XB_TOPGEN   3392
#define XB_SPIN_CAP (1u << 18)
DI unsigned xb_ld(unsigned* p)              { return __hip_atomic_load(p, __ATOMIC_RELAXED, __HIP_MEMORY_SCOPE_AGENT); }
DI unsigned xb_add(unsigned* p, unsigned v) { return __hip_atomic_fetch_add(p, v, __ATOMIC_RELAXED, __HIP_MEMORY_SCOPE_AGENT); }
DI unsigned xb_xcc_id() { return (unsigned)__builtin_amdgcn_s_getreg((3 << 11) | 20) & 0xFu; }
#define XB_SPIN(cond, bar) do { unsigned _sp = 0; while (cond) { __builtin_amdgcn_s_sleep(1); \
    if ((++_sp & 255u) == 0u) { if (xb_ld(&(bar)[XB_TMO])) break; if (_sp > XB_SPIN_CAP) { atomicAdd(&(bar)[XB_TMO], 1u); break; } } } } while (0)
DI void xcd_barrier_complete(unsigned* bar, unsigned x, unsigned G, unsigned& nloc, unsigned& nx) {
    unsigned sum, cnt, mine, sp = 0u;
    for (;;) {
        sum = 0u; cnt = 0u; mine = 0u;
#pragma unroll
        for (unsigned j = 0; j < 16; ++j) { const unsigned c = xb_ld(&bar[XB_XCNT(j)]); sum += c; cnt += (c > 0u) ? 1u : 0u; mine = (j == x) ? c : mine; }
        if (sum == G) break;
        __builtin_amdgcn_s_sleep(1);
        if ((++sp & 255u) == 0u) { if (xb_ld(&bar[XB_TMO])) break; if (sp > XB_SPIN_CAP) { atomicAdd(&bar[XB_TMO], 1u); break; } }
    }
    nloc = mine > 0u ? mine : 1u; nx = cnt > 0u ? cnt : 1u;
}
DI void xcd_barrier(unsigned* bar, volatile LAS unsigned* st, bool t0, unsigned G) {
    asm volatile("s_waitcnt vmcnt(0)" ::: "memory");
    __syncthreads();
    if (t0) {
        const unsigned x = xb_xcc_id();
        __builtin_amdgcn_s_waitcnt(0);
        unsigned nloc = st[0], nx = st[1];
        if (nloc == 0u) { xcd_barrier_complete(bar, x, G, nloc, nx); st[0] = nloc; st[1] = nx; }
        const unsigned old = xb_add(&bar[XB_XSUB(x)], 1u);
        const unsigned gen = old / nloc;
        if (old + 1u == (gen + 1u) * nloc) {
            __builtin_amdgcn_fence(__ATOMIC_RELEASE, "agent");
            asm volatile("s_waitcnt vmcnt(0)" ::: "memory");
            const unsigned og = xb_add(&bar[XB_TOP], 1u);
            const unsigned tg = og / nx;
            if (og + 1u == (tg + 1u) * nx) xb_add(&bar[XB_TOPGEN], 1u);
            else XB_SPIN(xb_ld(&bar[XB_TOPGEN]) == tg, bar);
            __builtin_amdgcn_fence(__ATOMIC_ACQUIRE, "agent");
            xb_add(&bar[XB_XGEN(x)], 1u);
            asm volatile("s_waitcnt vmcnt(0)" ::: "memory");
        } else {
            XB_SPIN(xb_ld(&bar[XB_XGEN(x)]) == gen, bar);
            __builtin_amdgcn_fence(__ATOMIC_ACQUIRE, "agent");
            asm volatile("s_waitcnt vmcnt(0)" ::: "memory");
        }
    }
    __syncthreads();
}

struct Args { const float* in[26]; float* out; unsigned char* ws; int ph_lo, ph_hi; };
constexpr int NPH = DEPTH * 11 + 1;

__global__ void __launch_bounds__(512, 2) mega_fwd(Args a) {
    extern __shared__ __attribute__((aligned(16))) unsigned char lds_raw[];
    LAS unsigned char* lds = (LAS unsigned char*)lds_raw;
    cg::grid_group grid = cg::this_grid();
    const int G = gridDim.x, bx = blockIdx.x;
    const int ph_lo = a.ph_lo, ph_hi = a.ph_hi;
    const int wave0 = __builtin_amdgcn_readfirstlane(threadIdx.x >> 6);
    {
        int ln0; asm volatile("v_mbcnt_lo_u32_b32 %0, -1, 0\n\tv_mbcnt_hi_u32_b32 %0, -1, %0" : "=v"(ln0));
        if (wave0 == 0 && ln0 == 0) {
            volatile LAS unsigned* xst = (volatile LAS unsigned*)(lds + LDS_XB); xst[0] = 0u; xst[1] = 0u;
            (void)xb_add(&((unsigned*)(a.ws + OFF_BAR))[XB_XCNT(xb_xcc_id())], 1u);
        }
        __syncthreads();
    }
#define PH_LOCALS \
    int lane_v; asm volatile("v_mbcnt_lo_u32_b32 %0, -1, 0\n\tv_mbcnt_hi_u32_b32 %0, -1, %0" : "=v"(lane_v)); int wave_s = wave0; asm volatile("" : "+s"(wave_s)); \
    const int lane = lane_v, wave = wave_s, tid = wave * 64 + lane; \
    const int gw = bx * 8 + wave, nw = G * 8; (void)gw; (void)nw; (void)lane; \
    const Args* ap = (const Args*)__builtin_amdgcn_kernarg_segment_ptr(); asm volatile("" : "+s"(ap)); \
    unsigned char* ws = as_global(ap->ws); float* X = as_global(ap->out); (void)X; \
    bf16_t* WIN = (bf16_t*)(ws + OFF_WIN); bf16_t* WUP = (bf16_t*)(ws + OFF_WUP); bf16_t* WDN = (bf16_t*)(ws + OFF_WDN); bf16_t* WOUT = (bf16_t*)(ws + OFF_WOUT); \
    bf16_t* WBR = (bf16_t*)(ws + OFF_WBR); bf16_t* WGLU = (bf16_t*)(ws + OFF_WGLU); bf16_t* WC1 = (bf16_t*)(ws + OFF_WC1); bf16_t* WC2 = (bf16_t*)(ws + OFF_WC2); \
    float* CB = (float*)(ws + OFF_CB); float* S5S = (float*)(ws + OFF_S5S); bf16_t* KC = (bf16_t*)(ws + OFF_KC); bf16_t* VCT = (bf16_t*)(ws + OFF_VCT); \
    float* ROPE = (float*)(ws + OFF_ROPE); \
    bf16_t* Hb = (bf16_t*)(ws + OFF_HY); bf16_t* YA = (bf16_t*)(ws + OFF_HY); bf16_t* YB = (bf16_t*)(ws + OFF_HY + YSZ); bf16_t* YC = (bf16_t*)(ws + OFF_HY + 2 * YSZ); \
    bf16_t* VT = YC; bf16_t* PROJ = (bf16_t*)(ws + OFF_PROJ); bf16_t* GG = (bf16_t*)(ws + OFF_G); bf16_t* MG = PROJ; bf16_t* HID = PROJ; \
    LAS unsigned char* wl = lds + wave * LDS_WAVE; \
    (void)WIN; (void)WUP; (void)WDN; (void)WOUT; (void)WBR; (void)WGLU; (void)WC1; (void)WC2; (void)CB; (void)S5S; (void)KC; (void)VCT; (void)ROPE; (void)Hb; (void)YA; (void)YB; (void)YC; (void)VT; (void)PROJ; (void)GG; (void)MG; (void)HID; (void)wl;

#define INP(k) as_global(ap->in[k])
#define PH_BEGIN(p) if (ph_lo <= (p) && (p) < ph_hi) { PH_LOCALS
#define PH_SYNC_CG do { asm volatile("s_waitcnt vmcnt(0)" ::: "memory"); __syncthreads(); if (wave0 == 0) { __builtin_amdgcn_fence(__ATOMIC_RELEASE, "agent"); asm volatile("s_waitcnt vmcnt(0)" ::: "memory"); } __syncthreads(); grid.sync(); if (wave0 == 0) { __builtin_amdgcn_fence(__ATOMIC_ACQUIRE, "agent"); asm volatile("s_waitcnt vmcnt(0)" ::: "memory"); } __syncthreads(); } while (0)
#define PH_SYNC_XCD do { int ln_; asm volatile("v_mbcnt_lo_u32_b32 %0, -1, 0\n\tv_mbcnt_hi_u32_b32 %0, -1, %0" : "=v"(ln_)); const Args* ap_ = (const Args*)__builtin_amdgcn_kernarg_segment_ptr(); asm volatile("" : "+s"(ap_)); \
    xcd_barrier((unsigned*)(ap_->ws + OFF_BAR), (volatile LAS unsigned*)(lds + LDS_XB), wave0 == 0 && ln_ == 0, (unsigned)G); } while (0)
#define PH_END(p) } if (ph_lo <= (p) && (p) + 1 < ph_hi) { PH_SYNC_XCD; }

    if (ph_hi - ph_lo > 1) grid.sync();
#pragma unroll 1
    for (int l = 0; l < DEPTH; ++l) {
        const int pb = l * 11;
        PH_BEGIN(pb + 0)
            LAS float* scr = (LAS float*)lds;
            for (int it = bx; it < 4294; it += G) {
                if (it >= 4292) {
                    const int j = it - 4292; const int hid = tid & 127, part = tid >> 7;
                    const float* pos = INP(4) + (size_t)(l * 2 + j) * 2048; const float* w1 = INP(5) + (size_t)(l * 2 + j) * 2048 * 128;
                    float s = 0.f;
                    for (int kk = part * 512; kk < part * 512 + 512; ++kk) s += pos[kk] * w1[(size_t)kk * 128 + hid];
                    scr[part * 128 + hid] = s;
                    __syncthreads();
                    if (tid < 128) CB[j * 128 + tid] = scr[tid] + scr[128 + tid] + scr[256 + tid] + scr[384 + tid];
                    __syncthreads();
                    continue;
                }
                int rr = it; const float* W; bf16_t* WT; int K, N, tn; bool remap = false;
                if (rr < 1408) { W = INP(3) + (size_t)l * 1024 * 5528; WT = WIN; K = 1024; N = 5528; tn = 88; remap = true; }
                else if ((rr -= 1408) < 1024) { W = INP(23) + (size_t)l * 1024 * 4096; WT = WUP; K = 1024; N = 4096; tn = 64; }
                else if ((rr -= 1024) < 1024) { W = INP(24) + (size_t)l * 4096 * 1024; WT = WDN; K = 4096; N = 1024; tn = 16; }
                else if ((rr -= 1024) < 256) { W = INP(21) + (size_t)l * 1024 * 1024; WT = WOUT; K = 1024; N = 1024; tn = 16; }
                else if ((rr -= 256) < 384) { const int br = rr / 128; rr %= 128; W = INP(18 + br) + (size_t)l * 512 * 1024; WT = WBR + (size_t)br * 1024 * 512; K = 512; N = 1024; tn = 16; }
                else if ((rr -= 384) < 64) { W = INP(16) + (size_t)l * 512 * 512; WT = WGLU; K = 512; N = 512; tn = 8; }
                else if ((rr -= 64) < 128) { const int j = rr / 64; rr %= 64; W = INP(5) + (size_t)(l * 2 + j) * 2048 * 128; WT = WC1 + (size_t)j * 128 * 2048; K = 2048; N = 128; tn = 2; }
                else { rr -= 128; const int j = rr / 2; rr %= 2; W = INP(6) + (size_t)(l * 2 + j) * 128 * 64; WT = WC2 + (size_t)j * 64 * 128; K = 128; N = 64; tn = 1; }
                const int k0 = (rr / tn) * 64, n0 = (rr % tn) * 64;
                {
                    const int tx = tid & 63, ty = tid >> 6; const int nn = n0 + tx; const int sc = remap ? in_srccol(nn) : nn;
#pragma unroll
                    for (int q = 0; q < 8; ++q) { const int k = k0 + ty * 8 + q; scr[(ty * 8 + q) * 65 + tx] = sc >= 0 ? W[(size_t)k * N + sc] : 0.f; }
                }
                __syncthreads();
                {
                    const int nn = tid >> 3, kc = (tid & 7) * 8;
                    f32x4 v0, v1;
#pragma unroll
                    for (int q = 0; q < 4; ++q) { v0[q] = scr[(kc + q) * 65 + nn]; v1[q] = scr[(kc + 4 + q) * 65 + nn]; }
                    *(u32x4*)(WT + (size_t)(n0 + nn) * K + k0 + kc) = pg8::pack8(v0, v1);
                }
                __syncthreads();
            }
            if (l == 0 && bx == 0 && tid < 64) ((unsigned*)(ws + OFF_CB + 2048))[tid] = 0u;
            if (l == 0) {
                const int* positions = (const int*)INP(1);
                for (int idx = bx * 512 + tid; idx < T * 32; idx += 131072) {
                    const int t = idx >> 5, i = idx & 31;
                    const float invf = exp2f(-(float)i * 0.41524101186092029f);
                    const float ang = (float)positions[t] * invf;
                    ROPE[2 * idx] = cosf(ang); ROPE[2 * idx + 1] = sinf(ang);
                }
                rmsnorm_rows<false>(INP(0), INP(2), Hb, nullptr, X, gw, nw, lane);
            } else {
                rmsnorm_rows<false>(X, INP(2) + (size_t)l * DM, Hb, nullptr, nullptr, gw, nw, lane);
            }
        PH_END(pb + 0)
        PH_BEGIN(pb + 1)
            pg8::Gemm g{Hb, WIN, T, NIN, DM, DM, 0, 0}; pg8::StaticOrder S; S.init(T, NIN, G, bx);
            pg8::EpiIn E{PROJ, GG};
            pg8::gemm_phase(lds, g, S, E, tid);
        PH_END(pb + 1)
        PH_BEGIN(pb + 2)
            { const int u = bx * 2 + (wave >> 2); compress_unit(PROJ, WC1, WC2, CB, ROPE, KC, VCT, u >> 8, (u >> 5) & 7, (u >> 4) & 1, u & 15, wave & 3, lds, wave, lane); }
            {
                LAS bf16_t* tile = (LAS bf16_t*)lds;
                for (int it = bx; it < 5 * 8 * 64; it += G) {
                    const int slot = it / 512, b = (it / 64) % 8, st = it % 64;
                    const int vcol = slot < 4 ? C_KVA + (1 + (slot >> 1)) * 256 + 128 + (slot & 1) * 64 : C_VB;
                    {
                        const int tok = tid >> 3, dc = (tid & 7) * 8;
                        const bf16x8 v = *(const bf16x8*)(PROJ + ((size_t)b * SEQ + st * 64 + tok) * PP + vcol + dc);
#pragma unroll
                        for (int j = 0; j < 8; ++j) tile[(dc + j) * 72 + perm16(tok)] = (bf16_t)v[j];
                    }
                    __syncthreads();
                    {
                        const int d = tid >> 3, tc = (tid & 7) * 8;
                        const bf16x8 v = *(const LAS bf16x8*)(tile + d * 72 + tc);
                        *(bf16x8*)(VT + (size_t)(slot * 8 + b) * 64 * SEQ + (size_t)(st * 4 + (tc >> 4)) * 1024 + d * 16 + (tc & 8)) = v;
                    }
                    __syncthreads();
                }
            }
            for (int idx = bx * 512 + tid; idx < T * 84; idx += 131072) {
                const int t = idx / 84, rem = idx % 84, head = rem >> 2, ch = rem & 3;
                int col;
                if (head < 8) col = C_QA + head * 64; else if (head < 12) { const int hh = head - 8; col = C_KVA + (1 + (hh >> 1)) * 256 + (hh & 1) * 64; }
                else if (head < 20) col = C_QB + (head - 12) * 64; else col = C_KB;
                bf16_t* p = PROJ + (size_t)t * PP + col + 8 * ch;
                f32x4 a0, a1, b0, b1; pg8::unpack8(*(const u32x4*)p, a0, a1); pg8::unpack8(*(const u32x4*)(p + 32), b0, b1);
                const float* cs = ROPE + ((size_t)t * 32 + 8 * ch) * 2;
                f32x4 o0, o1, q0, q1;
#pragma unroll
                for (int j = 0; j < 4; ++j) {
                    const float c0 = cs[2 * j], s0 = cs[2 * j + 1], c1 = cs[2 * (j + 4)], s1 = cs[2 * (j + 4) + 1];
                    o0[j] = a0[j] * c0 - b0[j] * s0; q0[j] = b0[j] * c0 + a0[j] * s0;
                    o1[j] = a1[j] * c1 - b1[j] * s1; q1[j] = b1[j] * c1 + a1[j] * s1;
                }
                *(u32x4*)p = pg8::pack8(o0, o1); *(u32x4*)(p + 32) = pg8::pack8(q0, q1);
            }
            {
                const S5In P{INP(8) + (size_t)l * 2048, INP(9) + (size_t)l * 2048, INP(10) + (size_t)l * 32, INP(11) + (size_t)l * 32768, INP(12) + (size_t)l * 32768,
                             INP(13) + (size_t)l * 32768, INP(14) + (size_t)l * 32768, INP(15) + (size_t)l * 512};
            }
        PH_END(pb + 2)
        PH_BEGIN(pb + 4)
            {
                const S5In P{INP(8) + (size_t)l * 2048, INP(9) + (size_t)l * 2048, INP(10) + (size_t)l * 32, INP(11) + (size_t)l * 32768, INP(12) + (size_t)l * 32768,
                             INP(13) + (size_t)l * 32768, INP(14) + (size_t)l * 32768, INP(15) + (size_t)l * 512};
                if (bx < 64 && wave < 4) s5_unit<true>(P, PROJ, S5S, bx >> 3, 4 * (bx & 7) + wave, 0, 128, wl, lane);
            }
            {
                unsigned* xbw = (unsigned*)(ws + OFF_BAR);
                const unsigned xme = xb_xcc_id(); unsigned rk = 0, nx = 0;
#pragma unroll
                for (unsigned j = 0; j < 16; ++j) { const unsigned c = xb_ld(&xbw[XB_XCNT(j)]); if (c) { rk += (j < xme) ? 1u : 0u; ++nx; } }
                rk = __builtin_amdgcn_readfirstlane(rk); nx = __builtin_amdgcn_readfirstlane(nx); if (nx == 0u) nx = 1u;
                const unsigned nbA = rk < 16u ? (16u - rk + nx - 1u) / nx : 0u, nbB = rk < 8u ? (8u - rk + nx - 1u) / nx : 0u;
                const unsigned totA = nbA * 256u, totB = nbB * 512u;
                unsigned* ctr = (unsigned*)(ws + OFF_CB + 2048) + l * 16 + rk;
                for (;;) {
                    unsigned i = 0;
                    if (lane == 0) i = atomicAdd(ctr, 1u);
                    i = __builtin_amdgcn_readfirstlane(i);
                    if (i >= totA + totB) break;
                    if (i < totA) {
                        const unsigned g8 = i >> 3, bl = g8 % nbA, q8 = g8 / nbA;
                        const int bh = (int)(rk + nx * bl), qt = (31 - (int)q8) * 8 + (int)(i & 7u);
                        attnA_unit(PROJ, KC, VCT, VT, YA, bh >> 1, bh & 1, qt * 16, wl, lane);
                    } else {
                        const unsigned u = i - totA; const int b = (int)(rk + nx * (u >> 9));
                        attnB_unit(PROJ, VT, INP(7) + (size_t)l * 8, YB, b, (int)(u & 511u) * 8, lane);
                    }
                }
            }
        PH_END(pb + 4)
        PH_BEGIN(pb + 5)
            pg8::Gemm g{PROJ + C_U, WGLU, T, 512, 512, PP, 0, 0}; pg8::StaticOrder S; S.init(T, 512, G, bx);
            pg8::EpiGlu E{PROJ + C_U, INP(17) + (size_t)l * 512, YC};
            pg8::gemm_phase(lds, g, S, E, tid);
        PH_END(pb + 5)
        PH_BEGIN(pb + 6)
            pg8::Gemm g{YA, WBR, T, DM, 512, 512, YSZ, (size_t)DM * 512 * 2}; pg8::Z3Order S; S.init(T, DM, G, bx);
            pg8::EpiMerge E{GG, MG};
            pg8::gemm_phase(lds, g, S, E, tid);
        PH_END(pb + 6)
        PH_BEGIN(pb + 7)
            pg8::Gemm g{MG, WOUT, T, DM, DM, DM, 0, 0}; pg8::StaticOrder S; S.init(T, DM, G, bx);
            pg8::EpiResid E{X};
            pg8::gemm_phase(lds, g, S, E, tid);
        PH_END(pb + 7)
        PH_BEGIN(pb + 8)
            rmsnorm_rows<false>(X, INP(22) + (size_t)l * DM, Hb, nullptr, nullptr, gw, nw, lane);
        PH_END(pb + 8)
        PH_BEGIN(pb + 9)
            pg8::Gemm g{Hb, WUP, T, DFF, DM, DM, 0, 0}; pg8::StaticOrder S; S.init(T, DFF, G, bx);
            pg8::EpiUp E{HID};
            pg8::gemm_phase(lds, g, S, E, tid);
        PH_END(pb + 9)
        PH_BEGIN(pb + 10)
            pg8::Gemm g{HID, WDN, T, DM, DFF, DFF, 0, 0}; pg8::StaticOrder S; S.init(T, DM, G, bx);
            pg8::EpiResid E{X};
            pg8::gemm_phase(lds, g, S, E, tid);
        PH_END(pb + 10)
    }
    PH_BEGIN(NPH - 1)
        rmsnorm_rows<true>(X, INP(25), nullptr, X, nullptr, gw, nw, lane);
    }
}

extern "C" void kernel_launch(void* const* d_in, const int* in_sizes, int n_in, void* d_out, int out_size, void* d_ws, size_t ws_size, hipStream_t stream) {
    static int ready = 0;
    if (ready == 0) {
        if (n_in != 26 || out_size != T * DM || ws_size < WS_END + BAR_BYTES) { fprintf(stderr, "kernel_launch: unexpected shapes (n_in %d out %d ws %zu need %zu)\n", n_in, out_size, ws_size, (size_t)WS_END); ready = -1; return; }
        if (hipFuncSetAttribute((const void*)mega_fwd, hipFuncAttributeMaxDynamicSharedMemorySize, LDS_BYTES) != hipSuccess) { fprintf(stderr, "kernel_launch: hipFuncSetAttribute failed\n"); ready = -1; return; }
        ready = 1;
    }
    if (ready < 0) return;
#ifdef DBG_MEMSET
    hipMemsetAsync(d_ws, 0xAA, WS_END, stream); hipMemsetAsync(d_out, 0xAA, (size_t)T * DM * 4, stream);
#endif
    if (hipMemsetAsync((unsigned char*)d_ws + OFF_BAR, 0, BAR_BYTES, stream) != hipSuccess) { fprintf(stderr, "kernel_launch: barrier memset failed\n"); return; }
    Args a{};
    for (int i = 0; i < 26; ++i) a.in[i] = (const float*)d_in[i];
    a.out = (float*)d_out; a.ws = (unsigned char*)d_ws;
#if MK_MULTI
    for (int p = 0; p < NPH; ++p) { a.ph_lo = p; a.ph_hi = p + 1; hipLaunchKernelGGL(mega_fwd, dim3(256), dim3(512), LDS_BYTES, stream, a); }
#else
    a.ph_lo = 0; a.ph_hi = NPH;
    void* args[] = {&a};
    hipError_t e = hipLaunchCooperativeKernel((const void*)mega_fwd, dim3(256), dim3(512), args, LDS_BYTES, stream);
    if (e != hipSuccess) fprintf(stderr, "cooperative launch failed: %s\n", hipGetErrorString(e));
#endif
}
```

```cpp
#include <hip/hip_runtime.h>
#include <hip/hip_cooperative_groups.h>
#include <cstdio>
#include <cstdint>
namespace cg = cooperative_groups;

typedef unsigned short bf16_t;
typedef short bf16x8 __attribute__((ext_vector_type(8)));
typedef short s16x4 __attribute__((ext_vector_type(4)));
typedef float f32x4 __attribute__((ext_vector_type(4)));
typedef float f32x16 __attribute__((ext_vector_type(16)));
typedef unsigned u32x4 __attribute__((ext_vector_type(4)));
typedef unsigned u32x2 __attribute__((ext_vector_type(2)));
typedef __bf16 bf16x2_t __attribute__((ext_vector_type(2)));
typedef float f32x2_t __attribute__((ext_vector_type(2)));
#define LAS __attribute__((address_space(3)))
#define DI __device__ __forceinline__

#ifndef MK_MULTI
#define MK_MULTI 0
#endif
#ifndef DBG_MASK
#define DBG_MASK 7
#endif

constexpr int T = 32768, SEQ = 4096, NBATCH = 8, DM = 1024, PP = 2560, NGM = 3072, NIN = 5632, DFF = 4096, DEPTH = 4;
constexpr int C_QA = 0, C_KVA = 512, C_QB = 1280, C_KB = 1792, C_VB = 1856, C_U = 1920, C_GA = 2432;
constexpr float NORM_EPS = 1e-6f;
constexpr float SC2 = 0.125f * 1.4426950408889634f;
constexpr float LOG2E = 1.4426950408889634f;

constexpr size_t OFF_WIN = 0;
constexpr size_t OFF_WUP = OFF_WIN + (size_t)NIN * DM * 2;
constexpr size_t OFF_WDN = OFF_WUP + (size_t)DFF * DM * 2;
constexpr size_t OFF_WOUT = OFF_WDN + (size_t)DFF * DM * 2;
constexpr size_t OFF_WBR = OFF_WOUT + (size_t)DM * DM * 2;
constexpr size_t OFF_WGLU = OFF_WBR + (size_t)3 * DM * 512 * 2;
constexpr size_t OFF_WC1 = OFF_WGLU + (size_t)512 * 512 * 2;
constexpr size_t OFF_WC2 = OFF_WC1 + (size_t)2 * 128 * 2048 * 2;
constexpr size_t OFF_CB = OFF_WC2 + (size_t)2 * 64 * 128 * 2;
constexpr size_t OFF_S5S = OFF_CB + 4096;
constexpr size_t OFF_KC = OFF_S5S + (size_t)8 * 32 * 8 * 64 * 8;
constexpr size_t OFF_VCT = OFF_KC + (size_t)8 * 2 * 256 * 64 * 2;
constexpr size_t OFF_ROPE = OFF_VCT + (size_t)8 * 2 * 256 * 64 * 2;
constexpr size_t OFF_HY = OFF_ROPE + (size_t)T * 32 * 8;
constexpr size_t YSZ = (size_t)T * 512 * 2;
constexpr size_t OFF_PROJ = OFF_HY + 3 * YSZ;
constexpr size_t OFF_G = OFF_PROJ + (size_t)T * PP * 2;
constexpr size_t WS_END = OFF_G + (size_t)T * NGM * 2;
constexpr size_t OFF_BAR = WS_END;
constexpr size_t BAR_BYTES = 3456 * 4;
static_assert(WS_END + BAR_BYTES <= (size_t)512 * 1024 * 1024, "workspace too large");
static_assert((size_t)T * DFF * 2 <= WS_END - OFF_PROJ, "hidden overlay");
constexpr int LDS_WAVE = 18688;
constexpr int LDS_XB = 8 * LDS_WAVE;
constexpr int LDS_BYTES = 8 * LDS_WAVE + 16;

template <class Tp> DI Tp* as_global(Tp* p) { return p; }
DI float bf2f(bf16_t v) { return __uint_as_float((unsigned)v << 16); }
DI unsigned pk2(float lo, float hi) { f32x2_t v = {lo, hi}; bf16x2_t b = __builtin_convertvector(v, bf16x2_t); return __builtin_bit_cast(unsigned, b); }
DI float sigmoidf_(float x) { return __builtin_amdgcn_rcpf(1.0f + __expf(-x)); }
DI float gelu_tanh(float x) { const float u = 0.7978845608028654f * (x + 0.044715f * x * x * x); const float e = __expf(2.0f * u); const float th = 1.0f - 2.0f * __builtin_amdgcn_rcpf(e + 1.0f); return 0.5f * x * (1.0f + th); }
DI int perm16(int x) { return (x & ~12) | ((x & 4) << 1) | ((x & 8) >> 1); }
DI int crow(int reg, int h) { return (reg & 3) + 8 * (reg >> 2) + 4 * h; }
DI float shx(float v, int m, int lane) { return __int_as_float(__builtin_amdgcn_ds_bpermute((lane ^ m) << 2, __float_as_int(v))); }
typedef unsigned u32x2s __attribute__((ext_vector_type(2)));
DI float xmax32(float v) { const u32x2s r = __builtin_amdgcn_permlane32_swap(__float_as_uint(v), __float_as_uint(v), false, false); return fmaxf(__uint_as_float(r[0]), __uint_as_float(r[1])); }
DI float xsum32(float v) { const u32x2s r = __builtin_amdgcn_permlane32_swap(__float_as_uint(v), __float_as_uint(v), false, false); return __uint_as_float(r[0]) + __uint_as_float(r[1]); }
DI float wave_sum(float v, int lane) {
#pragma unroll
    for (int o = 32; o >= 1; o >>= 1) v += shx(v, o, lane);
    return v;
}
#define MFMA32(a, b, c) __builtin_amdgcn_mfma_f32_32x32x16_bf16((a), (b), (c), 0, 0, 0)
#define MFMA16(a, b, c) __builtin_amdgcn_mfma_f32_16x16x32_bf16((a), (b), (c), 0, 0, 0)

namespace pg8 {
constexpr int BM = 256, BK = 64, HALF = 128, HTB = HALF * BK * 2, STAGE_BYTES = 8 * HTB, NXCD = 8, WGM = 8;
__host__ __device__ __forceinline__ int lds_byte(int r, int c) { const int st = (r >> 4) * 2 + (c >> 5), rr = r & 15, cc = c & 31, ob = rr * 64 + cc * 2; return st * 1024 + (ob ^ (((ob >> 9) & 1) << 5)); }
__host__ __device__ __forceinline__ void stage_rc(int b, int& R, int& C) { const int st = b / 1024, sb = b % 1024, swz = sb ^ (((sb >> 9) & 1) << 5); R = (st >> 1) * 16 + swz / 64; C = (st & 1) * 32 + (swz % 64) / 2; }
__host__ __device__ __forceinline__ int perm32(int rho) { const int n = rho >> 4, i = rho & 15; return 8 * (i >> 2) + 4 * n + (i & 3); }

struct Unit { int pm, pn, z; };
struct Gemm { const bf16_t* A; const bf16_t* Bt; int M, N, K, lda; size_t zA, zB; };

DI void tile_of(int wgid, int nwg, int nM, int nN, int& pm, int& pn) {
    { const int q = nwg / NXCD, r = nwg % NXCD, xcd = wgid % NXCD, off = wgid / NXCD; wgid = (xcd < r ? xcd * (q + 1) : r * (q + 1) + (xcd - r) * q) + off; }
    const int nig = WGM * nN, gid = wgid / nig, fm = gid * WGM, gsz = (nM - fm) < WGM ? (nM - fm) : WGM;
    pm = fm + ((wgid % nig) % gsz); pn = (wgid % nig) / gsz;
}
struct StaticOrder {
    int nM, nN, nwg, G, c;
    DI void init(int M, int N, int G_, int c_) { nM = M / BM; nN = N / BM; nwg = nM * nN; G = G_; c = c_; }
    DI bool next(int i, Unit& u) const { const long L = (long)i * G + c; if (L >= nwg) return false; tile_of((int)L, nwg, nM, nN, u.pm, u.pn); u.z = 0; return true; }
};
struct Z3Order {
    int nM, nN, nwg, G, c;
    DI void init(int M, int N, int G_, int c_) { nM = M / BM; nN = N / BM; nwg = nM * nN; G = G_; c = c_; }
    DI bool next(int i, Unit& u) const { const long L = (long)(i / 3) * G + c; if (L >= nwg) return false; tile_of((int)L, nwg, nM, nN, u.pm, u.pn); u.z = i % 3; return true; }
};

template <class Epi, class Sched>
DI void gemm_phase(LAS unsigned char* lds, const Gemm g, const Sched& S, const Epi& E, int tid_l) {
    asm volatile("" : "+v"(tid_l));
    const int tid = tid_l, wid = __builtin_amdgcn_readfirstlane(tid >> 6), lane = tid & 63, wr = wid >> 2, wc = wid & 3, fr = lane & 15, fq = lane >> 4;
    const int K = g.K, nt = K / BK;
    unsigned voffA[2], voffB[2];
#pragma unroll
    for (int i = 0; i < 2; ++i) { int R, C; stage_rc(tid * 16 + i * 8192, R, C); const int Rb = (R & ~31) + perm32(R & 31);
        voffA[i] = (unsigned)(R * g.lda + C) * 2u; voffB[i] = (unsigned)(Rb * K + C) * 2u; }
    const size_t kstep = (size_t)(BK * 2);
    const size_t hstepA = (size_t)HALF * g.lda * 2, hstepB = (size_t)HALF * K * 2;
    const size_t tstepA = 2 * hstepA, tstepB = 2 * hstepB;
    const unsigned ldsw = (unsigned)wid * 1024u;
    const int aoff = lds_byte(wr * 64 + fr, fq * 8), boff = lds_byte(wc * 32 + fr, fq * 8);
#define PG8_SA(b, h) (((b) * 2 + (h)) * HTB)
#define PG8_SB(b, h) ((4 + (b) * 2 + (h)) * HTB)
#define PG8_STAGE(bufoff, gbase, voff) do { _Pragma("unroll") for (int _i = 0; _i < 2; ++_i) \
        __builtin_amdgcn_global_load_lds((const unsigned*)((const char*)(gbase) + (voff)[_i]), (LAS unsigned*)(lds + (bufoff) + ldsw + _i * 8192), 16, 0, 0); } while (0)
#define PG8_LDA(dst, b, h) do { _Pragma("unroll") for (int m = 0; m < 4; ++m) _Pragma("unroll") for (int k = 0; k < 2; ++k) dst[m][k] = *(const LAS bf16x8*)(lds + PG8_SA(b, h) + aoff + m * 2048 + k * 1024); } while (0)
#define PG8_LDB(dst, b, h) do { _Pragma("unroll") for (int n = 0; n < 2; ++n) _Pragma("unroll") for (int k = 0; k < 2; ++k) dst[n][k] = *(const LAS bf16x8*)(lds + PG8_SB(b, h) + boff + n * 2048 + k * 1024); } while (0)
#define PG8_MMA(ai, bj, At, Bt) do { __builtin_amdgcn_s_setprio(1); _Pragma("unroll") for (int m = 0; m < 4; ++m) _Pragma("unroll") for (int n = 0; n < 2; ++n) _Pragma("unroll") for (int k = 0; k < 2; ++k) \
        acc[ai][bj][m][n] = __builtin_amdgcn_mfma_f32_16x16x32_bf16(Bt[n][k], At[m][k], acc[ai][bj][m][n], 0, 0, 0); __builtin_amdgcn_s_setprio(0); } while (0)
#define PG8_WAIT_V(n) asm volatile("s_waitcnt vmcnt(" #n ")" ::: "memory")
#define PG8_WAIT_L(n) asm volatile("s_waitcnt lgkmcnt(" #n ")" ::: "memory")
#define PG8_BAR __builtin_amdgcn_s_barrier()
#define PG8_SCHED __builtin_amdgcn_sched_barrier(0)
    Unit cur, nxt; int ui = 0;
    if (!S.next(0, cur)) return;
    f32x4 acc[2][2][4][2];
#pragma unroll
    for (int a = 0; a < 2; ++a)
#pragma unroll
        for (int b = 0; b < 2; ++b)
#pragma unroll
            for (int m = 0; m < 4; ++m)
#pragma unroll
                for (int n = 0; n < 2; ++n) acc[a][b][m][n] = (f32x4){0.f, 0.f, 0.f, 0.f};
    bf16x8 At[4][2], B0[2][2], B1[2][2];
    const char* cA = (const char*)g.A + (size_t)cur.z * g.zA + (size_t)cur.pm * tstepA; const char* cB = (const char*)g.Bt + (size_t)cur.z * g.zB + (size_t)cur.pn * tstepB;
    PG8_STAGE(PG8_SB(0, 0), cB, voffB); PG8_STAGE(PG8_SB(0, 1), cB + hstepB, voffB); PG8_STAGE(PG8_SA(0, 0), cA, voffA); PG8_STAGE(PG8_SA(0, 1), cA + hstepA, voffA);
    if (wr == 1) PG8_BAR;
    PG8_WAIT_V(2); PG8_BAR;
    PG8_STAGE(PG8_SB(1, 0), cB + kstep, voffB); PG8_STAGE(PG8_SA(1, 0), cA + kstep, voffA); PG8_STAGE(PG8_SB(1, 1), cB + hstepB + kstep, voffB);
    PG8_WAIT_V(6); PG8_BAR;
    for (;;) {
        const bool has_next = S.next(ui + 1, nxt);
        const char* nA = has_next ? (const char*)g.A + (size_t)nxt.z * g.zA + (size_t)nxt.pm * tstepA : cA; const char* nB = has_next ? (const char*)g.Bt + (size_t)nxt.z * g.zB + (size_t)nxt.pn * tstepB : cB;
        for (int t = 0; t < nt; t += 2) {
            const bool last = (t == nt - 2);
            const char* a1 = cA + (size_t)(t + 1) * kstep;
            const char* a2 = last ? nA : cA + (size_t)(t + 2) * kstep; const char* b2 = last ? nB : cB + (size_t)(t + 2) * kstep;
            const char* a3 = a2 + kstep; const char* b3 = b2 + kstep;
            PG8_LDB(B0, 0, 0); PG8_LDB(B1, 0, 1); PG8_SCHED; PG8_LDA(At, 0, 0); PG8_STAGE(PG8_SA(1, 1), a1 + hstepA, voffA);
            PG8_WAIT_V(8); PG8_WAIT_L(0); PG8_BAR; PG8_MMA(0, 0, At, B0); PG8_MMA(0, 1, At, B1); PG8_BAR; PG8_SCHED;
            PG8_LDA(At, 0, 1); PG8_STAGE(PG8_SB(0, 0), b2, voffB); PG8_STAGE(PG8_SB(0, 1), b2 + hstepB, voffB); PG8_STAGE(PG8_SA(0, 0), a2, voffA);
            PG8_WAIT_V(8); PG8_WAIT_L(0); PG8_BAR; PG8_MMA(1, 0, At, B0); PG8_MMA(1, 1, At, B1); PG8_BAR; PG8_SCHED;
            PG8_LDB(B0, 1, 0); PG8_LDB(B1, 1, 1); PG8_SCHED; PG8_LDA(At, 1, 0); PG8_STAGE(PG8_SA(0, 1), a2 + hstepA, voffA);
            PG8_WAIT_V(8); PG8_WAIT_L(0); PG8_BAR; PG8_MMA(0, 0, At, B0); PG8_MMA(0, 1, At, B1); PG8_BAR; PG8_SCHED;
            PG8_LDA(At, 1, 1); PG8_STAGE(PG8_SB(1, 0), b3, voffB); PG8_STAGE(PG8_SB(1, 1), b3 + hstepB, voffB); PG8_STAGE(PG8_SA(1, 0), a3, voffA);
            PG8_WAIT_V(8); PG8_WAIT_L(0); PG8_BAR; PG8_MMA(1, 0, At, B0); PG8_MMA(1, 1, At, B1); PG8_BAR; PG8_SCHED;
        }
        if (wr == 0) PG8_BAR;
        E(acc, cur, wr, wc, fr, fq);
        if (!has_next) break;
#pragma unroll
        for (int a = 0; a < 2; ++a)
#pragma unroll
            for (int b = 0; b < 2; ++b)
#pragma unroll
                for (int m = 0; m < 4; ++m)
#pragma unroll
                    for (int n = 0; n < 2; ++n) acc[a][b][m][n] = (f32x4){0.f, 0.f, 0.f, 0.f};
        cur = nxt; cA = nA; cB = nB; ++ui;
        if (wr == 1) PG8_BAR;
    }
    PG8_WAIT_V(0);
    PG8_BAR;
#undef PG8_SA
#undef PG8_SB
#undef PG8_STAGE
#undef PG8_LDA
#undef PG8_LDB
#undef PG8_MMA
#undef PG8_WAIT_V
#undef PG8_WAIT_L
#undef PG8_BAR
#undef PG8_SCHED
}

#define EPI_LOOP_BEGIN \
    const int row0 = u.pm * BM + wr * 64 + fr; \
    _Pragma("unroll") for (int ai = 0; ai < 2; ++ai) _Pragma("unroll") for (int m = 0; m < 4; ++m) { const size_t row = (size_t)(row0 + ai * HALF + m * 16); \
    _Pragma("unroll") for (int bj = 0; bj < 2; ++bj) { const int col = u.pn * BM + bj * HALF + wc * 32 + 8 * fq; f32x4 v0 = acc[ai][bj][m][0], v1 = acc[ai][bj][m][1];
#define EPI_LOOP_END } }
DI u32x4 pack8(f32x4 v0, f32x4 v1) { u32x4 w; w.x = pk2(v0[0], v0[1]); w.y = pk2(v0[2], v0[3]); w.z = pk2(v1[0], v1[1]); w.w = pk2(v1[2], v1[3]); return w; }
DI void unpack8(u32x4 w, f32x4& a, f32x4& b) {
    a[0] = __uint_as_float(w.x << 16); a[1] = __uint_as_float(w.x & 0xffff0000u); a[2] = __uint_as_float(w.y << 16); a[3] = __uint_as_float(w.y & 0xffff0000u);
    b[0] = __uint_as_float(w.z << 16); b[1] = __uint_as_float(w.z & 0xffff0000u); b[2] = __uint_as_float(w.w << 16); b[3] = __uint_as_float(w.w & 0xffff0000u);
}
struct EpiIn {
    bf16_t* proj; bf16_t* G;
    DI void operator()(const f32x4 (&acc)[2][2][4][2], const Unit& u, int wr, int wc, int fr, int fq) const {
        EPI_LOOP_BEGIN
            if (col >= C_GA) {
#pragma unroll
                for (int j = 0; j < 4; ++j) { v0[j] = sigmoidf_(v0[j]); v1[j] = sigmoidf_(v1[j]); }
            }
            bf16_t* dst = (col < PP) ? proj + row * PP + col : G + row * NGM + (col - PP);
            *(u32x4*)dst = pack8(v0, v1);
        EPI_LOOP_END
    }
};
struct EpiGlu {
    const bf16_t* z; const float* bias; bf16_t* yc;
    DI void operator()(const f32x4 (&acc)[2][2][4][2], const Unit& u, int wr, int wc, int fr, int fq) const {
        const int row0 = u.pm * BM + wr * 64 + fr; const int colb = u.pn * BM + wc * 32 + 8 * fq;
        f32x4 b0[2], b1[2];
#pragma unroll
        for (int bj = 0; bj < 2; ++bj) { b0[bj] = *(const f32x4*)(bias + colb + bj * HALF); b1[bj] = *(const f32x4*)(bias + colb + bj * HALF + 4); }
#pragma unroll
        for (int ai = 0; ai < 2; ++ai) {
            u32x4 zq[4][2];
#pragma unroll
            for (int m = 0; m < 4; ++m)
#pragma unroll
                for (int bj = 0; bj < 2; ++bj) zq[m][bj] = *(const u32x4*)(z + (size_t)(row0 + ai * HALF + m * 16) * PP + colb + bj * HALF);
#pragma unroll
            for (int m = 0; m < 4; ++m)
#pragma unroll
                for (int bj = 0; bj < 2; ++bj) {
                    f32x4 z0, z1; unpack8(zq[m][bj], z0, z1); f32x4 v0 = acc[ai][bj][m][0], v1 = acc[ai][bj][m][1];
#pragma unroll
                    for (int j = 0; j < 4; ++j) { v0[j] = z0[j] * sigmoidf_(v0[j] + b0[bj][j]); v1[j] = z1[j] * sigmoidf_(v1[j] + b1[bj][j]); }
                    *(u32x4*)(yc + (size_t)(row0 + ai * HALF + m * 16) * 512 + colb + bj * HALF) = pack8(v0, v1);
                }
        }
    }
};
struct EpiMerge {
    const bf16_t* G; bf16_t* mg;
    DI void operator()(const f32x4 (&acc)[2][2][4][2], const Unit& u, int wr, int wc, int fr, int fq) const {
        const int row0 = u.pm * BM + wr * 64 + fr; const int colb = u.pn * BM + wc * 32 + 8 * fq;
#pragma unroll
        for (int ai = 0; ai < 2; ++ai) {
            u32x4 gq[4][2], pq[4][2];
#pragma unroll
            for (int m = 0; m < 4; ++m)
#pragma unroll
                for (int bj = 0; bj < 2; ++bj) {
                    const size_t row = (size_t)(row0 + ai * HALF + m * 16); const int col = colb + bj * HALF;
                    gq[m][bj] = *(const u32x4*)(G + row * NGM + u.z * DM + col);
                    pq[m][bj] = (u.z > 0) ? *(const u32x4*)(mg + row * DM + col) : (u32x4){0u, 0u, 0u, 0u};
                }
#pragma unroll
            for (int m = 0; m < 4; ++m)
#pragma unroll
                for (int bj = 0; bj < 2; ++bj) {
                    const size_t row = (size_t)(row0 + ai * HALF + m * 16); const int col = colb + bj * HALF;
                    f32x4 g0, g1, p0, p1; unpack8(gq[m][bj], g0, g1); unpack8(pq[m][bj], p0, p1);
                    const f32x4 v0 = acc[ai][bj][m][0] * g0 + p0, v1 = acc[ai][bj][m][1] * g1 + p1;
                    *(u32x4*)(mg + row * DM + col) = pack8(v0, v1);
                }
        }
    }
};
struct EpiResid {
    float* x;
    DI void operator()(const f32x4 (&acc)[2][2][4][2], const Unit& u, int wr, int wc, int fr, int fq) const {
        const int row0 = u.pm * BM + wr * 64 + fr; const int colb = u.pn * BM + wc * 32 + 8 * fq;
#pragma unroll
        for (int ai = 0; ai < 2; ++ai) {
            f32x4 xa[4][2], xb[4][2];
#pragma unroll
            for (int m = 0; m < 4; ++m)
#pragma unroll
                for (int bj = 0; bj < 2; ++bj) {
                    const float* p = x + (size_t)(row0 + ai * HALF + m * 16) * DM + colb + bj * HALF;
                    xa[m][bj] = *(const f32x4*)p; xb[m][bj] = *(const f32x4*)(p + 4);
                }
#pragma unroll
            for (int m = 0; m < 4; ++m)
#pragma unroll
                for (int bj = 0; bj < 2; ++bj) {
                    float* p = x + (size_t)(row0 + ai * HALF + m * 16) * DM + colb + bj * HALF;
                    *(f32x4*)p = xa[m][bj] + acc[ai][bj][m][0]; *(f32x4*)(p + 4) = xb[m][bj] + acc[ai][bj][m][1];
                }
        }
    }
};
struct EpiUp {
    bf16_t* hid;
    DI void operator()(const f32x4 (&acc)[2][2][4][2], const Unit& u, int wr, int wc, int fr, int fq) const {
        EPI_LOOP_BEGIN
#pragma unroll
            for (int j = 0; j < 4; ++j) { const float a = fmaxf(v0[j], 0.f), b = fmaxf(v1[j], 0.f); v0[j] = a * a; v1[j] = b * b; }
            *(u32x4*)(hid + row * DFF + col) = pack8(v0, v1);
        EPI_LOOP_END
    }
};
}

enum { MODE_WIN = 0, MODE_CMP = 1, MODE_SEL = 2 };
template <int MODE>
DI void fa_tile(f32x16 (&o)[2][2], float (&m)[2], float (&ls)[2], const bf16x8 (&qf)[2][4],
                bf16x8 (&kf)[4], const bf16_t* knext, const bf16_t* VTb, int vpitch, int vks, int kbase, int r, int h,
                const int (&qpos)[2], int W, bool rs0, bool rs1, int qlo, int qhi) {
    bool fullw;
    if (MODE == MODE_WIN) fullw = (kbase + 31 <= qlo) && (kbase > qhi - W);
    else if (MODE == MODE_CMP) fullw = (16 * (kbase + 31) + 31 <= qlo);
    else fullw = (kbase + 31 <= qlo) && (__builtin_amdgcn_ballot_w64(rs0 && rs1) == ~0ull);
    bf16x8 vf[2][2];
#pragma unroll
    for (int dt = 0; dt < 2; ++dt)
#pragma unroll
        for (int s = 0; s < 2; ++s) {
            vf[dt][s] = *(const bf16x8*)(VTb + (size_t)(32 * dt + r) * vpitch + (size_t)(kbase + 16 * s) * vks + 8 * h);
        }
#pragma unroll
    for (int rt = 0; rt < 2; ++rt) {
        f32x16 st;
#pragma unroll
        for (int i = 0; i < 16; ++i) st[i] = 0.f;
#pragma unroll
        for (int ks = 0; ks < 4; ++ks) st = MFMA32(kf[ks], qf[rt][ks], st);
        if (rt == 1) {
#pragma unroll
            for (int ks = 0; ks < 4; ++ks) kf[ks] = *(const bf16x8*)(knext + 16 * ks);
        }
        const int qp = qpos[rt]; const bool rs = rt == 0 ? rs0 : rs1;
        if (!fullw) {
#pragma unroll
            for (int i = 0; i < 16; ++i) {
                const int kpos = kbase + crow(i, h);
                bool valid;
                if (MODE == MODE_WIN) valid = (kpos <= qp) && (kpos > qp - W);
                else if (MODE == MODE_CMP) valid = (16 * kpos + 31 <= qp);
                else valid = rs && (kpos <= qp);
                st[i] = valid ? st[i] : -INFINITY;
            }
        }
        float mx = st[0];
#pragma unroll
        for (int i = 1; i < 16; ++i) mx = fmaxf(mx, st[i]);
        mx = xmax32(mx);
        const float cand = fmaxf(m[rt], mx * SC2);
        if (__builtin_amdgcn_ballot_w64((cand - m[rt]) > 8.0f) != 0ull) {
            const float alpha = __builtin_amdgcn_exp2f(m[rt] - cand);
            m[rt] = cand; ls[rt] *= alpha;
#pragma unroll
            for (int dt = 0; dt < 2; ++dt)
#pragma unroll
                for (int i = 0; i < 16; ++i) o[rt][dt][i] *= alpha;
        }
        const float mref = m[rt];
        float sum = 0.f;
#pragma unroll
        for (int i = 0; i < 16; ++i) { const float p = __builtin_amdgcn_exp2f(__builtin_fmaf(st[i], SC2, -mref)); st[i] = p; sum += p; }
        ls[rt] += sum;
        bf16x8 pf[2];
#pragma unroll
        for (int s = 0; s < 2; ++s) {
            u32x4 w; w.x = pk2(st[8 * s + 0], st[8 * s + 1]); w.y = pk2(st[8 * s + 2], st[8 * s + 3]); w.z = pk2(st[8 * s + 4], st[8 * s + 5]); w.w = pk2(st[8 * s + 6], st[8 * s + 7]);
            pf[s] = __builtin_bit_cast(bf16x8, w);
        }
#pragma unroll
        for (int dt = 0; dt < 2; ++dt)
#pragma unroll
            for (int s = 0; s < 2; ++s) o[rt][dt] = MFMA32(vf[dt][s], pf[s], o[rt][dt]);
    }
}
DI void kf_load(bf16x8 (&kf)[4], const bf16_t* kp) {
#pragma unroll
    for (int ks = 0; ks < 4; ++ks) kf[ks] = *(const bf16x8*)(kp + 16 * ks);
}
DI void fa_zero(f32x16 (&o)[2][2]) {
#pragma unroll
    for (int a = 0; a < 2; ++a)
#pragma unroll
        for (int b = 0; b < 2; ++b)
#pragma unroll
            for (int i = 0; i < 16; ++i) o[a][b][i] = 0.f;
}

DI unsigned long long topk_mask(float impv, int lane, int cur) {
    const bool valid = lane <= cur; const bool forced = (lane == 0) | (lane == cur) | (lane == cur - 1);
    if (cur + 1 <= 16) return __ballot(valid);
    const unsigned key = valid ? (forced ? 0x7f000000u : (__float_as_uint(fmaxf(impv, 0.f)) + 1u)) : 0u;
    unsigned t = 0;
    for (int bit = 30; bit >= 0; --bit) {
        const unsigned cand = t | (1u << bit);
        const int cnt = __popcll(__ballot(key >= cand));
        if (cnt >= 16) t = cand;
    }
    const unsigned long long gt = __ballot(key > t), eq = __ballot(key == t);
    const int need = 16 - __popcll(gt);
    const int below = __popcll(eq & ((1ull << lane) - 1ull));
    const bool sel = (key > t) || ((key == t) && (below < need));
    return __ballot(sel);
}

DI void attnA_unit(const bf16_t* proj, const bf16_t* kc, const bf16_t* vct, const bf16_t* VT, bf16_t* ya,
                   int b, int hkv, int q0, LAS unsigned char* wl, int lane) {
    asm volatile("" : "+v"(lane));
    int r = lane & 31, h = lane >> 5;
#define RELAUNDER() do { asm volatile("" : "+v"(lane)); r = lane & 31; h = lane >> 5; } while (0)
    const size_t tokbase = (size_t)b * SEQ;
    LAS float* ytot = (LAS float*)wl;
    LAS float* impscr = (LAS float*)(wl + 16384);
    LAS unsigned* mskscr = (LAS unsigned*)(wl + 16384 + 2048);
    int qpos[2]; bf16x8 qf[2][4];
#pragma unroll
    for (int rt = 0; rt < 2; ++rt) {
        const int R = 32 * rt + r, qi = R >> 2, gi = R & 3; qpos[rt] = q0 + qi;
        const bf16_t* qp = proj + (tokbase + qpos[rt]) * PP + C_QA + (hkv * 4 + gi) * 64 + 8 * h;
#pragma unroll
        for (int ks = 0; ks < 4; ++ks) qf[rt][ks] = *(const bf16x8*)(qp + 16 * ks);
    }
    f32x16 o[2][2]; float m[2], ls[2];
    const bf16_t* Kc = kc + (size_t)(b * 2 + hkv) * 256 * 64; const bf16_t* Vc = vct + (size_t)(b * 2 + hkv) * 64 * 256;
    const int nmax = (q0 + 15 - 31) >> 4; const int ntile = nmax >= 0 ? (nmax >> 5) + 1 : 0;
    fa_zero(o); m[0] = m[1] = -1e30f; ls[0] = ls[1] = 0.f;
    {
        bf16x8 kf[4]; const bf16_t* kl = Kc + (size_t)r * 64 + 8 * h; kf_load(kf, kl);
#pragma unroll 1
        for (int t = 0; t < ntile; ++t) { const int nb = (t + 1 < ntile) ? 32 * (t + 1) : 32 * t; fa_tile<MODE_CMP>(o, m, ls, qf, kf, kl + (size_t)nb * 64, Vc, 16, 64, 32 * t, r, h, qpos, 0, false, false, q0, q0 + 15); }
    }
    float mc[2], invc[2];
#pragma unroll
    for (int rt = 0; rt < 2; ++rt) {
        const float lt = xsum32(ls[rt]); const float inv = lt > 0.f ? __builtin_amdgcn_rcpf(lt) : 0.f; mc[rt] = m[rt]; invc[rt] = inv;
        const float gsc = bf2f(proj[(tokbase + qpos[rt]) * PP + C_GA + 0 + hkv * 4 + ((32 * rt + r) & 3)]) * inv;
#pragma unroll
        for (int dt = 0; dt < 2; ++dt)
#pragma unroll
            for (int i = 0; i < 16; ++i) ytot[((rt * 2 + dt) * 16 + i) * 64 + lane] = o[rt][dt][i] * gsc;
    }
    RELAUNDER();
    fa_zero(o);
#pragma unroll 1
    for (int t = 0; t < ntile; ++t) {
        const int kbase = 32 * t;
        const bf16_t* kp = Kc + (size_t)(kbase + r) * 64 + 8 * h;
        bf16x8 kf[4];
#pragma unroll
        for (int ks = 0; ks < 4; ++ks) kf[ks] = *(const bf16x8*)(kp + 16 * ks);
        bf16x8 cf[2][2];
#pragma unroll
        for (int jt = 0; jt < 2; ++jt)
#pragma unroll
            for (int s = 0; s < 2; ++s) {
                const int jj = 32 * jt + r;
#pragma unroll
                for (int j = 0; j < 8; ++j) {
                    const int n = kbase + 16 * s + 8 * (j >> 2) + 4 * h + (j & 3);
                    const int jn = n >> 2; const bool edge = (n & 3) == 3;
                    const unsigned short w = (jj == jn) ? (edge ? 0x3F00 : 0x3F80) : ((edge && jj == jn + 1) ? 0x3F00 : 0);
                    cf[jt][s][j] = (short)w;
                }
            }
#pragma unroll
        for (int rt = 0; rt < 2; ++rt) {
            f32x16 st;
#pragma unroll
            for (int i = 0; i < 16; ++i) st[i] = 0.f;
#pragma unroll
            for (int ks = 0; ks < 4; ++ks) st = MFMA32(kf[ks], qf[rt][ks], st);
#pragma unroll
            for (int i = 0; i < 16; ++i) {
                const int kpos = kbase + crow(i, h);
                const bool valid = (16 * kpos + 31 <= qpos[rt]);
                st[i] = valid ? __builtin_amdgcn_exp2f(st[i] * SC2 - mc[rt]) * invc[rt] : 0.f;
            }
            bf16x8 pf[2];
#pragma unroll
            for (int s = 0; s < 2; ++s) {
                u32x4 w; w.x = pk2(st[8 * s + 0], st[8 * s + 1]); w.y = pk2(st[8 * s + 2], st[8 * s + 3]); w.z = pk2(st[8 * s + 4], st[8 * s + 5]); w.w = pk2(st[8 * s + 6], st[8 * s + 7]);
                pf[s] = __builtin_bit_cast(bf16x8, w);
            }
#pragma unroll
            for (int jt = 0; jt < 2; ++jt)
#pragma unroll
                for (int s = 0; s < 2; ++s) o[rt][jt] = MFMA32(cf[jt][s], pf[s], o[rt][jt]);
        }
    }
    RELAUNDER();
    const int cur = q0 >> 6;
    unsigned long long uni = 0ull; unsigned mlo[2], mhi[2];
#pragma unroll
    for (int rt = 0; rt < 2; ++rt) {
#pragma unroll
        for (int jt = 0; jt < 2; ++jt)
#pragma unroll
            for (int i = 0; i < 16; ++i) {
                float v = o[rt][jt][i]; v += shx(v, 1, lane); v += shx(v, 2, lane);
                if ((r & 3) == 0) impscr[(r >> 2) * 64 + 32 * jt + crow(i, h)] = v;
            }
        asm volatile("s_waitcnt lgkmcnt(0)" ::: "memory");
        for (int qi = 0; qi < 8; ++qi) {
            const float v = impscr[qi * 64 + lane];
            const unsigned long long mk = topk_mask(v, lane, cur);
            uni |= mk;
            if (lane == 0) { mskscr[qi * 2] = (unsigned)mk; mskscr[qi * 2 + 1] = (unsigned)(mk >> 32); }
        }
        asm volatile("s_waitcnt lgkmcnt(0)" ::: "memory");
        mlo[rt] = mskscr[(r >> 2) * 2]; mhi[rt] = mskscr[(r >> 2) * 2 + 1];
        asm volatile("s_waitcnt lgkmcnt(0)" ::: "memory");
    }
    RELAUNDER();
    {
        const bf16_t* Ks = proj + tokbase * PP + C_KVA + 256 + hkv * 64;
        const bf16_t* Vs = VT + (size_t)((0 + hkv) * 8 + b) * 64 * SEQ;
        fa_zero(o); m[0] = m[1] = -1e30f; ls[0] = ls[1] = 0.f;
        {
            const unsigned long long vm = uni & ((2ull << cur) - 1ull);
            const bf16_t* kl = Ks + (size_t)r * PP + 8 * h;
            int j = __builtin_ctzll(vm), hf = 0; bool has = true;
            bf16x8 kf[4]; kf_load(kf, kl + (size_t)(64 * j) * PP);
#pragma unroll 1
            while (has) {
                int nj = j, nhf = hf; bool hasn = false;
                if (hf == 0 && 64 * j + 32 <= q0 + 15) { nhf = 1; hasn = true; }
                else { const unsigned long long rem = (j < 63) ? (vm & (~0ull << (j + 1))) : 0ull; if (rem) { nj = __builtin_ctzll(rem); nhf = 0; hasn = true; } }
                const bool rs0 = ((j < 32 ? mlo[0] : mhi[0]) >> (j & 31)) & 1u, rs1 = ((j < 32 ? mlo[1] : mhi[1]) >> (j & 31)) & 1u;
                fa_tile<MODE_SEL>(o, m, ls, qf, kf, kl + (size_t)(64 * nj + 32 * nhf) * PP, Vs, 16, 64, 64 * j + 32 * hf, r, h, qpos, 0, rs0, rs1, q0, q0 + 15);
                j = nj; hf = nhf; has = hasn;
            }
        }
#pragma unroll
        for (int rt = 0; rt < 2; ++rt) {
            const float lt = xsum32(ls[rt]); const float inv = lt > 0.f ? __builtin_amdgcn_rcpf(lt) : 0.f;
            const float gsc = bf2f(proj[(tokbase + qpos[rt]) * PP + C_GA + 8 + hkv * 4 + ((32 * rt + r) & 3)]) * inv;
#pragma unroll
            for (int dt = 0; dt < 2; ++dt)
#pragma unroll
                for (int i = 0; i < 16; ++i) ytot[((rt * 2 + dt) * 16 + i) * 64 + lane] += o[rt][dt][i] * gsc;
        }
    }
    RELAUNDER();
    {
        const bf16_t* Kw = proj + tokbase * PP + C_KVA + 512 + hkv * 64;
        const bf16_t* Vw = VT + (size_t)((2 + hkv) * 8 + b) * 64 * SEQ;
        fa_zero(o); m[0] = m[1] = -1e30f; ls[0] = ls[1] = 0.f;
        int kb0 = (q0 - 511) & ~31; if (kb0 < 0) kb0 = 0;
        {
            const bf16_t* kl = Kw + (size_t)r * PP + 8 * h; bf16x8 kf[4]; kf_load(kf, kl + (size_t)kb0 * PP);
#pragma unroll 1
            for (int kbase = kb0; kbase <= q0 + 15; kbase += 32) { const int nb = (kbase + 32 <= q0 + 15) ? kbase + 32 : kbase; fa_tile<MODE_WIN>(o, m, ls, qf, kf, kl + (size_t)nb * PP, Vw, 16, 64, kbase, r, h, qpos, 512, false, false, q0, q0 + 15); }
        }
#pragma unroll
        for (int rt = 0; rt < 2; ++rt) {
            const float lt = xsum32(ls[rt]); const float inv = lt > 0.f ? __builtin_amdgcn_rcpf(lt) : 0.f;
            const float gsc = bf2f(proj[(tokbase + qpos[rt]) * PP + C_GA + 16 + hkv * 4 + ((32 * rt + r) & 3)]) * inv;
            const int R = 32 * rt + r, gi = R & 3;
            bf16_t* yp = ya + (tokbase + qpos[rt]) * 512 + (hkv * 4 + gi) * 64;
#pragma unroll
            for (int dt = 0; dt < 2; ++dt)
#pragma unroll
                for (int a = 0; a < 4; ++a) {
                    float v[4];
#pragma unroll
                    for (int bb = 0; bb < 4; ++bb) { const int i = 4 * a + bb; v[bb] = ytot[((rt * 2 + dt) * 16 + i) * 64 + lane] + o[rt][dt][i] * gsc; }
                    u32x2 w; w.x = pk2(v[0], v[1]); w.y = pk2(v[2], v[3]);
                    *(u32x2*)(yp + 32 * dt + 8 * a + 4 * h) = w;
                }
        }
    }
    asm volatile("s_waitcnt lgkmcnt(0)" ::: "memory");
}

DI void attnB_unit(const bf16_t* proj, const bf16_t* VT, const float* sinks, bf16_t* yb, int b, int q0, int lane) {
    asm volatile("" : "+v"(lane));
    const int r = lane & 31, h = lane >> 5;
    const size_t tokbase = (size_t)b * SEQ;
    int qpos[2]; bf16x8 qf[2][4]; f32x16 o[2][2]; float m[2], ls[2];
#pragma unroll
    for (int rt = 0; rt < 2; ++rt) {
        const int R = 32 * rt + r, qi = R >> 3, gi = R & 7; qpos[rt] = q0 + qi;
        const bf16_t* qp = proj + (tokbase + qpos[rt]) * PP + C_QB + gi * 64 + 8 * h;
#pragma unroll
        for (int ks = 0; ks < 4; ++ks) qf[rt][ks] = *(const bf16x8*)(qp + 16 * ks);
        m[rt] = sinks[gi] * LOG2E; ls[rt] = (h == 0) ? 1.0f : 0.f;
    }
    fa_zero(o);
    const bf16_t* Kb = proj + tokbase * PP + C_KB;
    const bf16_t* Vb = VT + (size_t)(4 * 8 + b) * 64 * SEQ;
    int kb0 = (q0 - 127) & ~31; if (kb0 < 0) kb0 = 0;
    {
        const bf16_t* kl = Kb + (size_t)r * PP + 8 * h; bf16x8 kf[4]; kf_load(kf, kl + (size_t)kb0 * PP);
#pragma unroll 1
        for (int kbase = kb0; kbase <= q0 + 7; kbase += 32) { const int nb = (kbase + 32 <= q0 + 7) ? kbase + 32 : kbase; fa_tile<MODE_WIN>(o, m, ls, qf, kf, kl + (size_t)nb * PP, Vb, 16, 64, kbase, r, h, qpos, 128, false, false, q0, q0 + 7); }
    }
#pragma unroll
    for (int rt = 0; rt < 2; ++rt) {
        const float lt = xsum32(ls[rt]); const float inv = __builtin_amdgcn_rcpf(lt);
        const int R = 32 * rt + r, gi = R & 7;
        bf16_t* yp = yb + (tokbase + qpos[rt]) * 512 + gi * 64;
#pragma unroll
        for (int dt = 0; dt < 2; ++dt)
#pragma unroll
            for (int a = 0; a < 4; ++a) {
                u32x2 w; w.x = pk2(o[rt][dt][4 * a] * inv, o[rt][dt][4 * a + 1] * inv); w.y = pk2(o[rt][dt][4 * a + 2] * inv, o[rt][dt][4 * a + 3] * inv);
                *(u32x2*)(yp + 32 * dt + 8 * a + 4 * h) = w;
            }
    }
}

DI void compress_unit(const bf16_t* proj, const bf16_t* W1T, const bf16_t* W2T, const float* cb, const float* rope, bf16_t* kc, bf16_t* vct,
                      int j, int b, int hkv, int nch, int kpart, LAS unsigned char* ldsb, int wave, int lane) {
    asm volatile("" : "+v"(lane));
    const int fr = lane & 15, fq = lane >> 4;
    const int n0 = nch * 16; const int n = n0 + fr; const int nl = n > 254 ? 254 : n;
    const bf16_t* src = proj + ((size_t)b * SEQ + (size_t)nl * 16) * PP + C_KVA + j * 128 + hkv * 64 + fq * 8;
    const bf16_t* w1 = W1T + (size_t)j * 128 * 2048 + (size_t)fr * 2048 + fq * 8;
    f32x4 acc1[8];
#pragma unroll
    for (int ht = 0; ht < 8; ++ht) acc1[ht] = (f32x4){0.f, 0.f, 0.f, 0.f};
    const float* rp = rope + (((size_t)b * SEQ + (size_t)nl * 16) * 32 + fq * 8) * 2;
#pragma unroll 2
    for (int l = kpart * 8; l < kpart * 8 + 8; ++l) {
        bf16x8 b0 = *(const bf16x8*)(src + (size_t)l * PP), b1 = *(const bf16x8*)(src + (size_t)l * PP + 32);
        if (j == 0) {
            f32x4 x0, x1, y0, y1; pg8::unpack8(__builtin_bit_cast(u32x4, b0), x0, x1); pg8::unpack8(__builtin_bit_cast(u32x4, b1), y0, y1);
            const f32x4 cs0 = *(const f32x4*)(rp + (size_t)l * 64), cs1 = *(const f32x4*)(rp + (size_t)l * 64 + 4), cs2 = *(const f32x4*)(rp + (size_t)l * 64 + 8), cs3 = *(const f32x4*)(rp + (size_t)l * 64 + 12);
            f32x4 o0, o1, q0, q1;
            o0[0] = x0[0] * cs0[0] - y0[0] * cs0[1]; q0[0] = y0[0] * cs0[0] + x0[0] * cs0[1];
            o0[1] = x0[1] * cs0[2] - y0[1] * cs0[3]; q0[1] = y0[1] * cs0[2] + x0[1] * cs0[3];
            o0[2] = x0[2] * cs1[0] - y0[2] * cs1[1]; q0[2] = y0[2] * cs1[0] + x0[2] * cs1[1];
            o0[3] = x0[3] * cs1[2] - y0[3] * cs1[3]; q0[3] = y0[3] * cs1[2] + x0[3] * cs1[3];
            o1[0] = x1[0] * cs2[0] - y1[0] * cs2[1]; q1[0] = y1[0] * cs2[0] + x1[0] * cs2[1];
            o1[1] = x1[1] * cs2[2] - y1[1] * cs2[3]; q1[1] = y1[1] * cs2[2] + x1[1] * cs2[3];
            o1[2] = x1[2] * cs3[0] - y1[2] * cs3[1]; q1[2] = y1[2] * cs3[0] + x1[2] * cs3[1];
            o1[3] = x1[3] * cs3[2] - y1[3] * cs3[3]; q1[3] = y1[3] * cs3[2] + x1[3] * cs3[3];
            b0 = __builtin_bit_cast(bf16x8, pg8::pack8(o0, o1)); b1 = __builtin_bit_cast(bf16x8, pg8::pack8(q0, q1));
        }
#pragma unroll
        for (int ht = 0; ht < 8; ++ht) {
            const bf16x8 a0 = *(const bf16x8*)(w1 + (size_t)ht * 16 * 2048 + (2 * l) * 32);
            const bf16x8 a1 = *(const bf16x8*)(w1 + (size_t)ht * 16 * 2048 + (2 * l + 1) * 32);
            acc1[ht] = MFMA16(a0, b0, acc1[ht]);
            acc1[ht] = MFMA16(a1, b1, acc1[ht]);
        }
    }
    {
        LAS float* mine = (LAS float*)(ldsb + wave * LDS_WAVE);
#pragma unroll
        for (int ht = 0; ht < 8; ++ht)
#pragma unroll
            for (int i = 0; i < 4; ++i) mine[(ht * 4 + i) * 64 + lane] = acc1[ht][i];
    }
    __syncthreads();
    if (kpart == 0) {
#pragma unroll
    for (int p = 1; p < 4; ++p) {
        const LAS float* oth = (const LAS float*)(ldsb + (wave + p) * LDS_WAVE);
#pragma unroll
        for (int ht = 0; ht < 8; ++ht)
#pragma unroll
            for (int i = 0; i < 4; ++i) acc1[ht][i] += oth[(ht * 4 + i) * 64 + lane];
    }
    const float* cbj = cb + j * 128;
#pragma unroll
    for (int ht = 0; ht < 8; ++ht)
#pragma unroll
        for (int i = 0; i < 4; ++i) acc1[ht][i] = gelu_tanh(acc1[ht][i] + cbj[16 * ht + 4 * fq + i]);
    f32x4 acc2[4];
#pragma unroll
    for (int ot = 0; ot < 4; ++ot) acc2[ot] = (f32x4){0.f, 0.f, 0.f, 0.f};
    const bf16_t* w2 = W2T + (size_t)j * 64 * 128;
#pragma unroll
    for (int s = 0; s < 4; ++s) {
        u32x4 w; w.x = pk2(acc1[2 * s][0], acc1[2 * s][1]); w.y = pk2(acc1[2 * s][2], acc1[2 * s][3]); w.z = pk2(acc1[2 * s + 1][0], acc1[2 * s + 1][1]); w.w = pk2(acc1[2 * s + 1][2], acc1[2 * s + 1][3]);
        const bf16x8 bfr = __builtin_bit_cast(bf16x8, w);
#pragma unroll
        for (int ot = 0; ot < 4; ++ot) {
            const bf16_t* ap = w2 + (size_t)(ot * 16 + fr) * 128 + 32 * s + 4 * fq;
            const s16x4 lo = *(const s16x4*)ap, hi = *(const s16x4*)(ap + 16);
            const bf16x8 afr = (bf16x8){lo[0], lo[1], lo[2], lo[3], hi[0], hi[1], hi[2], hi[3]};
            acc2[ot] = MFMA16(afr, bfr, acc2[ot]);
        }
    }
    const bool live = n <= 254;
    if (j == 0) {
        bf16_t* dst = kc + ((size_t)(b * 2 + hkv) * 256 + n) * 64;
#pragma unroll
        for (int ot = 0; ot < 4; ++ot) { u32x2 w; w.x = live ? pk2(acc2[ot][0], acc2[ot][1]) : 0u; w.y = live ? pk2(acc2[ot][2], acc2[ot][3]) : 0u; *(u32x2*)(dst + 16 * ot + 4 * fq) = w; }
    } else {
        bf16_t* dst = vct + (size_t)(b * 2 + hkv) * 64 * 256 + (size_t)nch * 1024 + perm16(fr);
#pragma unroll
        for (int ot = 0; ot < 4; ++ot)
#pragma unroll
            for (int i = 0; i < 4; ++i) dst[(16 * ot + 4 * fq + i) * 16] = live ? (bf16_t)(pk2(acc2[ot][i], 0.f) & 0xffffu) : (bf16_t)0;
    }
    }
    __syncthreads();
}

struct S5In { const float *a_re, *a_im, *log_dt, *b_re, *b_im, *c_re, *c_im, *d; };
DI void cplx_abar(const S5In& P, int g, int p, float dt, float& abr, float& abi, float& cfr, float& cfi) {
    const float ar = P.a_re[g * 64 + p], ai = P.a_im[g * 64 + p];
    const float mag = expf(dt * ar); abr = mag * cosf(dt * ai); abi = mag * sinf(dt * ai);
    const float den = ar * ar + ai * ai, nr = abr - 1.0f, ni = abi;
    cfr = (nr * ar + ni * ai) / den; cfi = (ni * ar - nr * ai) / den;
}
template <bool OUT>
DI void s5_unit(const S5In& P, bf16_t* proj, float* states, int b, int g, int c, int nsc, LAS unsigned char* wl, int lane) {
    asm volatile("" : "+v"(lane));
    const int r = lane & 31, h = lane >> 5, fr = lane & 15, fq = lane >> 4;
    const float dt = expf(P.log_dt[g]);
    float abr, abi, t0, t1; cplx_abar(P, g, lane, dt, abr, abi, t0, t1);
    bf16x8 bfrag[4];
#pragma unroll
    for (int hs = 0; hs < 2; ++hs) {
        const int p = r + 32 * hs; float a0, a1, cr, ci; cplx_abar(P, g, p, dt, a0, a1, cr, ci);
        const float* br = P.b_re + ((size_t)g * 64 + p) * 16 + 8 * h; const float* bi = P.b_im + ((size_t)g * 64 + p) * 16 + 8 * h;
        float re[8], im[8];
#pragma unroll
        for (int j = 0; j < 8; ++j) { re[j] = cr * br[j] - ci * bi[j]; im[j] = cr * bi[j] + ci * br[j]; }
        u32x4 wr_, wi_; wr_.x = pk2(re[0], re[1]); wr_.y = pk2(re[2], re[3]); wr_.z = pk2(re[4], re[5]); wr_.w = pk2(re[6], re[7]);
        wi_.x = pk2(im[0], im[1]); wi_.y = pk2(im[2], im[3]); wi_.z = pk2(im[4], im[5]); wi_.w = pk2(im[6], im[7]);
        bfrag[hs] = __builtin_bit_cast(bf16x8, wr_); bfrag[2 + hs] = __builtin_bit_cast(bf16x8, wi_);
    }
    bf16x8 cfrag[4]; float dch = 0.f;
    if (OUT) {
#pragma unroll
        for (int ks = 0; ks < 4; ++ks) {
            const float* cr = P.c_re + ((size_t)g * 16 + fr) * 64 + 16 * ks + 4 * fq; const float* ci = P.c_im + ((size_t)g * 16 + fr) * 64 + 16 * ks + 4 * fq;
            u32x4 w; w.x = pk2(cr[0], -ci[0]); w.y = pk2(cr[1], -ci[1]); w.z = pk2(cr[2], -ci[2]); w.w = pk2(cr[3], -ci[3]);
            cfrag[ks] = __builtin_bit_cast(bf16x8, w);
        }
        dch = P.d[g * 16 + fr];
    }
    float xr = 0.f, xi = 0.f;
    if (OUT) {
        float pr = abr, pi = abi;
#pragma unroll
        for (int q = 0; q < 9; ++q) { const float nr = pr * pr - pi * pi, ni = 2.0f * pr * pi; pr = nr; pi = ni; }
#ifndef DBG_NOSTATE
        for (int cc = 0; cc < c; ++cc) {
            const float* sp = states + ((((size_t)b * 32 + g) * 8 + cc) * 64 + lane) * 2;
            const float sr = sp[0], si = sp[1];
            const float nr = pr * xr - pi * xi + sr, ni = pr * xi + pi * xr + si; xr = nr; xi = ni;
        }
#endif
    }
    LAS float* bu = (LAS float*)wl;
    bf16_t* ucol = proj + ((size_t)b * SEQ + (size_t)c * 512) * PP + C_U + g * 16;
    bf16x8 ufr_n = *(const bf16x8*)(ucol + (size_t)r * PP + 8 * h);
    LAS bf16_t* uimg = (LAS bf16_t*)(wl + 16896);
#pragma unroll 1
    for (int sc = 0; sc < nsc; ++sc) {
        bf16_t* ub = ucol + (size_t)sc * 32 * PP;
        const bf16x8 ufr = ufr_n;
        if (OUT) *(LAS bf16x8*)(uimg + r * 16 + 8 * h) = ufr;
        {
            const bf16_t* un = ucol + (size_t)(sc + 1 < nsc ? sc + 1 : sc) * 32 * PP;
            ufr_n = *(const bf16x8*)(un + (size_t)r * PP + 8 * h);
        }
#pragma unroll
        for (int nt = 0; nt < 4; ++nt) {
            f32x16 d;
#pragma unroll
            for (int i = 0; i < 16; ++i) d[i] = 0.f;
            d = MFMA32(ufr, bfrag[nt], d);
#pragma unroll
            for (int i = 0; i < 16; ++i) bu[crow(i, h) * 132 + 32 * nt + r] = d[i];
        }
        asm volatile("s_waitcnt lgkmcnt(0)" ::: "memory");
#pragma unroll 8
        for (int t = 0; t < 32; ++t) {
            const float br_ = bu[t * 132 + lane], bi_ = bu[t * 132 + 64 + lane];
            const float nr = abr * xr - abi * xi + br_, ni = abr * xi + abi * xr + bi_; xr = nr; xi = ni;
            if (OUT) {
                ((LAS unsigned*)(bu + t * 132))[lane] = pk2(xr, xi);
            }
        }
        if (OUT) {
            asm volatile("s_waitcnt lgkmcnt(0)" ::: "memory");
#pragma unroll
            for (int mt = 0; mt < 2; ++mt) {
                f32x4 y = (f32x4){0.f, 0.f, 0.f, 0.f};
#pragma unroll
                for (int ks = 0; ks < 4; ++ks) {
                    const bf16x8 xa = *(const LAS bf16x8*)((LAS unsigned char*)bu + (mt * 16 + fr) * 528 + ks * 64 + fq * 16);
                    y = MFMA16(xa, cfrag[ks], y);
                }
#pragma unroll
                for (int i = 0; i < 4; ++i) {
                    LAS bf16_t* e = uimg + (mt * 16 + 4 * fq + i) * 16 + fr;
                    const float yy = y[i] + dch * bf2f(*e);
                    *e = (bf16_t)(pk2(gelu_tanh(yy), 0.f) & 0xffffu);
                }
            }
            asm volatile("s_waitcnt lgkmcnt(0)" ::: "memory");
            {
                const bf16x8 zv = *(const LAS bf16x8*)(uimg + lane * 8);
                *(bf16x8*)(ub + (size_t)(lane >> 1) * PP + 8 * (lane & 1)) = zv;
            }
            asm volatile("s_waitcnt lgkmcnt(0)" ::: "memory");
        }
    }
    if (!OUT) { float* sp = states + ((((size_t)b * 32 + g) * 8 + c) * 64 + lane) * 2; sp[0] = xr; sp[1] = xi; }
}

template <bool OUT_F32>
DI void rmsnorm_rows(const float* src, const float* gain, bf16_t* dstb, float* dstf, float* copy, int gw, int nw, int lane) {
    f32x4 gv[4];
#pragma unroll
    for (int i = 0; i < 4; ++i) gv[i] = *(const f32x4*)(gain + 256 * i + 4 * lane);
#pragma unroll 2
    for (int row = gw; row < T; row += nw) {
        const float* xp = src + (size_t)row * DM + 4 * lane;
        f32x4 v[4]; float ss = 0.f;
#pragma unroll
        for (int i = 0; i < 4; ++i) { v[i] = *(const f32x4*)(xp + 256 * i); ss += v[i][0] * v[i][0] + v[i][1] * v[i][1] + v[i][2] * v[i][2] + v[i][3] * v[i][3]; }
        ss = wave_sum(ss, lane);
        const float rs = rsqrtf(ss * (1.0f / 1024.0f) + NORM_EPS);
#pragma unroll
        for (int i = 0; i < 4; ++i) {
            if (copy) *(f32x4*)(copy + (size_t)row * DM + 256 * i + 4 * lane) = v[i];
            const f32x4 y = v[i] * rs * gv[i];
            if (OUT_F32) *(f32x4*)(dstf + (size_t)row * DM + 256 * i + 4 * lane) = y;
            else { u32x2 w; w.x = pk2(y[0], y[1]); w.y = pk2(y[2], y[3]); *(u32x2*)(dstb + (size_t)row * DM + 256 * i + 4 * lane) = w; }
        }
    }
}

DI int in_srccol(int n) { return n < 1280 ? n : (n < 2432 ? n + 24 : (n < 2456 ? n - 1152 : (n < 2560 ? -1 : n - 104))); }

#define XB_TMO      128
#define XB_XCNT(j)  (256  + 64 * (j))
#define XB_XSUB(j)  (1280 + 64 * (j))
#define XB_XGEN(j)  (2304 + 64 * (j))
#define XB_TOP      3328
#define XB_TOPGEN   3392
#define XB_SPIN_CAP (1u << 18)
DI unsigned xb_ld(unsigned* p)              { return __hip_atomic_load(p, __ATOMIC_RELAXED, __HIP_MEMORY_SCOPE_AGENT); }
DI unsigned xb_add(unsigned* p, unsigned v) { return __hip_atomic_fetch_add(p, v, __ATOMIC_RELAXED, __HIP_MEMORY_SCOPE_AGENT); }
DI unsigned xb_xcc_id() { return (unsigned)__builtin_amdgcn_s_getreg((3 << 11) | 20) & 0xFu; }
#define XB_SPIN(cond, bar) do { unsigned _sp = 0; while (cond) { __builtin_amdgcn_s_sleep(1); \
    if ((++_sp & 255u) == 0u) { if (xb_ld(&(bar)[XB_TMO])) break; if (_sp > XB_SPIN_CAP) { atomicAdd(&(bar)[XB_TMO], 1u); break; } } } } while (0)
DI void xcd_barrier_complete(unsigned* bar, unsigned x, unsigned G, unsigned& nloc, unsigned& nx) {
    unsigned sum, cnt, mine, sp = 0u;
    for (;;) {
        sum = 0u; cnt = 0u; mine = 0u;
#pragma unroll
        for (unsigned j = 0; j < 16; ++j) { const unsigned c = xb_ld(&bar[XB_XCNT(j)]); sum += c; cnt += (c > 0u) ? 1u : 0u; mine = (j == x) ? c : mine; }
        if (sum == G) break;
        __builtin_amdgcn_s_sleep(1);
        if ((++sp & 255u) == 0u) { if (xb_ld(&bar[XB_TMO])) break; if (sp > XB_SPIN_CAP) { atomicAdd(&bar[XB_TMO], 1u); break; } }
    }
    nloc = mine > 0u ? mine : 1u; nx = cnt > 0u ? cnt : 1u;
}
DI void xcd_barrier(unsigned* bar, volatile LAS unsigned* st, bool t0, unsigned G) {
    asm volatile("s_waitcnt vmcnt(0)" ::: "memory");
    __syncthreads();
    if (t0) {
        const unsigned x = xb_xcc_id();
        __builtin_amdgcn_s_waitcnt(0);
        unsigned nloc = st[0], nx = st[1];
        if (nloc == 0u) { xcd_barrier_complete(bar, x, G, nloc, nx); st[0] = nloc; st[1] = nx; }
        const unsigned old = xb_add(&bar[XB_XSUB(x)], 1u);
        const unsigned gen = old / nloc;
        if (old + 1u == (gen + 1u) * nloc) {
            __builtin_amdgcn_fence(__ATOMIC_RELEASE, "agent");
            asm volatile("s_waitcnt vmcnt(0)" ::: "memory");
            const unsigned og = xb_add(&bar[XB_TOP], 1u);
            const unsigned tg = og / nx;
            if (og + 1u == (tg + 1u) * nx) xb_add(&bar[XB_TOPGEN], 1u);
            else XB_SPIN(xb_ld(&bar[XB_TOPGEN]) == tg, bar);
            __builtin_amdgcn_fence(__ATOMIC_ACQUIRE, "agent");
            xb_add(&bar[XB_XGEN(x)], 1u);
            asm volatile("s_waitcnt vmcnt(0)" ::: "memory");
        } else {
            XB_SPIN(xb_ld(&bar[XB_XGEN(x)]) == gen, bar);
            __builtin_amdgcn_fence(__ATOMIC_ACQUIRE, "agent");
            asm volatile("s_waitcnt vmcnt(0)" ::: "memory");
        }
    }
    __syncthreads();
}

struct Args { const float* in[26]; float* out; unsigned char* ws; int ph_lo, ph_hi; };
constexpr int NPH = DEPTH * 11 + 1;

__global__ void __launch_bounds__(512, 2) mega_fwd(Args a) {
    extern __shared__ __attribute__((aligned(16))) unsigned char lds_raw[];
    LAS unsigned char* lds = (LAS unsigned char*)lds_raw;
    cg::grid_group grid = cg::this_grid();
    const int G = gridDim.x, bx = blockIdx.x;
    const int ph_lo = a.ph_lo, ph_hi = a.ph_hi;
    const int wave0 = __builtin_amdgcn_readfirstlane(threadIdx.x >> 6);
    {
        int ln0; asm volatile("v_mbcnt_lo_u32_b32 %0, -1, 0\n\tv_mbcnt_hi_u32_b32 %0, -1, %0" : "=v"(ln0));
        if (wave0 == 0 && ln0 == 0) {
            volatile LAS unsigned* xst = (volatile LAS unsigned*)(lds + LDS_XB); xst[0] = 0u; xst[1] = 0u;
            (void)xb_add(&((unsigned*)(a.ws + OFF_BAR))[XB_XCNT(xb_xcc_id())], 1u);
        }
        __syncthreads();
    }
#define PH_LOCALS \
    int lane_v; asm volatile("v_mbcnt_lo_u32_b32 %0, -1, 0\n\tv_mbcnt_hi_u32_b32 %0, -1, %0" : "=v"(lane_v)); int wave_s = wave0; asm volatile("" : "+s"(wave_s)); \
    const int lane = lane_v, wave = wave_s, tid = wave * 64 + lane; \
    const int gw = bx * 8 + wave, nw = G * 8; (void)gw; (void)nw; (void)lane; \
    const Args* ap = (const Args*)__builtin_amdgcn_kernarg_segment_ptr(); asm volatile("" : "+s"(ap)); \
    unsigned char* ws = as_global(ap->ws); float* X = as_global(ap->out); (void)X; \
    bf16_t* WIN = (bf16_t*)(ws + OFF_WIN); bf16_t* WUP = (bf16_t*)(ws + OFF_WUP); bf16_t* WDN = (bf16_t*)(ws + OFF_WDN); bf16_t* WOUT = (bf16_t*)(ws + OFF_WOUT); \
    bf16_t* WBR = (bf16_t*)(ws + OFF_WBR); bf16_t* WGLU = (bf16_t*)(ws + OFF_WGLU); bf16_t* WC1 = (bf16_t*)(ws + OFF_WC1); bf16_t* WC2 = (bf16_t*)(ws + OFF_WC2); \
    float* CB = (float*)(ws + OFF_CB); float* S5S = (float*)(ws + OFF_S5S); bf16_t* KC = (bf16_t*)(ws + OFF_KC); bf16_t* VCT = (bf16_t*)(ws + OFF_VCT); \
    float* ROPE = (float*)(ws + OFF_ROPE); \
    bf16_t* Hb = (bf16_t*)(ws + OFF_HY); bf16_t* YA = (bf16_t*)(ws + OFF_HY); bf16_t* YB = (bf16_t*)(ws + OFF_HY + YSZ); bf16_t* YC = (bf16_t*)(ws + OFF_HY + 2 * YSZ); \
    bf16_t* VT = YC; bf16_t* PROJ = (bf16_t*)(ws + OFF_PROJ); bf16_t* GG = (bf16_t*)(ws + OFF_G); bf16_t* MG = PROJ; bf16_t* HID = PROJ; \
    LAS unsigned char* wl = lds + wave * LDS_WAVE; \
    (void)WIN; (void)WUP; (void)WDN; (void)WOUT; (void)WBR; (void)WGLU; (void)WC1; (void)WC2; (void)CB; (void)S5S; (void)KC; (void)VCT; (void)ROPE; (void)Hb; (void)YA; (void)YB; (void)YC; (void)VT; (void)PROJ; (void)GG; (void)MG; (void)HID; (void)wl;

#define INP(k) as_global(ap->in[k])
#define PH_BEGIN(p) if (ph_lo <= (p) && (p) < ph_hi) { PH_LOCALS
#define PH_SYNC_CG do { asm volatile("s_waitcnt vmcnt(0)" ::: "memory"); __syncthreads(); if (wave0 == 0) { __builtin_amdgcn_fence(__ATOMIC_RELEASE, "agent"); asm volatile("s_waitcnt vmcnt(0)" ::: "memory"); } __syncthreads(); grid.sync(); if (wave0 == 0) { __builtin_amdgcn_fence(__ATOMIC_ACQUIRE, "agent"); asm volatile("s_waitcnt vmcnt(0)" ::: "memory"); } __syncthreads(); } while (0)
#define PH_SYNC_XCD do { int ln_; asm volatile("v_mbcnt_lo_u32_b32 %0, -1, 0\n\tv_mbcnt_hi_u32_b32 %0, -1, %0" : "=v"(ln_)); const Args* ap_ = (const Args*)__builtin_amdgcn_kernarg_segment_ptr(); asm volatile("" : "+s"(ap_)); \
    xcd_barrier((unsigned*)(ap_->ws + OFF_BAR), (volatile LAS unsigned*)(lds + LDS_XB), wave0 == 0 && ln_ == 0, (unsigned)G); } while (0)
#define PH_END(p) } if (ph_lo <= (p) && (p) + 1 < ph_hi) { PH_SYNC_XCD; }

    if (ph_hi - ph_lo > 1) grid.sync();
#pragma unroll 1
    for (int l = 0; l < DEPTH; ++l) {
        const int pb = l * 11;
        PH_BEGIN(pb + 0)
            LAS float* scr = (LAS float*)lds;
            for (int it = bx; it < 4294; it += G) {
                if (it >= 4292) {
                    const int j = it - 4292; const int hid = tid & 127, part = tid >> 7;
                    const float* pos = INP(4) + (size_t)(l * 2 + j) * 2048; const float* w1 = INP(5) + (size_t)(l * 2 + j) * 2048 * 128;
                    float s = 0.f;
                    for (int kk = part * 512; kk < part * 512 + 512; ++kk) s += pos[kk] * w1[(size_t)kk * 128 + hid];
                    scr[part * 128 + hid] = s;
                    __syncthreads();
                    if (tid < 128) CB[j * 128 + tid] = scr[tid] + scr[128 + tid] + scr[256 + tid] + scr[384 + tid];
                    __syncthreads();
                    continue;
                }
                int rr = it; const float* W; bf16_t* WT; int K, N, tn; bool remap = false;
                if (rr < 1408) { W = INP(3) + (size_t)l * 1024 * 5528; WT = WIN; K = 1024; N = 5528; tn = 88; remap = true; }
                else if ((rr -= 1408) < 1024) { W = INP(23) + (size_t)l * 1024 * 4096; WT = WUP; K = 1024; N = 4096; tn = 64; }
                else if ((rr -= 1024) < 1024) { W = INP(24) + (size_t)l * 4096 * 1024; WT = WDN; K = 4096; N = 1024; tn = 16; }
                else if ((rr -= 1024) < 256) { W = INP(21) + (size_t)l * 1024 * 1024; WT = WOUT; K = 1024; N = 1024; tn = 16; }
                else if ((rr -= 256) < 384) { const int br = rr / 128; rr %= 128; W = INP(18 + br) + (size_t)l * 512 * 1024; WT = WBR + (size_t)br * 1024 * 512; K = 512; N = 1024; tn = 16; }
                else if ((rr -= 384) < 64) { W = INP(16) + (size_t)l * 512 * 512; WT = WGLU; K = 512; N = 512; tn = 8; }
                else if ((rr -= 64) < 128) { const int j = rr / 64; rr %= 64; W = INP(5) + (size_t)(l * 2 + j) * 2048 * 128; WT = WC1 + (size_t)j * 128 * 2048; K = 2048; N = 128; tn = 2; }
                else { rr -= 128; const int j = rr / 2; rr %= 2; W = INP(6) + (size_t)(l * 2 + j) * 128 * 64; WT = WC2 + (size_t)j * 64 * 128; K = 128; N = 64; tn = 1; }
                const int k0 = (rr / tn) * 64, n0 = (rr % tn) * 64;
                {
                    const int tx = tid & 63, ty = tid >> 6; const int nn = n0 + tx; const int sc = remap ? in_srccol(nn) : nn;
#pragma unroll
                    for (int q = 0; q < 8; ++q) { const int k = k0 + ty * 8 + q; scr[(ty * 8 + q) * 65 + tx] = sc >= 0 ? W[(size_t)k * N + sc] : 0.f; }
                }
                __syncthreads();
                {
                    const int nn = tid >> 3, kc = (tid & 7) * 8;
                    f32x4 v0, v1;
#pragma unroll
                    for (int q = 0; q < 4; ++q) { v0[q] = scr[(kc + q) * 65 + nn]; v1[q] = scr[(kc + 4 + q) * 65 + nn]; }
                    *(u32x4*)(WT + (size_t)(n0 + nn) * K + k0 + kc) = pg8::pack8(v0, v1);
                }
                __syncthreads();
            }
            if (l == 0 && bx == 0 && tid < 64) ((unsigned*)(ws + OFF_CB + 2048))[tid] = 0u;
            if (l == 0) {
                const int* positions = (const int*)INP(1);
                for (int idx = bx * 512 + tid; idx < T * 32; idx += 131072) {
                    const int t = idx >> 5, i = idx & 31;
                    const float invf = exp2f(-(float)i * 0.41524101186092029f);
                    const float ang = (float)positions[t] * invf;
                    ROPE[2 * idx] = cosf(ang); ROPE[2 * idx + 1] = sinf(ang);
                }
                rmsnorm_rows<false>(INP(0), INP(2), Hb, nullptr, X, gw, nw, lane);
            } else {
                rmsnorm_rows<false>(X, INP(2) + (size_t)l * DM, Hb, nullptr, nullptr, gw, nw, lane);
            }
        PH_END(pb + 0)
        PH_BEGIN(pb + 1)
            pg8::Gemm g{Hb, WIN, T, NIN, DM, DM, 0, 0}; pg8::StaticOrder S; S.init(T, NIN, G, bx);
            pg8::EpiIn E{PROJ, GG};
            pg8::gemm_phase(lds, g, S, E, tid);
        PH_END(pb + 1)
        PH_BEGIN(pb + 2)
            { const int u = bx * 2 + (wave >> 2); compress_unit(PROJ, WC1, WC2, CB, ROPE, KC, VCT, u >> 8, (u >> 5) & 7, (u >> 4) & 1, u & 15, wave & 3, lds, wave, lane); }
            {
                LAS bf16_t* tile = (LAS bf16_t*)lds;
                for (int it = bx; it < 5 * 8 * 64; it += G) {
                    const int slot = it / 512, b = (it / 64) % 8, st = it % 64;
                    const int vcol = slot < 4 ? C_KVA + (1 + (slot >> 1)) * 256 + 128 + (slot & 1) * 64 : C_VB;
                    {
                        const int tok = tid >> 3, dc = (tid & 7) * 8;
                        const bf16x8 v = *(const bf16x8*)(PROJ + ((size_t)b * SEQ + st * 64 + tok) * PP + vcol + dc);
#pragma unroll
                        for (int j = 0; j < 8; ++j) tile[(dc + j) * 72 + perm16(tok)] = (bf16_t)v[j];
                    }
                    __syncthreads();
                    {
                        const int d = tid >> 3, tc = (tid & 7) * 8;
                        const bf16x8 v = *(const LAS bf16x8*)(tile + d * 72 + tc);
                        *(bf16x8*)(VT + (size_t)(slot * 8 + b) * 64 * SEQ + (size_t)(st * 4 + (tc >> 4)) * 1024 + d * 16 + (tc & 8)) = v;
                    }
                    __syncthreads();
                }
            }
            for (int idx = bx * 512 + tid; idx < T * 84; idx += 131072) {
                const int t = idx / 84, rem = idx % 84, head = rem >> 2, ch = rem & 3;
                int col;
                if (head < 8) col = C_QA + head * 64; else if (head < 12) { const int hh = head - 8; col = C_KVA + (1 + (hh >> 1)) * 256 + (hh & 1) * 64; }
                else if (head < 20) col = C_QB + (head - 12) * 64; else col = C_KB;
                bf16_t* p = PROJ + (size_t)t * PP + col + 8 * ch;
                f32x4 a0, a1, b0, b1; pg8::unpack8(*(const u32x4*)p, a0, a1); pg8::unpack8(*(const u32x4*)(p + 32), b0, b1);
                const float* cs = ROPE + ((size_t)t * 32 + 8 * ch) * 2;
                f32x4 o0, o1, q0, q1;
#pragma unroll
                for (int j = 0; j < 4; ++j) {
                    const float c0 = cs[2 * j], s0 = cs[2 * j + 1], c1 = cs[2 * (j + 4)], s1 = cs[2 * (j + 4) + 1];
                    o0[j] = a0[j] * c0 - b0[j] * s0; q0[j] = b0[j] * c0 + a0[j] * s0;
                    o1[j] = a1[j] * c1 - b1[j] * s1; q1[j] = b1[j] * c1 + a1[j] * s1;
                }
                *(u32x4*)p = pg8::pack8(o0, o1); *(u32x4*)(p + 32) = pg8::pack8(q0, q1);
            }
            {
                const S5In P{INP(8) + (size_t)l * 2048, INP(9) + (size_t)l * 2048, INP(10) + (size_t)l * 32, INP(11) + (size_t)l * 32768, INP(12) + (size_t)l * 32768,
                             INP(13) + (size_t)l * 32768, INP(14) + (size_t)l * 32768, INP(15) + (size_t)l * 512};
            }
        PH_END(pb + 2)
        PH_BEGIN(pb + 4)
            {
                const S5In P{INP(8) + (size_t)l * 2048, INP(9) + (size_t)l * 2048, INP(10) + (size_t)l * 32, INP(11) + (size_t)l * 32768, INP(12) + (size_t)l * 32768,
                             INP(13) + (size_t)l * 32768, INP(14) + (size_t)l * 32768, INP(15) + (size_t)l * 512};
                if (bx < 64 && wave < 4) s5_unit<true>(P, PROJ, S5S, bx >> 3, 4 * (bx & 7) + wave, 0, 128, wl, lane);
            }
            {
                unsigned* xbw = (unsigned*)(ws + OFF_BAR);
                const unsigned xme = xb_xcc_id(); unsigned rk = 0, nx = 0;
#pragma unroll
                for (unsigned j = 0; j < 16; ++j) { const unsigned c = xb_ld(&xbw[XB_XCNT(j)]); if (c) { rk += (j < xme) ? 1u : 0u; ++nx; } }
                rk = __builtin_amdgcn_readfirstlane(rk); nx = __builtin_amdgcn_readfirstlane(nx); if (nx == 0u) nx = 1u;
                const unsigned nbA = rk < 16u ? (16u - rk + nx - 1u) / nx : 0u, nbB = rk < 8u ? (8u - rk + nx - 1u) / nx : 0u;
                const unsigned totA = nbA * 256u, totB = nbB * 512u;
                unsigned* ctr = (unsigned*)(ws + OFF_CB + 2048) + l * 16 + rk;
                for (;;) {
                    unsigned i = 0;
                    if (lane == 0) i = atomicAdd(ctr, 1u);
                    i = __builtin_amdgcn_readfirstlane(i);
                    if (i >= totA + totB) break;
                    if (i < totA) {
                        const unsigned g8 = i >> 3, bl = g8 % nbA, q8 = g8 / nbA;
                        const int bh = (int)(rk + nx * bl), qt = (31 - (int)q8) * 8 + (int)(i & 7u);
                        attnA_unit(PROJ, KC, VCT, VT, YA, bh >> 1, bh & 1, qt * 16, wl, lane);
                    } else {
                        const unsigned u = i - totA; const int b = (int)(rk + nx * (u >> 9));
                        attnB_unit(PROJ, VT, INP(7) + (size_t)l * 8, YB, b, (int)(u & 511u) * 8, lane);
                    }
                }
            }
        PH_END(pb + 4)
        PH_BEGIN(pb + 5)
            pg8::Gemm g{PROJ + C_U, WGLU, T, 512, 512, PP, 0, 0}; pg8::StaticOrder S; S.init(T, 512, G, bx);
            pg8::EpiGlu E{PROJ + C_U, INP(17) + (size_t)l * 512, YC};
            pg8::gemm_phase(lds, g, S, E, tid);
        PH_END(pb + 5)
        PH_BEGIN(pb + 6)
            pg8::Gemm g{YA, WBR, T, DM, 512, 512, YSZ, (size_t)DM * 512 * 2}; pg8::Z3Order S; S.init(T, DM, G, bx);
            pg8::EpiMerge E{GG, MG};
            pg8::gemm_phase(lds, g, S, E, tid);
        PH_END(pb + 6)
        PH_BEGIN(pb + 7)
            pg8::Gemm g{MG, WOUT, T, DM, DM, DM, 0, 0}; pg8::StaticOrder S; S.init(T, DM, G, bx);
            pg8::EpiResid E{X};
            pg8::gemm_phase(lds, g, S, E, tid);
        PH_END(pb + 7)
        PH_BEGIN(pb + 8)
            rmsnorm_rows<false>(X, INP(22) + (size_t)l * DM, Hb, nullptr, nullptr, gw, nw, lane);
        PH_END(pb + 8)
        PH_BEGIN(pb + 9)
            pg8::Gemm g{Hb, WUP, T, DFF, DM, DM, 0, 0}; pg8::StaticOrder S; S.init(T, DFF, G, bx);
            pg8::EpiUp E{HID};
            pg8::gemm_phase(lds, g, S, E, tid);
        PH_END(pb + 9)
        PH_BEGIN(pb + 10)
            pg8::Gemm g{HID, WDN, T, DM, DFF, DFF, 0, 0}; pg8::StaticOrder S; S.init(T, DM, G, bx);
            pg8::EpiResid E{X};
            pg8::gemm_phase(lds, g, S, E, tid);
        PH_END(pb + 10)
    }
    PH_BEGIN(NPH - 1)
        rmsnorm_rows<true>(X, INP(25), nullptr, X, nullptr, gw, nw, lane);
    }
}

extern "C" void kernel_launch(void* const* d_in, const int* in_sizes, int n_in, void* d_out, int out_size, void* d_ws, size_t ws_size, hipStream_t stream) {
    static int ready = 0;
    if (ready == 0) {
        if (n_in != 26 || out_size != T * DM || ws_size < WS_END + BAR_BYTES) { fprintf(stderr, "kernel_launch: unexpected shapes (n_in %d out %d ws %zu need %zu)\n", n_in, out_size, ws_size, (size_t)WS_END); ready = -1; return; }
        if (hipFuncSetAttribute((const void*)mega_fwd, hipFuncAttributeMaxDynamicSharedMemorySize, LDS_BYTES) != hipSuccess) { fprintf(stderr, "kernel_launch: hipFuncSetAttribute failed\n"); ready = -1; return; }
        ready = 1;
    }
    if (ready < 0) return;
#ifdef DBG_MEMSET
    hipMemsetAsync(d_ws, 0xAA, WS_END, stream); hipMemsetAsync(d_out, 0xAA, (size_t)T * DM * 4, stream);
#endif
    if (hipMemsetAsync((unsigned char*)d_ws + OFF_BAR, 0, BAR_BYTES, stream) != hipSuccess) { fprintf(stderr, "kernel_launch: barrier memset failed\n"); return; }
    Args a{};
    for (int i = 0; i < 26; ++i) a.in[i] = (const float*)d_in[i];
    a.out = (float*)d_out; a.ws = (unsigned char*)d_ws;
#if MK_MULTI
    for (int p = 0; p < NPH; ++p) { a.ph_lo = p; a.ph_hi = p + 1; hipLaunchKernelGGL(mega_fwd, dim3(256), dim3(512), LDS_BYTES, stream, a); }
#else
    a.ph_lo = 0; a.ph_hi = NPH;
    void* args[] = {&a};
    hipError_t e = hipLaunchCooperativeKernel((const void*)mega_fwd, dim3(256), dim3(512), args, LDS_BYTES, stream);
    if (e != hipSuccess) fprintf(stderr, "cooperative launch failed: %s\n", hipGetErrorString(e));
#endif
}
```

```cpp
#include <hip/hip_runtime.h>
#include <hip/hip_cooperative_groups.h>
#include <cstdio>
#include <cstdint>
namespace cg = cooperative_groups;

typedef unsigned short bf16_t;
typedef short bf16x8 __attribute__((ext_vector_type(8)));
typedef short s16x4 __attribute__((ext_vector_type(4)));
typedef float f32x4 __attribute__((ext_vector_type(4)));
typedef float f32x16 __attribute__((ext_vector_type(16)));
typedef unsigned u32x4 __attribute__((ext_vector_type(4)));
typedef unsigned u32x2 __attribute__((ext_vector_type(2)));
typedef __bf16 bf16x2_t __attribute__((ext_vector_type(2)));
typedef float f32x2_t __attribute__((ext_vector_type(2)));
#define LAS __attribute__((address_space(3)))
#define DI __device__ __forceinline__

#ifndef MK_MULTI
#define MK_MULTI 0
#endif
#ifndef DBG_MASK
#define DBG_MASK 7
#endif

constexpr int T = 32768, SEQ = 4096, NBATCH = 8, DM = 1024, PP = 2560, NGM = 3072, NIN = 5632, DFF = 4096, DEPTH = 4;
constexpr int C_QA = 0, C_KVA = 512, C_QB = 1280, C_KB = 1792, C_VB = 1856, C_U = 1920, C_GA = 2432;
constexpr float NORM_EPS = 1e-6f;
constexpr float SC2 = 0.125f * 1.4426950408889634f;
constexpr float LOG2E = 1.4426950408889634f;

constexpr size_t OFF_WIN = 0;
constexpr size_t OFF_WUP = OFF_WIN + (size_t)NIN * DM * 2;
constexpr size_t OFF_WDN = OFF_WUP + (size_t)DFF * DM * 2;
constexpr size_t OFF_WOUT = OFF_WDN + (size_t)DFF * DM * 2;
constexpr size_t OFF_WBR = OFF_WOUT + (size_t)DM * DM * 2;
constexpr size_t OFF_WGLU = OFF_WBR + (size_t)3 * DM * 512 * 2;
constexpr size_t OFF_WC1 = OFF_WGLU + (size_t)512 * 512 * 2;
constexpr size_t OFF_WC2 = OFF_WC1 + (size_t)2 * 128 * 2048 * 2;
constexpr size_t OFF_CB = OFF_WC2 + (size_t)2 * 64 * 128 * 2;
constexpr size_t OFF_S5S = OFF_CB + 4096;
constexpr size_t OFF_KC = OFF_S5S + (size_t)8 * 32 * 8 * 64 * 8;
constexpr size_t OFF_VCT = OFF_KC + (size_t)8 * 2 * 256 * 64 * 2;
constexpr size_t OFF_ROPE = OFF_VCT + (size_t)8 * 2 * 256 * 64 * 2;
constexpr size_t OFF_HY = OFF_ROPE + (size_t)T * 32 * 8;
constexpr size_t YSZ = (size_t)T * 512 * 2;
constexpr size_t OFF_PROJ = OFF_HY + 3 * YSZ;
constexpr size_t OFF_G = OFF_PROJ + (size_t)T * PP * 2;
constexpr size_t WS_END = OFF_G + (size_t)T * NGM * 2;
constexpr size_t OFF_BAR = WS_END;
constexpr size_t BAR_BYTES = 3456 * 4;
static_assert(WS_END + BAR_BYTES <= (size_t)512 * 1024 * 1024, "workspace too large");
static_assert((size_t)T * DFF * 2 <= WS_END - OFF_PROJ, "hidden overlay");
constexpr int LDS_WAVE = 18688;
constexpr int LDS_XB = 8 * LDS_WAVE;
constexpr int LDS_BYTES = 8 * LDS_WAVE + 16;

template <class Tp> DI Tp* as_global(Tp* p) { return p; }
DI float bf2f(bf16_t v) { return __uint_as_float((unsigned)v << 16); }
DI unsigned pk2(float lo, float hi) { f32x2_t v = {lo, hi}; bf16x2_t b = __builtin_convertvector(v, bf16x2_t); return __builtin_bit_cast(unsigned, b); }
DI float sigmoidf_(float x) { return __builtin_amdgcn_rcpf(1.0f + __expf(-x)); }
DI float gelu_tanh(float x) { const float u = 0.7978845608028654f * (x + 0.044715f * x * x * x); const float e = __expf(2.0f * u); const float th = 1.0f - 2.0f * __builtin_amdgcn_rcpf(e + 1.0f); return 0.5f * x * (1.0f + th); }
DI int perm16(int x) { return (x & ~12) | ((x & 4) << 1) | ((x & 8) >> 1); }
DI int crow(int reg, int h) { return (reg & 3) + 8 * (reg >> 2) + 4 * h; }
DI float shx(float v, int m, int lane) { return __int_as_float(__builtin_amdgcn_ds_bpermute((lane ^ m) << 2, __float_as_int(v))); }
typedef unsigned u32x2s __attribute__((ext_vector_type(2)));
DI float xmax32(float v) { const u32x2s r = __builtin_amdgcn_permlane32_swap(__float_as_uint(v), __float_as_uint(v), false, false); return fmaxf(__uint_as_float(r[0]), __uint_as_float(r[1])); }
DI float xsum32(float v) { const u32x2s r = __builtin_amdgcn_permlane32_swap(__float_as_uint(v), __float_as_uint(v), false, false); return __uint_as_float(r[0]) + __uint_as_float(r[1]); }
DI float wave_sum(float v, int lane) {
#pragma unroll
    for (int o = 32; o >= 1; o >>= 1) v += shx(v, o, lane);
    return v;
}
#define MFMA32(a, b, c) __builtin_amdgcn_mfma_f32_32x32x16_bf16((a), (b), (c), 0, 0, 0)
#define MFMA16(a, b, c) __builtin_amdgcn_mfma_f32_16x16x32_bf16((a), (b), (c), 0, 0, 0)

namespace pg8 {
constexpr int BM = 256, BK = 64, HALF = 128, HTB = HALF * BK * 2, STAGE_BYTES = 8 * HTB, NXCD = 8, WGM = 8;
__host__ __device__ __forceinline__ int lds_byte(int r, int c) { const int st = (r >> 4) * 2 + (c >> 5), rr = r & 15, cc = c & 31, ob = rr * 64 + cc * 2; return st * 1024 + (ob ^ (((ob >> 9) & 1) << 5)); }
__host__ __device__ __forceinline__ void stage_rc(int b, int& R, int& C) { const int st = b / 1024, sb = b % 1024, swz = sb ^ (((sb >> 9) & 1) << 5); R = (st >> 1) * 16 + swz / 64; C = (st & 1) * 32 + (swz % 64) / 2; }
__host__ __device__ __forceinline__ int perm32(int rho) { const int n = rho >> 4, i = rho & 15; return 8 * (i >> 2) + 4 * n + (i & 3); }

struct Unit { int pm, pn, z; };
struct Gemm { const bf16_t* A; const bf16_t* Bt; int M, N, K, lda; size_t zA, zB; };

DI void tile_of(int wgid, int nwg, int nM, int nN, int& pm, int& pn) {
    { const int q = nwg / NXCD, r = nwg % NXCD, xcd = wgid % NXCD, off = wgid / NXCD; wgid = (xcd < r ? xcd * (q + 1) : r * (q + 1) + (xcd - r) * q) + off; }
    const int nig = WGM * nN, gid = wgid / nig, fm = gid * WGM, gsz = (nM - fm) < WGM ? (nM - fm) : WGM;
    pm = fm + ((wgid % nig) % gsz); pn = (wgid % nig) / gsz;
}
struct StaticOrder {
    int nM, nN, nwg, G, c;
    DI void init(int M, int N, int G_, int c_) { nM = M / BM; nN = N / BM; nwg = nM * nN; G = G_; c = c_; }
    DI bool next(int i, Unit& u) const { const long L = (long)i * G + c; if (L >= nwg) return false; tile_of((int)L, nwg, nM, nN, u.pm, u.pn); u.z = 0; return true; }
};
struct Z3Order {
    int nM, nN, nwg, G, c;
    DI void init(int M, int N, int G_, int c_) { nM = M / BM; nN = N / BM; nwg = nM * nN; G = G_; c = c_; }
    DI bool next(int i, Unit& u) const { const long L = (long)(i / 3) * G + c; if (L >= nwg) return false; tile_of((int)L, nwg, nM, nN, u.pm, u.pn); u.z = i % 3; return true; }
};

template <class Epi, class Sched>
DI void gemm_phase(LAS unsigned char* lds, const Gemm g, const Sched& S, const Epi& E, int tid_l) {
    asm volatile("" : "+v"(tid_l));
    const int tid = tid_l, wid = __builtin_amdgcn_readfirstlane(tid >> 6), lane = tid & 63, wr = wid >> 2, wc = wid & 3, fr = lane & 15, fq = lane >> 4;
    const int K = g.K, nt = K / BK;
    unsigned voffA[2], voffB[2];
#pragma unroll
    for (int i = 0; i < 2; ++i) { int R, C; stage_rc(tid * 16 + i * 8192, R, C); const int Rb = (R & ~31) + perm32(R & 31);
        voffA[i] = (unsigned)(R * g.lda + C) * 2u; voffB[i] = (unsigned)(Rb * K + C) * 2u; }
    const size_t kstep = (size_t)(BK * 2);
    const size_t hstepA = (size_t)HALF * g.lda * 2, hstepB = (size_t)HALF * K * 2;
    const size_t tstepA = 2 * hstepA, tstepB = 2 * hstepB;
    const unsigned ldsw = (unsigned)wid * 1024u;
    const int aoff = lds_byte(wr * 64 + fr, fq * 8), boff = lds_byte(wc * 32 + fr, fq * 8);
#define PG8_SA(b, h) (((b) * 2 + (h)) * HTB)
#define PG8_SB(b, h) ((4 + (b) * 2 + (h)) * HTB)
#define PG8_STAGE(bufoff, gbase, voff) do { _Pragma("unroll") for (int _i = 0; _i < 2; ++_i) \
        __builtin_amdgcn_global_load_lds((const unsigned*)((const char*)(gbase) + (voff)[_i]), (LAS unsigned*)(lds + (bufoff) + ldsw + _i * 8192), 16, 0, 0); } while (0)
#define PG8_LDA(dst, b, h) do { _Pragma("unroll") for (int m = 0; m < 4; ++m) _Pragma("unroll") for (int k = 0; k < 2; ++k) dst[m][k] = *(const LAS bf16x8*)(lds + PG8_SA(b, h) + aoff + m * 2048 + k * 1024); } while (0)
#define PG8_LDB(dst, b, h) do { _Pragma("unroll") for (int n = 0; n < 2; ++n) _Pragma("unroll") for (int k = 0; k < 2; ++k) dst[n][k] = *(const LAS bf16x8*)(lds + PG8_SB(b, h) + boff + n * 2048 + k * 1024); } while (0)
#define PG8_MMA(ai, bj, At, Bt) do { __builtin_amdgcn_s_setprio(1); _Pragma("unroll") for (int m = 0; m < 4; ++m) _Pragma("unroll") for (int n = 0; n < 2; ++n) _Pragma("unroll") for (int k = 0; k < 2; ++k) \
        acc[ai][bj][m][n] = __builtin_amdgcn_mfma_f32_16x16x32_bf16(Bt[n][k], At[m][k], acc[ai][bj][m][n], 0, 0, 0); __builtin_amdgcn_s_setprio(0); } while (0)
#define PG8_WAIT_V(n) asm volatile("s_waitcnt vmcnt(" #n ")" ::: "memory")
#define PG8_WAIT_L(n) asm volatile("s_waitcnt lgkmcnt(" #n ")" ::: "memory")
#define PG8_BAR __builtin_amdgcn_s_barrier()
#define PG8_SCHED __builtin_amdgcn_sched_barrier(0)
    Unit cur, nxt; int ui = 0;
    if (!S.next(0, cur)) return;
    f32x4 acc[2][2][4][2];
#pragma unroll
    for (int a = 0; a < 2; ++a)
#pragma unroll
        for (int b = 0; b < 2; ++b)
#pragma unroll
            for (int m = 0; m < 4; ++m)
#pragma unroll
                for (int n = 0; n < 2; ++n) acc[a][b][m][n] = (f32x4){0.f, 0.f, 0.f, 0.f};
    bf16x8 At[4][2], B0[2][2], B1[2][2];
    const char* cA = (const char*)g.A + (size_t)cur.z * g.zA + (size_t)cur.pm * tstepA; const char* cB = (const char*)g.Bt + (size_t)cur.z * g.zB + (size_t)cur.pn * tstepB;
    PG8_STAGE(PG8_SB(0, 0), cB, voffB); PG8_STAGE(PG8_SB(0, 1), cB + hstepB, voffB); PG8_STAGE(PG8_SA(0, 0), cA, voffA); PG8_STAGE(PG8_SA(0, 1), cA + hstepA, voffA);
    if (wr == 1) PG8_BAR;
    PG8_WAIT_V(2); PG8_BAR;
    PG8_STAGE(PG8_SB(1, 0), cB + kstep, voffB); PG8_STAGE(PG8_SA(1, 0), cA + kstep, voffA); PG8_STAGE(PG8_SB(1, 1), cB + hstepB + kstep, voffB);
    PG8_WAIT_V(6); PG8_BAR;
    for (;;) {
        const bool has_next = S.next(ui + 1, nxt);
        const char* nA = has_next ? (const char*)g.A + (size_t)nxt.z * g.zA + (size_t)nxt.pm * tstepA : cA; const char* nB = has_next ? (const char*)g.Bt + (size_t)nxt.z * g.zB + (size_t)nxt.pn * tstepB : cB;
        for (int t = 0; t < nt; t += 2) {
            const bool last = (t == nt - 2);
            const char* a1 = cA + (size_t)(t + 1) * kstep;
            const char* a2 = last ? nA : cA + (size_t)(t + 2) * kstep; const char* b2 = last ? nB : cB + (size_t)(t + 2) * kstep;
            const char* a3 = a2 + kstep; const char* b3 = b2 + kstep;
            PG8_LDB(B0, 0, 0); PG8_LDB(B1, 0, 1); PG8_SCHED; PG8_LDA(At, 0, 0); PG8_STAGE(PG8_SA(1, 1), a1 + hstepA, voffA);
            PG8_WAIT_V(8); PG8_WAIT_L(0); PG8_BAR; PG8_MMA(0, 0, At, B0); PG8_MMA(0, 1, At, B1); PG8_BAR; PG8_SCHED;
            PG8_LDA(At, 0, 1); PG8_STAGE(PG8_SB(0, 0), b2, voffB); PG8_STAGE(PG8_SB(0, 1), b2 + hstepB, voffB); PG8_STAGE(PG8_SA(0, 0), a2, voffA);
            PG8_WAIT_V(8); PG8_WAIT_L(0); PG8_BAR; PG8_MMA(1, 0, At, B0); PG8_MMA(1, 1, At, B1); PG8_BAR; PG8_SCHED;
            PG8_LDB(B0, 1, 0); PG8_LDB(B1, 1, 1); PG8_SCHED; PG8_LDA(At, 1, 0); PG8_STAGE(PG8_SA(0, 1), a2 + hstepA, voffA);
            PG8_WAIT_V(8); PG8_WAIT_L(0); PG8_BAR; PG8_MMA(0, 0, At, B0); PG8_MMA(0, 1, At, B1); PG8_BAR; PG8_SCHED;
            PG8_LDA(At, 1, 1); PG8_STAGE(PG8_SB(1, 0), b3, voffB); PG8_STAGE(PG8_SB(1, 1), b3 + hstepB, voffB); PG8_STAGE(PG8_SA(1, 0), a3, voffA);
            PG8_WAIT_V(8); PG8_WAIT_L(0); PG8_BAR; PG8_MMA(1, 0, At, B0); PG8_MMA(1, 1, At, B1); PG8_BAR; PG8_SCHED;
        }
        if (wr == 0) PG8_BAR;
        E(acc, cur, wr, wc, fr, fq);
        if (!has_next) break;
#pragma unroll
        for (int a = 0; a < 2; ++a)
#pragma unroll
            for (int b = 0; b < 2; ++b)
#pragma unroll
                for (int m = 0; m < 4; ++m)
#pragma unroll
                    for (int n = 0; n < 2; ++n) acc[a][b][m][n] = (f32x4){0.f, 0.f, 0.f, 0.f};
        cur = nxt; cA = nA; cB = nB; ++ui;
        if (wr == 1) PG8_BAR;
    }
    PG8_WAIT_V(0);
    PG8_BAR;
#undef PG8_SA
#undef PG8_SB
#undef PG8_STAGE
#undef PG8_LDA
#undef PG8_LDB
#undef PG8_MMA
#undef PG8_WAIT_V
#undef PG8_WAIT_L
#undef PG8_BAR
#undef PG8_SCHED
}

#define EPI_LOOP_BEGIN \
    const int row0 = u.pm * BM + wr * 64 + fr; \
    _Pragma("unroll") for (int ai = 0; ai < 2; ++ai) _Pragma("unroll") for (int m = 0; m < 4; ++m) { const size_t row = (size_t)(row0 + ai * HALF + m * 16); \
    _Pragma("unroll") for (int bj = 0; bj < 2; ++bj) { const int col = u.pn * BM + bj * HALF + wc * 32 + 8 * fq; f32x4 v0 = acc[ai][bj][m][0], v1 = acc[ai][bj][m][1];
#define EPI_LOOP_END } }
DI u32x4 pack8(f32x4 v0, f32x4 v1) { u32x4 w; w.x = pk2(v0[0], v0[1]); w.y = pk2(v0[2], v0[3]); w.z = pk2(v1[0], v1[1]); w.w = pk2(v1[2], v1[3]); return w; }
DI void unpack8(u32x4 w, f32x4& a, f32x4& b) {
    a[0] = __uint_as_float(w.x << 16); a[1] = __uint_as_float(w.x & 0xffff0000u); a[2] = __uint_as_float(w.y << 16); a[3] = __uint_as_float(w.y & 0xffff0000u);
    b[0] = __uint_as_float(w.z << 16); b[1] = __uint_as_float(w.z & 0xffff0000u); b[2] = __uint_as_float(w.w << 16); b[3] = __uint_as_float(w.w & 0xffff0000u);
}
struct EpiIn {
    bf16_t* proj; bf16_t* G;
    DI void operator()(const f32x4 (&acc)[2][2][4][2], const Unit& u, int wr, int wc, int fr, int fq) const {
        EPI_LOOP_BEGIN
            if (col >= C_GA) {
#pragma unroll
                for (int j = 0; j < 4; ++j) { v0[j] = sigmoidf_(v0[j]); v1[j] = sigmoidf_(v1[j]); }
            }
            bf16_t* dst = (col < PP) ? proj + row * PP + col : G + row * NGM + (col - PP);
            *(u32x4*)dst = pack8(v0, v1);
        EPI_LOOP_END
    }
};
struct EpiGlu {
    const bf16_t* z; const float* bias; bf16_t* yc;
    DI void operator()(const f32x4 (&acc)[2][2][4][2], const Unit& u, int wr, int wc, int fr, int fq) const {
        const int row0 = u.pm * BM + wr * 64 + fr; const int colb = u.pn * BM + wc * 32 + 8 * fq;
        f32x4 b0[2], b1[2];
#pragma unroll
        for (int bj = 0; bj < 2; ++bj) { b0[bj] = *(const f32x4*)(bias + colb + bj * HALF); b1[bj] = *(const f32x4*)(bias + colb + bj * HALF + 4); }
#pragma unroll
        for (int ai = 0; ai < 2; ++ai) {
            u32x4 zq[4][2];
#pragma unroll
            for (int m = 0; m < 4; ++m)
#pragma unroll
                for (int bj = 0; bj < 2; ++bj) zq[m][bj] = *(const u32x4*)(z + (size_t)(row0 + ai * HALF + m * 16) * PP + colb + bj * HALF);
#pragma unroll
            for (int m = 0; m < 4; ++m)
#pragma unroll
                for (int bj = 0; bj < 2; ++bj) {
                    f32x4 z0, z1; unpack8(zq[m][bj], z0, z1); f32x4 v0 = acc[ai][bj][m][0], v1 = acc[ai][bj][m][1];
#pragma unroll
                    for (int j = 0; j < 4; ++j) { v0[j] = z0[j] * sigmoidf_(v0[j] + b0[bj][j]); v1[j] = z1[j] * sigmoidf_(v1[j] + b1[bj][j]); }
                    *(u32x4*)(yc + (size_t)(row0 + ai * HALF + m * 16) * 512 + colb + bj * HALF) = pack8(v0, v1);
                }
        }
    }
};
struct EpiMerge {
    const bf16_t* G; bf16_t* mg;
    DI void operator()(const f32x4 (&acc)[2][2][4][2], const Unit& u, int wr, int wc, int fr, int fq) const {
        const int row0 = u.pm * BM + wr * 64 + fr; const int colb = u.pn * BM + wc * 32 + 8 * fq;
#pragma unroll
        for (int ai = 0; ai < 2; ++ai) {
            u32x4 gq[4][2], pq[4][2];
#pragma unroll
            for (int m = 0; m < 4; ++m)
#pragma unroll
                for (int bj = 0; bj < 2; ++bj) {
                    const size_t row = (size_t)(row0 + ai * HALF + m * 16); const int col = colb + bj * HALF;
                    gq[m][bj] = *(const u32x4*)(G + row * NGM + u.z * DM + col);
                    pq[m][bj] = (u.z > 0) ? *(const u32x4*)(mg + row * DM + col) : (u32x4){0u, 0u, 0u, 0u};
                }
#pragma unroll
            for (int m = 0; m < 4; ++m)
#pragma unroll
                for (int bj = 0; bj < 2; ++bj) {
                    const size_t row = (size_t)(row0 + ai * HALF + m * 16); const int col = colb + bj * HALF;
                    f32x4 g0, g1, p0, p1; unpack8(gq[m][bj], g0, g1); unpack8(pq[m][bj], p0, p1);
                    const f32x4 v0 = acc[ai][bj][m][0] * g0 + p0, v1 = acc[ai][bj][m][1] * g1 + p1;
                    *(u32x4*)(mg + row * DM + col) = pack8(v0, v1);
                }
        }
    }
};
struct EpiResid {
    float* x;
    DI void operator()(const f32x4 (&acc)[2][2][4][2], const Unit& u, int wr, int wc, int fr, int fq) const {
        const int row0 = u.pm * BM + wr * 64 + fr; const int colb = u.pn * BM + wc * 32 + 8 * fq;
#pragma unroll
        for (int ai = 0; ai < 2; ++ai) {
            f32x4 xa[4][2], xb[4][2];
#pragma unroll
            for (int m = 0; m < 4; ++m)
#pragma unroll
                for (int bj = 0; bj < 2; ++bj) {
                    const float* p = x + (size_t)(row0 + ai * HALF + m * 16) * DM + colb + bj * HALF;
                    xa[m][bj] = *(const f32x4*)p; xb[m][bj] = *(const f32x4*)(p + 4);
                }
#pragma unroll
            for (int m = 0; m < 4; ++m)
#pragma unroll
                for (int bj = 0; bj < 2; ++bj) {
                    float* p = x + (size_t)(row0 + ai * HALF + m * 16) * DM + colb + bj * HALF;
                    *(f32x4*)p = xa[m][bj] + acc[ai][bj][m][0]; *(f32x4*)(p + 4) = xb[m][bj] + acc[ai][bj][m][1];
                }
        }
    }
};
struct EpiUp {
    bf16_t* hid;
    DI void operator()(const f32x4 (&acc)[2][2][4][2], const Unit& u, int wr, int wc, int fr, int fq) const {
        EPI_LOOP_BEGIN
#pragma unroll
            for (int j = 0; j < 4; ++j) { const float a = fmaxf(v0[j], 0.f), b = fmaxf(v1[j], 0.f); v0[j] = a * a; v1[j] = b * b; }
            *(u32x4*)(hid + row * DFF + col) = pack8(v0, v1);
        EPI_LOOP_END
    }
};
}

enum { MODE_WIN = 0, MODE_CMP = 1, MODE_SEL = 2 };
template <int MODE>
DI void fa_tile(f32x16 (&o)[2][2], float (&m)[2], float (&ls)[2], const bf16x8 (&qf)[2][4],
                bf16x8 (&kf)[4], const bf16_t* knext, const bf16_t* VTb, int vpitch, int vks, int kbase, int r, int h,
                const int (&qpos)[2], int W, bool rs0, bool rs1, int qlo, int qhi) {
    bool fullw;
    if (MODE == MODE_WIN) fullw = (kbase + 31 <= qlo) && (kbase > qhi - W);
    else if (MODE == MODE_CMP) fullw = (16 * (kbase + 31) + 31 <= qlo);
    else fullw = (kbase + 31 <= qlo) && (__builtin_amdgcn_ballot_w64(rs0 && rs1) == ~0ull);
    bf16x8 vf[2][2];
#pragma unroll
    for (int dt = 0; dt < 2; ++dt)
#pragma unroll
        for (int s = 0; s < 2; ++s) {
            vf[dt][s] = *(const bf16x8*)(VTb + (size_t)(32 * dt + r) * vpitch + (size_t)(kbase + 16 * s) * vks + 8 * h);
        }
#pragma unroll
    for (int rt = 0; rt < 2; ++rt) {
        f32x16 st;
#pragma unroll
        for (int i = 0; i < 16; ++i) st[i] = 0.f;
#pragma unroll
        for (int ks = 0; ks < 4; ++ks) st = MFMA32(kf[ks], qf[rt][ks], st);
        if (rt == 1) {
#pragma unroll
            for (int ks = 0; ks < 4; ++ks) kf[ks] = *(const bf16x8*)(knext + 16 * ks);
        }
        const int qp = qpos[rt]; const bool rs = rt == 0 ? rs0 : rs1;
        if (!fullw) {
#pragma unroll
            for (int i = 0; i < 16; ++i) {
                const int kpos = kbase + crow(i, h);
                bool valid;
                if (MODE == MODE_WIN) valid = (kpos <= qp) && (kpos > qp - W);
                else if (MODE == MODE_CMP) valid = (16 * kpos + 31 <= qp);
                else valid = rs && (kpos <= qp);
                st[i] = valid ? st[i] : -INFINITY;
            }
        }
        float mx = st[0];
#pragma unroll
        for (int i = 1; i < 16; ++i) mx = fmaxf(mx, st[i]);
        mx = xmax32(mx);
        const float cand = fmaxf(m[rt], mx * SC2);
        if (__builtin_amdgcn_ballot_w64((cand - m[rt]) > 8.0f) != 0ull) {
            const float alpha = __builtin_amdgcn_exp2f(m[rt] - cand);
            m[rt] = cand; ls[rt] *= alpha;
#pragma unroll
            for (int dt = 0; dt < 2; ++dt)
#pragma unroll
                for (int i = 0; i < 16; ++i) o[rt][dt][i] *= alpha;
        }
        const float mref = m[rt];
        float sum = 0.f;
#pragma unroll
        for (int i = 0; i < 16; ++i) { const float p = __builtin_amdgcn_exp2f(__builtin_fmaf(st[i], SC2, -mref)); st[i] = p; sum += p; }
        ls[rt] += sum;
        bf16x8 pf[2];
#pragma unroll
        for (int s = 0; s < 2; ++s) {
            u32x4 w; w.x = pk2(st[8 * s + 0], st[8 * s + 1]); w.y = pk2(st[8 * s + 2], st[8 * s + 3]); w.z = pk2(st[8 * s + 4], st[8 * s + 5]); w.w = pk2(st[8 * s + 6], st[8 * s + 7]);
            pf[s] = __builtin_bit_cast(bf16x8, w);
        }
#pragma unroll
        for (int dt = 0; dt < 2; ++dt)
#pragma unroll
            for (int s = 0; s < 2; ++s) o[rt][dt] = MFMA32(vf[dt][s], pf[s], o[rt][dt]);
    }
}
DI void kf_load(bf16x8 (&kf)[4], const bf16_t* kp) {
#pragma unroll
    for (int ks = 0; ks < 4; ++ks) kf[ks] = *(const bf16x8*)(kp + 16 * ks);
}
DI void fa_zero(f32x16 (&o)[2][2]) {
#pragma unroll
    for (int a = 0; a < 2; ++a)
#pragma unroll
        for (int b = 0; b < 2; ++b)
#pragma unroll
            for (int i = 0; i < 16; ++i) o[a][b][i] = 0.f;
}

DI unsigned long long topk_mask(float impv, int lane, int cur) {
    const bool valid = lane <= cur; const bool forced = (lane == 0) | (lane == cur) | (lane == cur - 1);
    if (cur + 1 <= 16) return __ballot(valid);
    const unsigned key = valid ? (forced ? 0x7f000000u : (__float_as_uint(fmaxf(impv, 0.f)) + 1u)) : 0u;
    unsigned t = 0;
    for (int bit = 30; bit >= 0; --bit) {
        const unsigned cand = t | (1u << bit);
        const int cnt = __popcll(__ballot(key >= cand));
        if (cnt >= 16) t = cand;
    }
    const unsigned long long gt = __ballot(key > t), eq = __ballot(key == t);
    const int need = 16 - __popcll(gt);
    const int below = __popcll(eq & ((1ull << lane) - 1ull));
    const bool sel = (key > t) || ((key == t) && (below < need));
    return __ballot(sel);
}

DI void attnA_unit(const bf16_t* proj, const bf16_t* kc, const bf16_t* vct, const bf16_t* VT, bf16_t* ya,
                   int b, int hkv, int q0, LAS unsigned char* wl, int lane) {
    asm volatile("" : "+v"(lane));
    int r = lane & 31, h = lane >> 5;
#define RELAUNDER() do { asm volatile("" : "+v"(lane)); r = lane & 31; h = lane >> 5; } while (0)
    const size_t tokbase = (size_t)b * SEQ;
    LAS float* ytot = (LAS float*)wl;
    LAS float* impscr = (LAS float*)(wl + 16384);
    LAS unsigned* mskscr = (LAS unsigned*)(wl + 16384 + 2048);
    int qpos[2]; bf16x8 qf[2][4];
#pragma unroll
    for (int rt = 0; rt < 2; ++rt) {
        const int R = 32 * rt + r, qi = R >> 2, gi = R & 3; qpos[rt] = q0 + qi;
        const bf16_t* qp = proj + (tokbase + qpos[rt]) * PP + C_QA + (hkv * 4 + gi) * 64 + 8 * h;
#pragma unroll
        for (int ks = 0; ks < 4; ++ks) qf[rt][ks] = *(const bf16x8*)(qp + 16 * ks);
    }
    f32x16 o[2][2]; float m[2], ls[2];
    const bf16_t* Kc = kc + (size_t)(b * 2 + hkv) * 256 * 64; const bf16_t* Vc = vct + (size_t)(b * 2 + hkv) * 64 * 256;
    const int nmax = (q0 + 15 - 31) >> 4; const int ntile = nmax >= 0 ? (nmax >> 5) + 1 : 0;
    fa_zero(o); m[0] = m[1] = -1e30f; ls[0] = ls[1] = 0.f;
    {
        bf16x8 kf[4]; const bf16_t* kl = Kc + (size_t)r * 64 + 8 * h; kf_load(kf, kl);
#pragma unroll 1
        for (int t = 0; t < ntile; ++t) { const int nb = (t + 1 < ntile) ? 32 * (t + 1) : 32 * t; fa_tile<MODE_CMP>(o, m, ls, qf, kf, kl + (size_t)nb * 64, Vc, 16, 64, 32 * t, r, h, qpos, 0, false, false, q0, q0 + 15); }
    }
    float mc[2], invc[2];
#pragma unroll
    for (int rt = 0; rt < 2; ++rt) {
        const float lt = xsum32(ls[rt]); const float inv = lt > 0.f ? __builtin_amdgcn_rcpf(lt) : 0.f; mc[rt] = m[rt]; invc[rt] = inv;
        const float gsc = bf2f(proj[(tokbase + qpos[rt]) * PP + C_GA + 0 + hkv * 4 + ((32 * rt + r) & 3)]) * inv;
#pragma unroll
        for (int dt = 0; dt < 2; ++dt)
#pragma unroll
            for (int i = 0; i < 16; ++i) ytot[((rt * 2 + dt) * 16 + i) * 64 + lane] = o[rt][dt][i] * gsc;
    }
    RELAUNDER();
    fa_zero(o);
#pragma unroll 1
    for (int t = 0; t < ntile; ++t) {
        const int kbase = 32 * t;
        const bf16_t* kp = Kc + (size_t)(kbase + r) * 64 + 8 * h;
        bf16x8 kf[4];
#pragma unroll
        for (int ks = 0; ks < 4; ++ks) kf[ks] = *(const bf16x8*)(kp + 16 * ks);
        bf16x8 cf[2][2];
#pragma unroll
        for (int jt = 0; jt < 2; ++jt)
#pragma unroll
            for (int s = 0; s < 2; ++s) {
                const int jj = 32 * jt + r;
#pragma unroll
                for (int j = 0; j < 8; ++j) {
                    const int n = kbase + 16 * s + 8 * (j >> 2) + 4 * h + (j & 3);
                    const int jn = n >> 2; const bool edge = (n & 3) == 3;
                    const unsigned short w = (jj == jn) ? (edge ? 0x3F00 : 0x3F80) : ((edge && jj == jn + 1) ? 0x3F00 : 0);
                    cf[jt][s][j] = (short)w;
                }
            }
#pragma unroll
        for (int rt = 0; rt < 2; ++rt) {
            f32x16 st;
#pragma unroll
            for (int i = 0; i < 16; ++i) st[i] = 0.f;
#pragma unroll
            for (int ks = 0; ks < 4; ++ks) st = MFMA32(kf[ks], qf[rt][ks], st);
#pragma unroll
            for (int i = 0; i < 16; ++i) {
                const int kpos = kbase + crow(i, h);
                const bool valid = (16 * kpos + 31 <= qpos[rt]);
                st[i] = valid ? __builtin_amdgcn_exp2f(st[i] * SC2 - mc[rt]) * invc[rt] : 0.f;
            }
            bf16x8 pf[2];
#pragma unroll
            for (int s = 0; s < 2; ++s) {
                u32x4 w; w.x = pk2(st[8 * s + 0], st[8 * s + 1]); w.y = pk2(st[8 * s + 2], st[8 * s + 3]); w.z = pk2(st[8 * s + 4], st[8 * s + 5]); w.w = pk2(st[8 * s + 6], st[8 * s + 7]);
                pf[s] = __builtin_bit_cast(bf16x8, w);
            }
#pragma unroll
            for (int jt = 0; jt < 2; ++jt)
#pragma unroll
                for (int s = 0; s < 2; ++s) o[rt][jt] = MFMA32(cf[jt][s], pf[s], o[rt][jt]);
        }
    }
    RELAUNDER();
    const int cur = q0 >> 6;
    unsigned long long uni = 0ull; unsigned mlo[2], mhi[2];
#pragma unroll
    for (int rt = 0; rt < 2; ++rt) {
#pragma unroll
        for (int jt = 0; jt < 2; ++jt)
#pragma unroll
            for (int i = 0; i < 16; ++i) {
                float v = o[rt][jt][i]; v += shx(v, 1, lane); v += shx(v, 2, lane);
                if ((r & 3) == 0) impscr[(r >> 2) * 64 + 32 * jt + crow(i, h)] = v;
            }
        asm volatile("s_waitcnt lgkmcnt(0)" ::: "memory");
        for (int qi = 0; qi < 8; ++qi) {
            const float v = impscr[qi * 64 + lane];
            const unsigned long long mk = topk_mask(v, lane, cur);
            uni |= mk;
            if (lane == 0) { mskscr[qi * 2] = (unsigned)mk; mskscr[qi * 2 + 1] = (unsigned)(mk >> 32); }
        }
        asm volatile("s_waitcnt lgkmcnt(0)" ::: "memory");
        mlo[rt] = mskscr[(r >> 2) * 2]; mhi[rt] = mskscr[(r >> 2) * 2 + 1];
        asm volatile("s_waitcnt lgkmcnt(0)" ::: "memory");
    }
    RELAUNDER();
    {
        const bf16_t* Ks = proj + tokbase * PP + C_KVA + 256 + hkv * 64;
        const bf16_t* Vs = VT + (size_t)((0 + hkv) * 8 + b) * 64 * SEQ;
        fa_zero(o); m[0] = m[1] = -1e30f; ls[0] = ls[1] = 0.f;
        {
            const unsigned long long vm = uni & ((2ull << cur) - 1ull);
            const bf16_t* kl = Ks + (size_t)r * PP + 8 * h;
            int j = __builtin_ctzll(vm), hf = 0; bool has = true;
            bf16x8 kf[4]; kf_load(kf, kl + (size_t)(64 * j) * PP);
#pragma unroll 1
            while (has) {
                int nj = j, nhf = hf; bool hasn = false;
                if (hf == 0 && 64 * j + 32 <= q0 + 15) { nhf = 1; hasn = true; }
                else { const unsigned long long rem = (j < 63) ? (vm & (~0ull << (j + 1))) : 0ull; if (rem) { nj = __builtin_ctzll(rem); nhf = 0; hasn = true; } }
                const bool rs0 = ((j < 32 ? mlo[0] : mhi[0]) >> (j & 31)) & 1u, rs1 = ((j < 32 ? mlo[1] : mhi[1]) >> (j & 31)) & 1u;
                fa_tile<MODE_SEL>(o, m, ls, qf, kf, kl + (size_t)(64 * nj + 32 * nhf) * PP, Vs, 16, 64, 64 * j + 32 * hf, r, h, qpos, 0, rs0, rs1, q0, q0 + 15);
                j = nj; hf = nhf; has = hasn;
            }
        }
#pragma unroll
        for (int rt = 0; rt < 2; ++rt) {
            const float lt = xsum32(ls[rt]); const float inv = lt > 0.f ? __builtin_amdgcn_rcpf(lt) : 0.f;
            const float gsc = bf2f(proj[(tokbase + qpos[rt]) * PP + C_GA + 8 + hkv * 4 + ((32 * rt + r) & 3)]) * inv;
#pragma unroll
            for (int dt = 0; dt < 2; ++dt)
#pragma unroll
                for (int i = 0; i < 16; ++i) ytot[((rt * 2 + dt) * 16 + i) * 64 + lane] += o[rt][dt][i] * gsc;
        }
    }
    RELAUNDER();
    {
        const bf16_t* Kw = proj + tokbase * PP + C_KVA + 512 + hkv * 64;
        const bf16_t* Vw = VT + (size_t)((2 + hkv) * 8 + b) * 64 * SEQ;
        fa_zero(o); m[0] = m[1] = -1e30f; ls[0] = ls[1] = 0.f;
        int kb0 = (q0 - 511) & ~31; if (kb0 < 0) kb0 = 0;
        {
            const bf16_t* kl = Kw + (size_t)r * PP + 8 * h; bf16x8 kf[4]; kf_load(kf, kl + (size_t)kb0 * PP);
#pragma unroll 1
            for (int kbase = kb0; kbase <= q0 + 15; kbase += 32) { const int nb = (kbase + 32 <= q0 + 15) ? kbase + 32 : kbase; fa_tile<MODE_WIN>(o, m, ls, qf, kf, kl + (size_t)nb * PP, Vw, 16, 64, kbase, r, h, qpos, 512, false, false, q0, q0 + 15); }
        }
#pragma unroll
        for (int rt = 0; rt < 2; ++rt) {
            const float lt = xsum32(ls[rt]); const float inv = lt > 0.f ? __builtin_amdgcn_rcpf(lt) : 0.f;
            const float gsc = bf2f(proj[(tokbase + qpos[rt]) * PP + C_GA + 16 + hkv * 4 + ((32 * rt + r) & 3)]) * inv;
            const int R = 32 * rt + r, gi = R & 3;
            bf16_t* yp = ya + (tokbase + qpos[rt]) * 512 + (hkv * 4 + gi) * 64;
#pragma unroll
            for (int dt = 0; dt < 2; ++dt)
#pragma unroll
                for (int a = 0; a < 4; ++a) {
                    float v[4];
#pragma unroll
                    for (int bb = 0; bb < 4; ++bb) { const int i = 4 * a + bb; v[bb] = ytot[((rt * 2 + dt) * 16 + i) * 64 + lane] + o[rt][dt][i] * gsc; }
                    u32x2 w; w.x = pk2(v[0], v[1]); w.y = pk2(v[2], v[3]);
                    *(u32x2*)(yp + 32 * dt + 8 * a + 4 * h) = w;
                }
        }
    }
    asm volatile("s_waitcnt lgkmcnt(0)" ::: "memory");
}

DI void attnB_unit(const bf16_t* proj, const bf16_t* VT, const float* sinks, bf16_t* yb, int b, int q0, int lane) {
    asm volatile("" : "+v"(lane));
    const int r = lane & 31, h = lane >> 5;
    const size_t tokbase = (size_t)b * SEQ;
    int qpos[2]; bf16x8 qf[2][4]; f32x16 o[2][2]; float m[2], ls[2];
#pragma unroll
    for (int rt = 0; rt < 2; ++rt) {
        const int R = 32 * rt + r, qi = R >> 3, gi = R & 7; qpos[rt] = q0 + qi;
        const bf16_t* qp = proj + (tokbase + qpos[rt]) * PP + C_QB + gi * 64 + 8 * h;
#pragma unroll
        for (int ks = 0; ks < 4; ++ks) qf[rt][ks] = *(const bf16x8*)(qp + 16 * ks);
        m[rt] = sinks[gi] * LOG2E; ls[rt] = (h == 0) ? 1.0f : 0.f;
    }
    fa_zero(o);
    const bf16_t* Kb = proj + tokbase * PP + C_KB;
    const bf16_t* Vb = VT + (size_t)(4 * 8 + b) * 64 * SEQ;
    int kb0 = (q0 - 127) & ~31; if (kb0 < 0) kb0 = 0;
    {
        const bf16_t* kl = Kb + (size_t)r * PP + 8 * h; bf16x8 kf[4]; kf_load(kf, kl + (size_t)kb0 * PP);
#pragma unroll 1
        for (int kbase = kb0; kbase <= q0 + 7; kbase += 32) { const int nb = (kbase + 32 <= q0 + 7) ? kbase + 32 : kbase; fa_tile<MODE_WIN>(o, m, ls, qf, kf, kl + (size_t)nb * PP, Vb, 16, 64, kbase, r, h, qpos, 128, false, false, q0, q0 + 7); }
    }
#pragma unroll
    for (int rt = 0; rt < 2; ++rt) {
        const float lt = xsum32(ls[rt]); const float inv = __builtin_amdgcn_rcpf(lt);
        const int R = 32 * rt + r, gi = R & 7;
        bf16_t* yp = yb + (tokbase + qpos[rt]) * 512 + gi * 64;
#pragma unroll
        for (int dt = 0; dt < 2; ++dt)
#pragma unroll
            for (int a = 0; a < 4; ++a) {
                u32x2 w; w.x = pk2(o[rt][dt][4 * a] * inv, o[rt][dt][4 * a + 1] * inv); w.y = pk2(o[rt][dt][4 * a + 2] * inv, o[rt][dt][4 * a + 3] * inv);
                *(u32x2*)(yp + 32 * dt + 8 * a + 4 * h) = w;
            }
    }
}

DI void compress_unit(const bf16_t* proj, const bf16_t* W1T, const bf16_t* W2T, const float* cb, const float* rope, bf16_t* kc, bf16_t* vct,
                      int j, int b, int hkv, int nch, int kpart, LAS unsigned char* ldsb, int wave, int lane) {
    asm volatile("" : "+v"(lane));
    const int fr = lane & 15, fq = lane >> 4;
    const int n0 = nch * 16; const int n = n0 + fr; const int nl = n > 254 ? 254 : n;
    const bf16_t* src = proj + ((size_t)b * SEQ + (size_t)nl * 16) * PP + C_KVA + j * 128 + hkv * 64 + fq * 8;
    const bf16_t* w1 = W1T + (size_t)j * 128 * 2048 + (size_t)fr * 2048 + fq * 8;
    f32x4 acc1[8];
#pragma unroll
    for (int ht = 0; ht < 8; ++ht) acc1[ht] = (f32x4){0.f, 0.f, 0.f, 0.f};
    const float* rp = rope + (((size_t)b * SEQ + (size_t)nl * 16) * 32 + fq * 8) * 2;
#pragma unroll 2
    for (int l = kpart * 8; l < kpart * 8 + 8; ++l) {
        bf16x8 b0 = *(const bf16x8*)(src + (size_t)l * PP), b1 = *(const bf16x8*)(src + (size_t)l * PP + 32);
        if (j == 0) {
            f32x4 x0, x1, y0, y1; pg8::unpack8(__builtin_bit_cast(u32x4, b0), x0, x1); pg8::unpack8(__builtin_bit_cast(u32x4, b1), y0, y1);
            const f32x4 cs0 = *(const f32x4*)(rp + (size_t)l * 64), cs1 = *(const f32x4*)(rp + (size_t)l * 64 + 4), cs2 = *(const f32x4*)(rp + (size_t)l * 64 + 8), cs3 = *(const f32x4*)(rp + (size_t)l * 64 + 12);
            f32x4 o0, o1, q0, q1;
            o0[0] = x0[0] * cs0[0] - y0[0] * cs0[1]; q0[0] = y0[0] * cs0[0] + x0[0] * cs0[1];
            o0[1] = x0[1] * cs0[2] - y0[1] * cs0[3]; q0[1] = y0[1] * cs0[2] + x0[1] * cs0[3];
            o0[2] = x0[2] * cs1[0] - y0[2] * cs1[1]; q0[2] = y0[2] * cs1[0] + x0[2] * cs1[1];
            o0[3] = x0[3] * cs1[2] - y0[3] * cs1[3]; q0[3] = y0[3] * cs1[2] + x0[3] * cs1[3];
            o1[0] = x1[0] * cs2[0] - y1[0] * cs2[1]; q1[0] = y1[0] * cs2[0] + x1[0] * cs2[1];
            o1[1] = x1[1] * cs2[2] - y1[1] * cs2[3]; q1[1] = y1[1] * cs2[2] + x1[1] * cs2[3];
            o1[2] = x1[2] * cs3[0] - y1[2] * cs3[1]; q1[2] = y1[2] * cs3[0] + x1[2] * cs3[1];
            o1[3] = x1[3] * cs3[2] - y1[3] * cs3[3]; q1[3] = y1[3] * cs3[2] + x1[3] * cs3[3];
            b0 = __builtin_bit_cast(bf16x8, pg8::pack8(o0, o1)); b1 = __builtin_bit_cast(bf16x8, pg8::pack8(q0, q1));
        }
#pragma unroll
        for (int ht = 0; ht < 8; ++ht) {
            const bf16x8 a0 = *(const bf16x8*)(w1 + (size_t)ht * 16 * 2048 + (2 * l) * 32);
            const bf16x8 a1 = *(const bf16x8*)(w1 + (size_t)ht * 16 * 2048 + (2 * l + 1) * 32);
            acc1[ht] = MFMA16(a0, b0, acc1[ht]);
            acc1[ht] = MFMA16(a1, b1, acc1[ht]);
        }
    }
    {
        LAS float* mine = (LAS float*)(ldsb + wave * LDS_WAVE);
#pragma unroll
        for (int ht = 0; ht < 8; ++ht)
#pragma unroll
            for (int i = 0; i < 4; ++i) mine[(ht * 4 + i) * 64 + lane] = acc1[ht][i];
    }
    __syncthreads();
    if (kpart == 0) {
#pragma unroll
    for (int p = 1; p < 4; ++p) {
        const LAS float* oth = (const LAS float*)(ldsb + (wave + p) * LDS_WAVE);
#pragma unroll
        for (int ht = 0; ht < 8; ++ht)
#pragma unroll
            for (int i = 0; i < 4; ++i) acc1[ht][i] += oth[(ht * 4 + i) * 64 + lane];
    }
    const float* cbj = cb + j * 128;
#pragma unroll
    for (int ht = 0; ht < 8; ++ht)
#pragma unroll
        for (int i = 0; i < 4; ++i) acc1[ht][i] = gelu_tanh(acc1[ht][i] + cbj[16 * ht + 4 * fq + i]);
    f32x4 acc2[4];
#pragma unroll
    for (int ot = 0; ot < 4; ++ot) acc2[ot] = (f32x4){0.f, 0.f, 0.f, 0.f};
    const bf16_t* w2 = W2T + (size_t)j * 64 * 128;
#pragma unroll
    for (int s = 0; s < 4; ++s) {
        u32x4 w; w.x = pk2(acc1[2 * s][0], acc1[2 * s][1]); w.y = pk2(acc1[2 * s][2], acc1[2 * s][3]); w.z = pk2(acc1[2 * s + 1][0], acc1[2 * s + 1][1]); w.w = pk2(acc1[2 * s + 1][2], acc1[2 * s + 1][3]);
        const bf16x8 bfr = __builtin_bit_cast(bf16x8, w);
#pragma unroll
        for (int ot = 0; ot < 4; ++ot) {
            const bf16_t* ap = w2 + (size_t)(ot * 16 + fr) * 128 + 32 * s + 4 * fq;
            const s16x4 lo = *(const s16x4*)ap, hi = *(const s16x4*)(ap + 16);
            const bf16x8 afr = (bf16x8){lo[0], lo[1], lo[2], lo[3], hi[0], hi[1], hi[2], hi[3]};
            acc2[ot] = MFMA16(afr, bfr, acc2[ot]);
        }
    }
    const bool live = n <= 254;
    if (j == 0) {
        bf16_t* dst = kc + ((size_t)(b * 2 + hkv) * 256 + n) * 64;
#pragma unroll
        for (int ot = 0; ot < 4; ++ot) { u32x2 w; w.x = live ? pk2(acc2[ot][0], acc2[ot][1]) : 0u; w.y = live ? pk2(acc2[ot][2], acc2[ot][3]) : 0u; *(u32x2*)(dst + 16 * ot + 4 * fq) = w; }
    } else {
        bf16_t* dst = vct + (size_t)(b * 2 + hkv) * 64 * 256 + (size_t)nch * 1024 + perm16(fr);
#pragma unroll
        for (int ot = 0; ot < 4; ++ot)
#pragma unroll
            for (int i = 0; i < 4; ++i) dst[(16 * ot + 4 * fq + i) * 16] = live ? (bf16_t)(pk2(acc2[ot][i], 0.f) & 0xffffu) : (bf16_t)0;
    }
    }
    __syncthreads();
}

struct S5In { const float *a_re, *a_im, *log_dt, *b_re, *b_im, *c_re, *c_im, *d; };
DI void cplx_abar(const S5In& P, int g, int p, float dt, float& abr, float& abi, float& cfr, float& cfi) {
    const float ar = P.a_re[g * 64 + p], ai = P.a_im[g * 64 + p];
    const float mag = expf(dt * ar); abr = mag * cosf(dt * ai); abi = mag * sinf(dt * ai);
    const float den = ar * ar + ai * ai, nr = abr - 1.0f, ni = abi;
    cfr = (nr * ar + ni * ai) / den; cfi = (ni * ar - nr * ai) / den;
}
template <bool OUT>
DI void s5_unit(const S5In& P, bf16_t* proj, float* states, int b, int g, int c, int nsc, LAS unsigned char* wl, int lane) {
    asm volatile("" : "+v"(lane));
    const int r = lane & 31, h = lane >> 5, fr = lane & 15, fq = lane >> 4;
    const float dt = expf(P.log_dt[g]);
    float abr, abi, t0, t1; cplx_abar(P, g, lane, dt, abr, abi, t0, t1);
    bf16x8 bfrag[4];
#pragma unroll
    for (int hs = 0; hs < 2; ++hs) {
        const int p = r + 32 * hs; float a0, a1, cr, ci; cplx_abar(P, g, p, dt, a0, a1, cr, ci);
        const float* br = P.b_re + ((size_t)g * 64 + p) * 16 + 8 * h; const float* bi = P.b_im + ((size_t)g * 64 + p) * 16 + 8 * h;
        float re[8], im[8];
#pragma unroll
        for (int j = 0; j < 8; ++j) { re[j] = cr * br[j] - ci * bi[j]; im[j] = cr * bi[j] + ci * br[j]; }
        u32x4 wr_, wi_; wr_.x = pk2(re[0], re[1]); wr_.y = pk2(re[2], re[3]); wr_.z = pk2(re[4], re[5]); wr_.w = pk2(re[6], re[7]);
        wi_.x = pk2(im[0], im[1]); wi_.y = pk2(im[2], im[3]); wi_.z = pk2(im[4], im[5]); wi_.w = pk2(im[6], im[7]);
        bfrag[hs] = __builtin_bit_cast(bf16x8, wr_); bfrag[2 + hs] = __builtin_bit_cast(bf16x8, wi_);
    }
    bf16x8 cfrag[4]; float dch = 0.f;
    if (OUT) {
#pragma unroll
        for (int ks = 0; ks < 4; ++ks) {
            const float* cr = P.c_re + ((size_t)g * 16 + fr) * 64 + 16 * ks + 4 * fq; const float* ci = P.c_im + ((size_t)g * 16 + fr) * 64 + 16 * ks + 4 * fq;
            u32x4 w; w.x = pk2(cr[0], -ci[0]); w.y = pk2(cr[1], -ci[1]); w.z = pk2(cr[2], -ci[2]); w.w = pk2(cr[3], -ci[3]);
            cfrag[ks] = __builtin_bit_cast(bf16x8, w);
        }
        dch = P.d[g * 16 + fr];
    }
    float xr = 0.f, xi = 0.f;
    if (OUT) {
        float pr = abr, pi = abi;
#pragma unroll
        for (int q = 0; q < 9; ++q) { const float nr = pr * pr - pi * pi, ni = 2.0f * pr * pi; pr = nr; pi = ni; }
#ifndef DBG_NOSTATE
        for (int cc = 0; cc < c; ++cc) {
            const float* sp = states + ((((size_t)b * 32 + g) * 8 + cc) * 64 + lane) * 2;
            const float sr = sp[0], si = sp[1];
            const float nr = pr * xr - pi * xi + sr, ni = pr * xi + pi * xr + si; xr = nr; xi = ni;
        }
#endif
    }
    LAS float* bu = (LAS float*)wl;
    bf16_t* ucol = proj + ((size_t)b * SEQ + (size_t)c * 512) * PP + C_U + g * 16;
    bf16x8 ufr_n = *(const bf16x8*)(ucol + (size_t)r * PP + 8 * h);
    LAS bf16_t* uimg = (LAS bf16_t*)(wl + 16896);
#pragma unroll 1
    for (int sc = 0; sc < nsc; ++sc) {
        bf16_t* ub = ucol + (size_t)sc * 32 * PP;
        const bf16x8 ufr = ufr_n;
        if (OUT) *(LAS bf16x8*)(uimg + r * 16 + 8 * h) = ufr;
        {
            const bf16_t* un = ucol + (size_t)(sc + 1 < nsc ? sc + 1 : sc) * 32 * PP;
            ufr_n = *(const bf16x8*)(un + (size_t)r * PP + 8 * h);
        }
        f32x16 re0, re1, im0, im1;
        {
            f32x16 z16;
#pragma unroll
            for (int i = 0; i < 16; ++i) z16[i] = 0.f;
            const f32x16 d0 = MFMA32(ufr, bfrag[0], z16), d1 = MFMA32(ufr, bfrag[1], z16), d2 = MFMA32(ufr, bfrag[2], z16), d3 = MFMA32(ufr, bfrag[3], z16);
#pragma unroll
            for (int i = 0; i < 16; ++i) {
                const u32x2s a = __builtin_amdgcn_permlane32_swap(__float_as_uint(d0[i]), __float_as_uint(d1[i]), false, false);
                const u32x2s c = __builtin_amdgcn_permlane32_swap(__float_as_uint(d2[i]), __float_as_uint(d3[i]), false, false);
                re0[i] = __uint_as_float(a[0]); re1[i] = __uint_as_float(a[1]); im0[i] = __uint_as_float(c[0]); im1[i] = __uint_as_float(c[1]);
            }
        }
#pragma unroll
        for (int a4 = 0; a4 < 4; ++a4)
#pragma unroll
            for (int st_ = 0; st_ < 2; ++st_)
#pragma unroll
                for (int b4 = 0; b4 < 4; ++b4) {
                    const int i = 4 * a4 + b4, t = 8 * a4 + 4 * st_ + b4;
                    const float br_ = st_ ? re1[i] : re0[i], bi_ = st_ ? im1[i] : im0[i];
                    const float nr = abr * xr - abi * xi + br_, ni = abr * xi + abi * xr + bi_; xr = nr; xi = ni;
                    if (OUT) ((LAS unsigned*)(bu + t * 132))[lane] = pk2(xr, xi);
                }
        if (OUT) {
            asm volatile("s_waitcnt lgkmcnt(0)" ::: "memory");
#pragma unroll
            for (int mt = 0; mt < 2; ++mt) {
                f32x4 y = (f32x4){0.f, 0.f, 0.f, 0.f};
#pragma unroll
                for (int ks = 0; ks < 4; ++ks) {
                    const bf16x8 xa = *(const LAS bf16x8*)((LAS unsigned char*)bu + (mt * 16 + fr) * 528 + ks * 64 + fq * 16);
                    y = MFMA16(xa, cfrag[ks], y);
                }
#pragma unroll
                for (int i = 0; i < 4; ++i) {
                    LAS bf16_t* e = uimg + (mt * 16 + 4 * fq + i) * 16 + fr;
                    const float yy = y[i] + dch * bf2f(*e);
                    *e = (bf16_t)(pk2(gelu_tanh(yy), 0.f) & 0xffffu);
                }
            }
            asm volatile("s_waitcnt lgkmcnt(0)" ::: "memory");
            {
                const bf16x8 zv = *(const LAS bf16x8*)(uimg + lane * 8);
                *(bf16x8*)(ub + (size_t)(lane >> 1) * PP + 8 * (lane & 1)) = zv;
            }
            asm volatile("s_waitcnt lgkmcnt(0)" ::: "memory");
        }
    }
    if (!OUT) { float* sp = states + ((((size_t)b * 32 + g) * 8 + c) * 64 + lane) * 2; sp[0] = xr; sp[1] = xi; }
}

template <bool OUT_F32>
DI void rmsnorm_rows(const float* src, const float* gain, bf16_t* dstb, float* dstf, float* copy, int gw, int nw, int lane) {
    f32x4 gv[4];
#pragma unroll
    for (int i = 0; i < 4; ++i) gv[i] = *(const f32x4*)(gain + 256 * i + 4 * lane);
#pragma unroll 2
    for (int row = gw; row < T; row += nw) {
        const float* xp = src + (size_t)row * DM + 4 * lane;
        f32x4 v[4]; float ss = 0.f;
#pragma unroll
        for (int i = 0; i < 4; ++i) { v[i] = *(const f32x4*)(xp + 256 * i); ss += v[i][0] * v[i][0] + v[i][1] * v[i][1] + v[i][2] * v[i][2] + v[i][3] * v[i][3]; }
        ss = wave_sum(ss, lane);
        const float rs = rsqrtf(ss * (1.0f / 1024.0f) + NORM_EPS);
#pragma unroll
        for (int i = 0; i < 4; ++i) {
            if (copy) *(f32x4*)(copy + (size_t)row * DM + 256 * i + 4 * lane) = v[i];
            const f32x4 y = v[i] * rs * gv[i];
            if (OUT_F32) *(f32x4*)(dstf + (size_t)row * DM + 256 * i + 4 * lane) = y;
            else { u32x2 w; w.x = pk2(y[0], y[1]); w.y = pk2(y[2], y[3]); *(u32x2*)(dstb + (size_t)row * DM + 256 * i + 4 * lane) = w; }
        }
    }
}

DI int in_srccol(int n) { return n < 1280 ? n : (n < 2432 ? n + 24 : (n < 2456 ? n - 1152 : (n < 2560 ? -1 : n - 104))); }

#define XB_TMO      128
#define XB_XCNT(j)  (256  + 64 * (j))
#define XB_XSUB(j)  (1280 + 64 * (j))
#define XB_XGEN(j)  (2304 + 64 * (j))
#define XB_TOP      3328
#define XB_TOPGEN   3392
#define XB_SPIN_CAP (1u << 18)
DI unsigned xb_ld(unsigned* p)              { return __hip_atomic_load(p, __ATOMIC_RELAXED, __HIP_MEMORY_SCOPE_AGENT); }
DI unsigned xb_add(unsigned* p, unsigned v) { return __hip_atomic_fetch_add(p, v, __ATOMIC_RELAXED, __HIP_MEMORY_SCOPE_AGENT); }
DI unsigned xb_xcc_id() { return (unsigned)__builtin_amdgcn_s_getreg((3 << 11) | 20) & 0xFu; }
#define XB_SPIN(cond, bar) do { unsigned _sp = 0; while (cond) { __builtin_amdgcn_s_sleep(1); \
    if ((++_sp & 255u) == 0u) { if (xb_ld(&(bar)[XB_TMO])) break; if (_sp > XB_SPIN_CAP) { atomicAdd(&(bar)[XB_TMO], 1u); break; } } } } while (0)
DI void xcd_barrier_complete(unsigned* bar, unsigned x, unsigned G, unsigned& nloc, unsigned& nx) {
    unsigned sum, cnt, mine, sp = 0u;
    for (;;) {
        sum = 0u; cnt = 0u; mine = 0u;
#pragma unroll
        for (unsigned j = 0; j < 16; ++j) { const unsigned c = xb_ld(&bar[XB_XCNT(j)]); sum += c; cnt += (c > 0u) ? 1u : 0u; mine = (j == x) ? c : mine; }
        if (sum == G) break;
        __builtin_amdgcn_s_sleep(1);
        if ((++sp & 255u) == 0u) { if (xb_ld(&bar[XB_TMO])) break; if (sp > XB_SPIN_CAP) { atomicAdd(&bar[XB_TMO], 1u); break; } }
    }
    nloc = mine > 0u ? mine : 1u; nx = cnt > 0u ? cnt : 1u;
}
DI void xcd_barrier(unsigned* bar, volatile LAS unsigned* st, bool t0, unsigned G) {
    asm volatile("s_waitcnt vmcnt(0)" ::: "memory");
    __syncthreads();
    if (t0) {
        const unsigned x = xb_xcc_id();
        __builtin_amdgcn_s_waitcnt(0);
        unsigned nloc = st[0], nx = st[1];
        if (nloc == 0u) { xcd_barrier_complete(bar, x, G, nloc, nx); st[0] = nloc; st[1] = nx; }
        const unsigned old = xb_add(&bar[XB_XSUB(x)], 1u);
        const unsigned gen = old / nloc;
        if (old + 1u == (gen + 1u) * nloc) {
            __builtin_amdgcn_fence(__ATOMIC_RELEASE, "agent");
            asm volatile("s_waitcnt vmcnt(0)" ::: "memory");
            const unsigned og = xb_add(&bar[XB_TOP], 1u);
            const unsigned tg = og / nx;
            if (og + 1u == (tg + 1u) * nx) xb_add(&bar[XB_TOPGEN], 1u);
            else XB_SPIN(xb_ld(&bar[XB_TOPGEN]) == tg, bar);
            __builtin_amdgcn_fence(__ATOMIC_ACQUIRE, "agent");
            xb_add(&bar[XB_XGEN(x)], 1u);
            asm volatile("s_waitcnt vmcnt(0)" ::: "memory");
        } else {
            XB_SPIN(xb_ld(&bar[XB_XGEN(x)]) == gen, bar);
            __builtin_amdgcn_fence(__ATOMIC_ACQUIRE, "agent");
            asm volatile("s_waitcnt vmcnt(0)" ::: "memory");
        }
    }
    __syncthreads();
}

struct Args { const float* in[26]; float* out; unsigned char* ws; int ph_lo, ph_hi; };
constexpr int NPH = DEPTH * 11 + 1;

__global__ void __launch_bounds__(512, 2) mega_fwd(Args a) {
    extern __shared__ __attribute__((aligned(16))) unsigned char lds_raw[];
    LAS unsigned char* lds = (LAS unsigned char*)lds_raw;
    cg::grid_group grid = cg::this_grid();
    const int G = gridDim.x, bx = blockIdx.x;
    const int ph_lo = a.ph_lo, ph_hi = a.ph_hi;
    const int wave0 = __builtin_amdgcn_readfirstlane(threadIdx.x >> 6);
    {
        int ln0; asm volatile("v_mbcnt_lo_u32_b32 %0, -1, 0\n\tv_mbcnt_hi_u32_b32 %0, -1, %0" : "=v"(ln0));
        if (wave0 == 0 && ln0 == 0) {
            volatile LAS unsigned* xst = (volatile LAS unsigned*)(lds + LDS_XB); xst[0] = 0u; xst[1] = 0u;
            (void)xb_add(&((unsigned*)(a.ws + OFF_BAR))[XB_XCNT(xb_xcc_id())], 1u);
        }
        __syncthreads();
    }
#define PH_LOCALS \
    int lane_v; asm volatile("v_mbcnt_lo_u32_b32 %0, -1, 0\n\tv_mbcnt_hi_u32_b32 %0, -1, %0" : "=v"(lane_v)); int wave_s = wave0; asm volatile("" : "+s"(wave_s)); \
    const int lane = lane_v, wave = wave_s, tid = wave * 64 + lane; \
    const int gw = bx * 8 + wave, nw = G * 8; (void)gw; (void)nw; (void)lane; \
    const Args* ap = (const Args*)__builtin_amdgcn_kernarg_segment_ptr(); asm volatile("" : "+s"(ap)); \
    unsigned char* ws = as_global(ap->ws); float* X = as_global(ap->out); (void)X; \
    bf16_t* WIN = (bf16_t*)(ws + OFF_WIN); bf16_t* WUP = (bf16_t*)(ws + OFF_WUP); bf16_t* WDN = (bf16_t*)(ws + OFF_WDN); bf16_t* WOUT = (bf16_t*)(ws + OFF_WOUT); \
    bf16_t* WBR = (bf16_t*)(ws + OFF_WBR); bf16_t* WGLU = (bf16_t*)(ws + OFF_WGLU); bf16_t* WC1 = (bf16_t*)(ws + OFF_WC1); bf16_t* WC2 = (bf16_t*)(ws + OFF_WC2); \
    float* CB = (float*)(ws + OFF_CB); float* S5S = (float*)(ws + OFF_S5S); bf16_t* KC = (bf16_t*)(ws + OFF_KC); bf16_t* VCT = (bf16_t*)(ws + OFF_VCT); \
    float* ROPE = (float*)(ws + OFF_ROPE); \
    bf16_t* Hb = (bf16_t*)(ws + OFF_HY); bf16_t* YA = (bf16_t*)(ws + OFF_HY); bf16_t* YB = (bf16_t*)(ws + OFF_HY + YSZ); bf16_t* YC = (bf16_t*)(ws + OFF_HY + 2 * YSZ); \
    bf16_t* VT = YC; bf16_t* PROJ = (bf16_t*)(ws + OFF_PROJ); bf16_t* GG = (bf16_t*)(ws + OFF_G); bf16_t* MG = PROJ; bf16_t* HID = PROJ; \
    LAS unsigned char* wl = lds + wave * LDS_WAVE; \
    (void)WIN; (void)WUP; (void)WDN; (void)WOUT; (void)WBR; (void)WGLU; (void)WC1; (void)WC2; (void)CB; (void)S5S; (void)KC; (void)VCT; (void)ROPE; (void)Hb; (void)YA; (void)YB; (void)YC; (void)VT; (void)PROJ; (void)GG; (void)MG; (void)HID; (void)wl;

#define INP(k) as_global(ap->in[k])
#define PH_BEGIN(p) if (ph_lo <= (p) && (p) < ph_hi) { PH_LOCALS
#define PH_SYNC_CG do { asm volatile("s_waitcnt vmcnt(0)" ::: "memory"); __syncthreads(); if (wave0 == 0) { __builtin_amdgcn_fence(__ATOMIC_RELEASE, "agent"); asm volatile("s_waitcnt vmcnt(0)" ::: "memory"); } __syncthreads(); grid.sync(); if (wave0 == 0) { __builtin_amdgcn_fence(__ATOMIC_ACQUIRE, "agent"); asm volatile("s_waitcnt vmcnt(0)" ::: "memory"); } __syncthreads(); } while (0)
#define PH_SYNC_XCD do { int ln_; asm volatile("v_mbcnt_lo_u32_b32 %0, -1, 0\n\tv_mbcnt_hi_u32_b32 %0, -1, %0" : "=v"(ln_)); const Args* ap_ = (const Args*)__builtin_amdgcn_kernarg_segment_ptr(); asm volatile("" : "+s"(ap_)); \
    xcd_barrier((unsigned*)(ap_->ws + OFF_BAR), (volatile LAS unsigned*)(lds + LDS_XB), wave0 == 0 && ln_ == 0, (unsigned)G); } while (0)
#define PH_END(p) } if (ph_lo <= (p) && (p) + 1 < ph_hi) { PH_SYNC_XCD; }

    if (ph_hi - ph_lo > 1) grid.sync();
#pragma unroll 1
    for (int l = 0; l < DEPTH; ++l) {
        const int pb = l * 11;
        PH_BEGIN(pb + 0)
            LAS float* scr = (LAS float*)lds;
            for (int it = bx; it < 4294; it += G) {
                if (it >= 4292) {
                    const int j = it - 4292; const int hid = tid & 127, part = tid >> 7;
                    const float* pos = INP(4) + (size_t)(l * 2 + j) * 2048; const float* w1 = INP(5) + (size_t)(l * 2 + j) * 2048 * 128;
                    float s = 0.f;
                    for (int kk = part * 512; kk < part * 512 + 512; ++kk) s += pos[kk] * w1[(size_t)kk * 128 + hid];
                    scr[part * 128 + hid] = s;
                    __syncthreads();
                    if (tid < 128) CB[j * 128 + tid] = scr[tid] + scr[128 + tid] + scr[256 + tid] + scr[384 + tid];
                    __syncthreads();
                    continue;
                }
                int rr = it; const float* W; bf16_t* WT; int K, N, tn; bool remap = false;
                if (rr < 1408) { W = INP(3) + (size_t)l * 1024 * 5528; WT = WIN; K = 1024; N = 5528; tn = 88; remap = true; }
                else if ((rr -= 1408) < 1024) { W = INP(23) + (size_t)l * 1024 * 4096; WT = WUP; K = 1024; N = 4096; tn = 64; }
                else if ((rr -= 1024) < 1024) { W = INP(24) + (size_t)l * 4096 * 1024; WT = WDN; K = 4096; N = 1024; tn = 16; }
                else if ((rr -= 1024) < 256) { W = INP(21) + (size_t)l * 1024 * 1024; WT = WOUT; K = 1024; N = 1024; tn = 16; }
                else if ((rr -= 256) < 384) { const int br = rr / 128; rr %= 128; W = INP(18 + br) + (size_t)l * 512 * 1024; WT = WBR + (size_t)br * 1024 * 512; K = 512; N = 1024; tn = 16; }
                else if ((rr -= 384) < 64) { W = INP(16) + (size_t)l * 512 * 512; WT = WGLU; K = 512; N = 512; tn = 8; }
                else if ((rr -= 64) < 128) { const int j = rr / 64; rr %= 64; W = INP(5) + (size_t)(l * 2 + j) * 2048 * 128; WT = WC1 + (size_t)j * 128 * 2048; K = 2048; N = 128; tn = 2; }
                else { rr -= 128; const int j = rr / 2; rr %= 2; W = INP(6) + (size_t)(l * 2 + j) * 128 * 64; WT = WC2 + (size_t)j * 64 * 128; K = 128; N = 64; tn = 1; }
                const int k0 = (rr / tn) * 64, n0 = (rr % tn) * 64;
                {
                    const int tx = tid & 63, ty = tid >> 6; const int nn = n0 + tx; const int sc = remap ? in_srccol(nn) : nn;
#pragma unroll
                    for (int q = 0; q < 8; ++q) { const int k = k0 + ty * 8 + q; scr[(ty * 8 + q) * 65 + tx] = sc >= 0 ? W[(size_t)k * N + sc] : 0.f; }
                }
                __syncthreads();
                {
                    const int nn = tid >> 3, kc = (tid & 7) * 8;
                    f32x4 v0, v1;
#pragma unroll
                    for (int q = 0; q < 4; ++q) { v0[q] = scr[(kc + q) * 65 + nn]; v1[q] = scr[(kc + 4 + q) * 65 + nn]; }
                    *(u32x4*)(WT + (size_t)(n0 + nn) * K + k0 + kc) = pg8::pack8(v0, v1);
                }
                __syncthreads();
            }
            if (l == 0 && bx == 0 && tid < 64) ((unsigned*)(ws + OFF_CB + 2048))[tid] = 0u;
            if (l == 0) {
                const int* positions = (const int*)INP(1);
                for (int idx = bx * 512 + tid; idx < T * 32; idx += 131072) {
                    const int t = idx >> 5, i = idx & 31;
                    const float invf = exp2f(-(float)i * 0.41524101186092029f);
                    const float ang = (float)positions[t] * invf;
                    ROPE[2 * idx] = cosf(ang); ROPE[2 * idx + 1] = sinf(ang);
                }
                rmsnorm_rows<false>(INP(0), INP(2), Hb, nullptr, X, gw, nw, lane);
            } else {
                rmsnorm_rows<false>(X, INP(2) + (size_t)l * DM, Hb, nullptr, nullptr, gw, nw, lane);
            }
        PH_END(pb + 0)
        PH_BEGIN(pb + 1)
            pg8::Gemm g{Hb, WIN, T, NIN, DM, DM, 0, 0}; pg8::StaticOrder S; S.init(T, NIN, G, bx);
            pg8::EpiIn E{PROJ, GG};
            pg8::gemm_phase(lds, g, S, E, tid);
        PH_END(pb + 1)
        PH_BEGIN(pb + 2)
            { const int u = bx * 2 + (wave >> 2); compress_unit(PROJ, WC1, WC2, CB, ROPE, KC, VCT, u >> 8, (u >> 5) & 7, (u >> 4) & 1, u & 15, wave & 3, lds, wave, lane); }
            {
                LAS bf16_t* tile = (LAS bf16_t*)lds;
                for (int it = bx; it < 5 * 8 * 64; it += G) {
                    const int slot = it / 512, b = (it / 64) % 8, st = it % 64;
                    const int vcol = slot < 4 ? C_KVA + (1 + (slot >> 1)) * 256 + 128 + (slot & 1) * 64 : C_VB;
                    {
                        const int tok = tid >> 3, dc = (tid & 7) * 8;
                        const bf16x8 v = *(const bf16x8*)(PROJ + ((size_t)b * SEQ + st * 64 + tok) * PP + vcol + dc);
#pragma unroll
                        for (int j = 0; j < 8; ++j) tile[(dc + j) * 72 + perm16(tok)] = (bf16_t)v[j];
                    }
                    __syncthreads();
                    {
                        const int d = tid >> 3, tc = (tid & 7) * 8;
                        const bf16x8 v = *(const LAS bf16x8*)(tile + d * 72 + tc);
                        *(bf16x8*)(VT + (size_t)(slot * 8 + b) * 64 * SEQ + (size_t)(st * 4 + (tc >> 4)) * 1024 + d * 16 + (tc & 8)) = v;
                    }
                    __syncthreads();
                }
            }
            for (int idx = bx * 512 + tid; idx < T * 84; idx += 131072) {
                const int t = idx / 84, rem = idx % 84, head = rem >> 2, ch = rem & 3;
                int col;
                if (head < 8) col = C_QA + head * 64; else if (head < 12) { const int hh = head - 8; col = C_KVA + (1 + (hh >> 1)) * 256 + (hh & 1) * 64; }
                else if (head < 20) col = C_QB + (head - 12) * 64; else col = C_KB;
                bf16_t* p = PROJ + (size_t)t * PP + col + 8 * ch;
                f32x4 a0, a1, b0, b1; pg8::unpack8(*(const u32x4*)p, a0, a1); pg8::unpack8(*(const u32x4*)(p + 32), b0, b1);
                const float* cs = ROPE + ((size_t)t * 32 + 8 * ch) * 2;
                f32x4 o0, o1, q0, q1;
#pragma unroll
                for (int j = 0; j < 4; ++j) {
                    const float c0 = cs[2 * j], s0 = cs[2 * j + 1], c1 = cs[2 * (j + 4)], s1 = cs[2 * (j + 4) + 1];
                    o0[j] = a0[j] * c0 - b0[j] * s0; q0[j] = b0[j] * c0 + a0[j] * s0;
                    o1[j] = a1[j] * c1 - b1[j] * s1; q1[j] = b1[j] * c1 + a1[j] * s1;
                }
                *(u32x4*)p = pg8::pack8(o0, o1); *(u32x4*)(p + 32) = pg8::pack8(q0, q1);
            }
            {
                const S5In P{INP(8) + (size_t)l * 2048, INP(9) + (size_t)l * 2048, INP(10) + (size_t)l * 32, INP(11) + (size_t)l * 32768, INP(12) + (size_t)l * 32768,
                             INP(13) + (size_t)l * 32768, INP(14) + (size_t)l * 32768, INP(15) + (size_t)l * 512};
            }
        PH_END(pb + 2)
        PH_BEGIN(pb + 4)
            {
                const S5In P{INP(8) + (size_t)l * 2048, INP(9) + (size_t)l * 2048, INP(10) + (size_t)l * 32, INP(11) + (size_t)l * 32768, INP(12) + (size_t)l * 32768,
                             INP(13) + (size_t)l * 32768, INP(14) + (size_t)l * 32768, INP(15) + (size_t)l * 512};
                if (bx < 64 && wave < 4) s5_unit<true>(P, PROJ, S5S, bx >> 3, 4 * (bx & 7) + wave, 0, 128, wl, lane);
            }
            {
                unsigned* xbw = (unsigned*)(ws + OFF_BAR);
                const unsigned xme = xb_xcc_id(); unsigned rk = 0, nx = 0;
#pragma unroll
                for (unsigned j = 0; j < 16; ++j) { const unsigned c = xb_ld(&xbw[XB_XCNT(j)]); if (c) { rk += (j < xme) ? 1u : 0u; ++nx; } }
                rk = __builtin_amdgcn_readfirstlane(rk); nx = __builtin_amdgcn_readfirstlane(nx); if (nx == 0u) nx = 1u;
                const unsigned nbA = rk < 16u ? (16u - rk + nx - 1u) / nx : 0u, nbB = rk < 8u ? (8u - rk + nx - 1u) / nx : 0u;
                const unsigned totA = nbA * 256u, totB = nbB * 512u;
                unsigned* ctr = (unsigned*)(ws + OFF_CB + 2048) + l * 16 + rk;
                for (;;) {
                    unsigned i = 0;
                    if (lane == 0) i = atomicAdd(ctr, 1u);
                    i = __builtin_amdgcn_readfirstlane(i);
                    if (i >= totA + totB) break;
                    if (i < totA) {
                        const unsigned g8 = i >> 3, bl = g8 % nbA, q8 = g8 / nbA;
                        const int bh = (int)(rk + nx * bl), qt = (31 - (int)q8) * 8 + (int)(i & 7u);
                        attnA_unit(PROJ, KC, VCT, VT, YA, bh >> 1, bh & 1, qt * 16, wl, lane);
                    } else {
                        const unsigned u = i - totA; const int b = (int)(rk + nx * (u >> 9));
                        attnB_unit(PROJ, VT, INP(7) + (size_t)l * 8, YB, b, (int)(u & 511u) * 8, lane);
                    }
                }
            }
        PH_END(pb + 4)
        PH_BEGIN(pb + 5)
            pg8::Gemm g{PROJ + C_U, WGLU, T, 512, 512, PP, 0, 0}; pg8::StaticOrder S; S.init(T, 512, G, bx);
            pg8::EpiGlu E{PROJ + C_U, INP(17) + (size_t)l * 512, YC};
            pg8::gemm_phase(lds, g, S, E, tid);
        PH_END(pb + 5)
        PH_BEGIN(pb + 6)
            pg8::Gemm g{YA, WBR, T, DM, 512, 512, YSZ, (size_t)DM * 512 * 2}; pg8::Z3Order S; S.init(T, DM, G, bx);
            pg8::EpiMerge E{GG, MG};
            pg8::gemm_phase(lds, g, S, E, tid);
        PH_END(pb + 6)
        PH_BEGIN(pb + 7)
            pg8::Gemm g{MG, WOUT, T, DM, DM, DM, 0, 0}; pg8::StaticOrder S; S.init(T, DM, G, bx);
            pg8::EpiResid E{X};
            pg8::gemm_phase(lds, g, S, E, tid);
        PH_END(pb + 7)
        PH_BEGIN(pb + 8)
            rmsnorm_rows<false>(X, INP(22) + (size_t)l * DM, Hb, nullptr, nullptr, gw, nw, lane);
        PH_END(pb + 8)
        PH_BEGIN(pb + 9)
            pg8::Gemm g{Hb, WUP, T, DFF, DM, DM, 0, 0}; pg8::StaticOrder S; S.init(T, DFF, G, bx);
            pg8::EpiUp E{HID};
            pg8::gemm_phase(lds, g, S, E, tid);
        PH_END(pb + 9)
        PH_BEGIN(pb + 10)
            pg8::Gemm g{HID, WDN, T, DM, DFF, DFF, 0, 0}; pg8::StaticOrder S; S.init(T, DM, G, bx);
            pg8::EpiResid E{X};
            pg8::gemm_phase(lds, g, S, E, tid);
        PH_END(pb + 10)
    }
    PH_BEGIN(NPH - 1)
        rmsnorm_rows<true>(X, INP(25), nullptr, X, nullptr, gw, nw, lane);
    }
}

extern "C" void kernel_launch(void* const* d_in, const int* in_sizes, int n_in, void* d_out, int out_size, void* d_ws, size_t ws_size, hipStream_t stream) {
    static int ready = 0;
    if (ready == 0) {
        if (n_in != 26 || out_size != T * DM || ws_size < WS_END + BAR_BYTES) { fprintf(stderr, "kernel_launch: unexpected shapes (n_in %d out %d ws %zu need %zu)\n", n_in, out_size, ws_size, (size_t)WS_END); ready = -1; return; }
        if (hipFuncSetAttribute((const void*)mega_fwd, hipFuncAttributeMaxDynamicSharedMemorySize, LDS_BYTES) != hipSuccess) { fprintf(stderr, "kernel_launch: hipFuncSetAttribute failed\n"); ready = -1; return; }
        ready = 1;
    }
    if (ready < 0) return;
#ifdef DBG_MEMSET
    hipMemsetAsync(d_ws, 0xAA, WS_END, stream); hipMemsetAsync(d_out, 0xAA, (size_t)T * DM * 4, stream);
#endif
    if (hipMemsetAsync((unsigned char*)d_ws + OFF_BAR, 0, BAR_BYTES, stream) != hipSuccess) { fprintf(stderr, "kernel_launch: barrier memset failed\n"); return; }
    Args a{};
    for (int i = 0; i < 26; ++i) a.in[i] = (const float*)d_in[i];
    a.out = (float*)d_out; a.ws = (unsigned char*)d_ws;
#if MK_MULTI
    for (int p = 0; p < NPH; ++p) { a.ph_lo = p; a.ph_hi = p + 1; hipLaunchKernelGGL(mega_fwd, dim3(256), dim3(512), LDS_BYTES, stream, a); }
#else
    a.ph_lo = 0; a.ph_hi = NPH;
    void* args[] = {&a};
    hipError_t e = hipLaunchCooperativeKernel((const void*)mega_fwd, dim3(256), dim3(512), args, LDS_BYTES, stream);
    if (e != hipSuccess) fprintf(stderr, "cooperative launch failed: %s\n", hipGetErrorString(e));
#endif
}
```

```cpp
#include <hip/hip_runtime.h>
#include <hip/hip_cooperative_groups.h>
#include <cstdio>
#include <cstdint>
namespace cg = cooperative_groups;

typedef unsigned short bf16_t;
typedef short bf16x8 __attribute__((ext_vector_type(8)));
typedef short s16x4 __attribute__((ext_vector_type(4)));
typedef float f32x4 __attribute__((ext_vector_type(4)));
typedef float f32x16 __attribute__((ext_vector_type(16)));
typedef unsigned u32x4 __attribute__((ext_vector_type(4)));
typedef unsigned u32x2 __attribute__((ext_vector_type(2)));
typedef __bf16 bf16x2_t __attribute__((ext_vector_type(2)));
typedef float f32x2_t __attribute__((ext_vector_type(2)));
#define LAS __attribute__((address_space(3)))
#define DI __device__ __forceinline__

#ifndef MK_MULTI
#define MK_MULTI 0
#endif
#ifndef DBG_MASK
#define DBG_MASK 7
#endif

constexpr int T = 32768, SEQ = 4096, NBATCH = 8, DM = 1024, PP = 2560, NGM = 3072, NIN = 5632, DFF = 4096, DEPTH = 4;
constexpr int C_QA = 0, C_KVA = 512, C_QB = 1280, C_KB = 1792, C_VB = 1856, C_U = 1920, C_GA = 2432;
constexpr float NORM_EPS = 1e-6f;
constexpr float SC2 = 0.125f * 1.4426950408889634f;
constexpr float LOG2E = 1.4426950408889634f;

constexpr size_t OFF_WIN = 0;
constexpr size_t OFF_WUP = OFF_WIN + (size_t)NIN * DM * 2;
constexpr size_t OFF_WDN = OFF_WUP + (size_t)DFF * DM * 2;
constexpr size_t OFF_WOUT = OFF_WDN + (size_t)DFF * DM * 2;
constexpr size_t OFF_WBR = OFF_WOUT + (size_t)DM * DM * 2;
constexpr size_t OFF_WGLU = OFF_WBR + (size_t)3 * DM * 512 * 2;
constexpr size_t OFF_WC1 = OFF_WGLU + (size_t)512 * 512 * 2;
constexpr size_t OFF_WC2 = OFF_WC1 + (size_t)2 * 128 * 2048 * 2;
constexpr size_t OFF_CB = OFF_WC2 + (size_t)2 * 64 * 128 * 2;
constexpr size_t OFF_S5S = OFF_CB + 4096;
constexpr size_t OFF_KC = OFF_S5S + (size_t)8 * 32 * 8 * 64 * 8;
constexpr size_t OFF_VCT = OFF_KC + (size_t)8 * 2 * 256 * 64 * 2;
constexpr size_t OFF_ROPE = OFF_VCT + (size_t)8 * 2 * 256 * 64 * 2;
constexpr size_t OFF_HY = OFF_ROPE + (size_t)T * 32 * 8;
constexpr size_t YSZ = (size_t)T * 512 * 2;
constexpr size_t OFF_PROJ = OFF_HY + 3 * YSZ;
constexpr size_t OFF_G = OFF_PROJ + (size_t)T * PP * 2;
constexpr size_t WS_END = OFF_G + (size_t)T * NGM * 2;
constexpr size_t OFF_BAR = WS_END;
constexpr size_t BAR_BYTES = 3456 * 4;
static_assert(WS_END + BAR_BYTES <= (size_t)512 * 1024 * 1024, "workspace too large");
static_assert((size_t)T * DFF * 2 <= WS_END - OFF_PROJ, "hidden overlay");
constexpr int LDS_WAVE = 18688;
constexpr int LDS_XB = 8 * LDS_WAVE;
constexpr int LDS_BYTES = 8 * LDS_WAVE + 16;

template <class Tp> DI Tp* as_global(Tp* p) { return p; }
DI float bf2f(bf16_t v) { return __uint_as_float((unsigned)v << 16); }
DI unsigned pk2(float lo, float hi) { f32x2_t v = {lo, hi}; bf16x2_t b = __builtin_convertvector(v, bf16x2_t); return __builtin_bit_cast(unsigned, b); }
DI float sigmoidf_(float x) { return __builtin_amdgcn_rcpf(1.0f + __expf(-x)); }
DI float gelu_tanh(float x) { const float u = 0.7978845608028654f * (x + 0.044715f * x * x * x); const float e = __expf(2.0f * u); const float th = 1.0f - 2.0f * __builtin_amdgcn_rcpf(e + 1.0f); return 0.5f * x * (1.0f + th); }
DI int perm16(int x) { return (x & ~12) | ((x & 4) << 1) | ((x & 8) >> 1); }
DI int crow(int reg, int h) { return (reg & 3) + 8 * (reg >> 2) + 4 * h; }
DI float shx(float v, int m, int lane) { return __int_as_float(__builtin_amdgcn_ds_bpermute((lane ^ m) << 2, __float_as_int(v))); }
typedef unsigned u32x2s __attribute__((ext_vector_type(2)));
DI float xmax32(float v) { const u32x2s r = __builtin_amdgcn_permlane32_swap(__float_as_uint(v), __float_as_uint(v), false, false); return fmaxf(__uint_as_float(r[0]), __uint_as_float(r[1])); }
DI float xsum32(float v) { const u32x2s r = __builtin_amdgcn_permlane32_swap(__float_as_uint(v), __float_as_uint(v), false, false); return __uint_as_float(r[0]) + __uint_as_float(r[1]); }
DI float wave_sum(float v, int lane) {
#pragma unroll
    for (int o = 32; o >= 1; o >>= 1) v += shx(v, o, lane);
    return v;
}
#define MFMA32(a, b, c) __builtin_amdgcn_mfma_f32_32x32x16_bf16((a), (b), (c), 0, 0, 0)
#define MFMA16(a, b, c) __builtin_amdgcn_mfma_f32_16x16x32_bf16((a), (b), (c), 0, 0, 0)

namespace pg8 {
constexpr int BM = 256, BK = 64, HALF = 128, HTB = HALF * BK * 2, STAGE_BYTES = 8 * HTB, NXCD = 8, WGM = 8;
__host__ __device__ __forceinline__ int lds_byte(int r, int c) { const int st = (r >> 4) * 2 + (c >> 5), rr = r & 15, cc = c & 31, ob = rr * 64 + cc * 2; return st * 1024 + (ob ^ (((ob >> 9) & 1) << 5)); }
__host__ __device__ __forceinline__ void stage_rc(int b, int& R, int& C) { const int st = b / 1024, sb = b % 1024, swz = sb ^ (((sb >> 9) & 1) << 5); R = (st >> 1) * 16 + swz / 64; C = (st & 1) * 32 + (swz % 64) / 2; }
__host__ __device__ __forceinline__ int perm32(int rho) { const int n = rho >> 4, i = rho & 15; return 8 * (i >> 2) + 4 * n + (i & 3); }

struct Unit { int pm, pn, z; };
struct Gemm { const bf16_t* A; const bf16_t* Bt; int M, N, K, lda; size_t zA, zB; };

DI void tile_of(int wgid, int nwg, int nM, int nN, int& pm, int& pn) {
    { const int q = nwg / NXCD, r = nwg % NXCD, xcd = wgid % NXCD, off = wgid / NXCD; wgid = (xcd < r ? xcd * (q + 1) : r * (q + 1) + (xcd - r) * q) + off; }
    const int nig = WGM * nN, gid = wgid / nig, fm = gid * WGM, gsz = (nM - fm) < WGM ? (nM - fm) : WGM;
    pm = fm + ((wgid % nig) % gsz); pn = (wgid % nig) / gsz;
}
struct StaticOrder {
    int nM, nN, nwg, G, c;
    DI void init(int M, int N, int G_, int c_) { nM = M / BM; nN = N / BM; nwg = nM * nN; G = G_; c = c_; }
    DI bool next(int i, Unit& u) const { const long L = (long)i * G + c; if (L >= nwg) return false; tile_of((int)L, nwg, nM, nN, u.pm, u.pn); u.z = 0; return true; }
};
struct Z3Order {
    int nM, nN, nwg, G, c;
    DI void init(int M, int N, int G_, int c_) { nM = M / BM; nN = N / BM; nwg = nM * nN; G = G_; c = c_; }
    DI bool next(int i, Unit& u) const { const long L = (long)(i / 3) * G + c; if (L >= nwg) return false; tile_of((int)L, nwg, nM, nN, u.pm, u.pn); u.z = i % 3; return true; }
};

template <class Epi, class Sched>
DI void gemm_phase(LAS unsigned char* lds, const Gemm g, const Sched& S, const Epi& E, int tid_l) {
    asm volatile("" : "+v"(tid_l));
    const int tid = tid_l, wid = __builtin_amdgcn_readfirstlane(tid >> 6), lane = tid & 63, wr = wid >> 2, wc = wid & 3, fr = lane & 15, fq = lane >> 4;
    const int K = g.K, nt = K / BK;
    unsigned voffA[2], voffB[2];
#pragma unroll
    for (int i = 0; i < 2; ++i) { int R, C; stage_rc(tid * 16 + i * 8192, R, C); const int Rb = (R & ~31) + perm32(R & 31);
        voffA[i] = (unsigned)(R * g.lda + C) * 2u; voffB[i] = (unsigned)(Rb * K + C) * 2u; }
    const size_t kstep = (size_t)(BK * 2);
    const size_t hstepA = (size_t)HALF * g.lda * 2, hstepB = (size_t)HALF * K * 2;
    const size_t tstepA = 2 * hstepA, tstepB = 2 * hstepB;
    const unsigned ldsw = (unsigned)wid * 1024u;
    const int aoff = lds_byte(wr * 64 + fr, fq * 8), boff = lds_byte(wc * 32 + fr, fq * 8);
#define PG8_SA(b, h) (((b) * 2 + (h)) * HTB)
#define PG8_SB(b, h) ((4 + (b) * 2 + (h)) * HTB)
#define PG8_STAGE(bufoff, gbase, voff) do { _Pragma("unroll") for (int _i = 0; _i < 2; ++_i) \
        __builtin_amdgcn_global_load_lds((const unsigned*)((const char*)(gbase) + (voff)[_i]), (LAS unsigned*)(lds + (bufoff) + ldsw + _i * 8192), 16, 0, 0); } while (0)
#define PG8_LDA(dst, b, h) do { _Pragma("unroll") for (int m = 0; m < 4; ++m) _Pragma("unroll") for (int k = 0; k < 2; ++k) dst[m][k] = *(const LAS bf16x8*)(lds + PG8_SA(b, h) + aoff + m * 2048 + k * 1024); } while (0)
#define PG8_LDB(dst, b, h) do { _Pragma("unroll") for (int n = 0; n < 2; ++n) _Pragma("unroll") for (int k = 0; k < 2; ++k) dst[n][k] = *(const LAS bf16x8*)(lds + PG8_SB(b, h) + boff + n * 2048 + k * 1024); } while (0)
#define PG8_MMA(ai, bj, At, Bt) do { __builtin_amdgcn_s_setprio(1); _Pragma("unroll") for (int m = 0; m < 4; ++m) _Pragma("unroll") for (int n = 0; n < 2; ++n) _Pragma("unroll") for (int k = 0; k < 2; ++k) \
        acc[ai][bj][m][n] = __builtin_amdgcn_mfma_f32_16x16x32_bf16(Bt[n][k], At[m][k], acc[ai][bj][m][n], 0, 0, 0); __builtin_amdgcn_s_setprio(0); } while (0)
#define PG8_WAIT_V(n) asm volatile("s_waitcnt vmcnt(" #n ")" ::: "memory")
#define PG8_WAIT_L(n) asm volatile("s_waitcnt lgkmcnt(" #n ")" ::: "memory")
#define PG8_BAR __builtin_amdgcn_s_barrier()
#define PG8_SCHED __builtin_amdgcn_sched_barrier(0)
    Unit cur, nxt; int ui = 0;
    if (!S.next(0, cur)) return;
    f32x4 acc[2][2][4][2];
#pragma unroll
    for (int a = 0; a < 2; ++a)
#pragma unroll
        for (int b = 0; b < 2; ++b)
#pragma unroll
            for (int m = 0; m < 4; ++m)
#pragma unroll
                for (int n = 0; n < 2; ++n) acc[a][b][m][n] = (f32x4){0.f, 0.f, 0.f, 0.f};
    bf16x8 At[4][2], B0[2][2], B1[2][2];
    const char* cA = (const char*)g.A + (size_t)cur.z * g.zA + (size_t)cur.pm * tstepA; const char* cB = (const char*)g.Bt + (size_t)cur.z * g.zB + (size_t)cur.pn * tstepB;
    PG8_STAGE(PG8_SB(0, 0), cB, voffB); PG8_STAGE(PG8_SB(0, 1), cB + hstepB, voffB); PG8_STAGE(PG8_SA(0, 0), cA, voffA); PG8_STAGE(PG8_SA(0, 1), cA + hstepA, voffA);
    if (wr == 1) PG8_BAR;
    PG8_WAIT_V(2); PG8_BAR;
    PG8_STAGE(PG8_SB(1, 0), cB + kstep, voffB); PG8_STAGE(PG8_SA(1, 0), cA + kstep, voffA); PG8_STAGE(PG8_SB(1, 1), cB + hstepB + kstep, voffB);
    PG8_WAIT_V(6); PG8_BAR;
    for (;;) {
        const bool has_next = S.next(ui + 1, nxt);
        const char* nA = has_next ? (const char*)g.A + (size_t)nxt.z * g.zA + (size_t)nxt.pm * tstepA : cA; const char* nB = has_next ? (const char*)g.Bt + (size_t)nxt.z * g.zB + (size_t)nxt.pn * tstepB : cB;
        for (int t = 0; t < nt; t += 2) {
            const bool last = (t == nt - 2);
            const char* a1 = cA + (size_t)(t + 1) * kstep;
            const char* a2 = last ? nA : cA + (size_t)(t + 2) * kstep; const char* b2 = last ? nB : cB + (size_t)(t + 2) * kstep;
            const char* a3 = a2 + kstep; const char* b3 = b2 + kstep;
            PG8_LDB(B0, 0, 0); PG8_LDB(B1, 0, 1); PG8_SCHED; PG8_LDA(At, 0, 0); PG8_STAGE(PG8_SA(1, 1), a1 + hstepA, voffA);
            PG8_WAIT_V(8); PG8_WAIT_L(0); PG8_BAR; PG8_MMA(0, 0, At, B0); PG8_MMA(0, 1, At, B1); PG8_BAR; PG8_SCHED;
            PG8_LDA(At, 0, 1); PG8_STAGE(PG8_SB(0, 0), b2, voffB); PG8_STAGE(PG8_SB(0, 1), b2 + hstepB, voffB); PG8_STAGE(PG8_SA(0, 0), a2, voffA);
            PG8_WAIT_V(8); PG8_WAIT_L(0); PG8_BAR; PG8_MMA(1, 0, At, B0); PG8_MMA(1, 1, At, B1); PG8_BAR; PG8_SCHED;
            PG8_LDB(B0, 1, 0); PG8_LDB(B1, 1, 1); PG8_SCHED; PG8_LDA(At, 1, 0); PG8_STAGE(PG8_SA(0, 1), a2 + hstepA, voffA);
            PG8_WAIT_V(8); PG8_WAIT_L(0); PG8_BAR; PG8_MMA(0, 0, At, B0); PG8_MMA(0, 1, At, B1); PG8_BAR; PG8_SCHED;
            PG8_LDA(At, 1, 1); PG8_STAGE(PG8_SB(1, 0), b3, voffB); PG8_STAGE(PG8_SB(1, 1), b3 + hstepB, voffB); PG8_STAGE(PG8_SA(1, 0), a3, voffA);
            PG8_WAIT_V(8); PG8_WAIT_L(0); PG8_BAR; PG8_MMA(1, 0, At, B0); PG8_MMA(1, 1, At, B1); PG8_BAR; PG8_SCHED;
        }
        if (wr == 0) PG8_BAR;
        E(acc, cur, wr, wc, fr, fq);
        if (!has_next) break;
#pragma unroll
        for (int a = 0; a < 2; ++a)
#pragma unroll
            for (int b = 0; b < 2; ++b)
#pragma unroll
                for (int m = 0; m < 4; ++m)
#pragma unroll
                    for (int n = 0; n < 2; ++n) acc[a][b][m][n] = (f32x4){0.f, 0.f, 0.f, 0.f};
        cur = nxt; cA = nA; cB = nB; ++ui;
        if (wr == 1) PG8_BAR;
    }
    PG8_WAIT_V(0);
    PG8_BAR;
#undef PG8_SA
#undef PG8_SB
#undef PG8_STAGE
#undef PG8_LDA
#undef PG8_LDB
#undef PG8_MMA
#undef PG8_WAIT_V
#undef PG8_WAIT_L
#undef PG8_BAR
#undef PG8_SCHED
}

#define EPI_LOOP_BEGIN \
    const int row0 = u.pm * BM + wr * 64 + fr; \
    _Pragma("unroll") for (int ai = 0; ai < 2; ++ai) _Pragma("unroll") for (int m = 0; m < 4; ++m) { const size_t row = (size_t)(row0 + ai * HALF + m * 16); \
    _Pragma("unroll") for (int bj = 0; bj < 2; ++bj) { const int col = u.pn * BM + bj * HALF + wc * 32 + 8 * fq; f32x4 v0 = acc[ai][bj][m][0], v1 = acc[ai][bj][m][1];
#define EPI_LOOP_END } }
DI u32x4 pack8(f32x4 v0, f32x4 v1) { u32x4 w; w.x = pk2(v0[0], v0[1]); w.y = pk2(v0[2], v0[3]); w.z = pk2(v1[0], v1[1]); w.w = pk2(v1[2], v1[3]); return w; }
DI void unpack8(u32x4 w, f32x4& a, f32x4& b) {
    a[0] = __uint_as_float(w.x << 16); a[1] = __uint_as_float(w.x & 0xffff0000u); a[2] = __uint_as_float(w.y << 16); a[3] = __uint_as_float(w.y & 0xffff0000u);
    b[0] = __uint_as_float(w.z << 16); b[1] = __uint_as_float(w.z & 0xffff0000u); b[2] = __uint_as_float(w.w << 16); b[3] = __uint_as_float(w.w & 0xffff0000u);
}
struct EpiIn {
    bf16_t* proj; bf16_t* G;
    DI void operator()(const f32x4 (&acc)[2][2][4][2], const Unit& u, int wr, int wc, int fr, int fq) const {
        EPI_LOOP_BEGIN
            if (col >= C_GA) {
#pragma unroll
                for (int j = 0; j < 4; ++j) { v0[j] = sigmoidf_(v0[j]); v1[j] = sigmoidf_(v1[j]); }
            }
            bf16_t* dst = (col < PP) ? proj + row * PP + col : G + row * NGM + (col - PP);
            *(u32x4*)dst = pack8(v0, v1);
        EPI_LOOP_END
    }
};
struct EpiGlu {
    const bf16_t* z; const float* bias; bf16_t* yc;
    DI void operator()(const f32x4 (&acc)[2][2][4][2], const Unit& u, int wr, int wc, int fr, int fq) const {
        const int row0 = u.pm * BM + wr * 64 + fr; const int colb = u.pn * BM + wc * 32 + 8 * fq;
        f32x4 b0[2], b1[2];
#pragma unroll
        for (int bj = 0; bj < 2; ++bj) { b0[bj] = *(const f32x4*)(bias + colb + bj * HALF); b1[bj] = *(const f32x4*)(bias + colb + bj * HALF + 4); }
#pragma unroll
        for (int ai = 0; ai < 2; ++ai) {
            u32x4 zq[4][2];
#pragma unroll
            for (int m = 0; m < 4; ++m)
#pragma unroll
                for (int bj = 0; bj < 2; ++bj) zq[m][bj] = *(const u32x4*)(z + (size_t)(row0 + ai * HALF + m * 16) * PP + colb + bj * HALF);
#pragma unroll
            for (int m = 0; m < 4; ++m)
#pragma unroll
                for (int bj = 0; bj < 2; ++bj) {
                    f32x4 z0, z1; unpack8(zq[m][bj], z0, z1); f32x4 v0 = acc[ai][bj][m][0], v1 = acc[ai][bj][m][1];
#pragma unroll
                    for (int j = 0; j < 4; ++j) { v0[j] = z0[j] * sigmoidf_(v0[j] + b0[bj][j]); v1[j] = z1[j] * sigmoidf_(v1[j] + b1[bj][j]); }
                    *(u32x4*)(yc + (size_t)(row0 + ai * HALF + m * 16) * 512 + colb + bj * HALF) = pack8(v0, v1);
                }
        }
    }
};
struct EpiMerge {
    const bf16_t* G; bf16_t* mg;
    DI void operator()(const f32x4 (&acc)[2][2][4][2], const Unit& u, int wr, int wc, int fr, int fq) const {
        const int row0 = u.pm * BM + wr * 64 + fr; const int colb = u.pn * BM + wc * 32 + 8 * fq;
#pragma unroll
        for (int ai = 0; ai < 2; ++ai) {
            u32x4 gq[4][2], pq[4][2];
#pragma unroll
            for (int m = 0; m < 4; ++m)
#pragma unroll
                for (int bj = 0; bj < 2; ++bj) {
                    const size_t row = (size_t)(row0 + ai * HALF + m * 16); const int col = colb + bj * HALF;
                    gq[m][bj] = *(const u32x4*)(G + row * NGM + u.z * DM + col);
                    pq[m][bj] = (u.z > 0) ? *(const u32x4*)(mg + row * DM + col) : (u32x4){0u, 0u, 0u, 0u};
                }
#pragma unroll
            for (int m = 0; m < 4; ++m)
#pragma unroll
                for (int bj = 0; bj < 2; ++bj) {
                    const size_t row = (size_t)(row0 + ai * HALF + m * 16); const int col = colb + bj * HALF;
                    f32x4 g0, g1, p0, p1; unpack8(gq[m][bj], g0, g1); unpack8(pq[m][bj], p0, p1);
                    const f32x4 v0 = acc[ai][bj][m][0] * g0 + p0, v1 = acc[ai][bj][m][1] * g1 + p1;
                    *(u32x4*)(mg + row * DM + col) = pack8(v0, v1);
                }
        }
    }
};
struct EpiResid {
    float* x;
    DI void operator()(const f32x4 (&acc)[2][2][4][2], const Unit& u, int wr, int wc, int fr, int fq) const {
        const int row0 = u.pm * BM + wr * 64 + fr; const int colb = u.pn * BM + wc * 32 + 8 * fq;
#pragma unroll
        for (int ai = 0; ai < 2; ++ai) {
            f32x4 xa[4][2], xb[4][2];
#pragma unroll
            for (int m = 0; m < 4; ++m)
#pragma unroll
                for (int bj = 0; bj < 2; ++bj) {
                    const float* p = x + (size_t)(row0 + ai * HALF + m * 16) * DM + colb + bj * HALF;
                    xa[m][bj] = *(const f32x4*)p; xb[m][bj] = *(const f32x4*)(p + 4);
                }
#pragma unroll
            for (int m = 0; m < 4; ++m)
#pragma unroll
                for (int bj = 0; bj < 2; ++bj) {
                    float* p = x + (size_t)(row0 + ai * HALF + m * 16) * DM + colb + bj * HALF;
                    *(f32x4*)p = xa[m][bj] + acc[ai][bj][m][0]; *(f32x4*)(p + 4) = xb[m][bj] + acc[ai][bj][m][1];
                }
        }
    }
};
struct EpiUp {
    bf16_t* hid;
    DI void operator()(const f32x4 (&acc)[2][2][4][2], const Unit& u, int wr, int wc, int fr, int fq) const {
        EPI_LOOP_BEGIN
#pragma unroll
            for (int j = 0; j < 4; ++j) { const float a = fmaxf(v0[j], 0.f), b = fmaxf(v1[j], 0.f); v0[j] = a * a; v1[j] = b * b; }
            *(u32x4*)(hid + row * DFF + col) = pack8(v0, v1);
        EPI_LOOP_END
    }
};
}

enum { MODE_WIN = 0, MODE_CMP = 1, MODE_SEL = 2 };
template <int MODE>
DI void fa_tile(f32x16 (&o)[2][2], float (&m)[2], float (&ls)[2], const bf16x8 (&qf)[2][4],
                bf16x8 (&kf)[4], const bf16_t* knext, const bf16_t* VTb, int vpitch, int vks, int kbase, int r, int h,
                const int (&qpos)[2], int W, bool rs0, bool rs1, int qlo, int qhi) {
    bool fullw;
    if (MODE == MODE_WIN) fullw = (kbase + 31 <= qlo) && (kbase > qhi - W);
    else if (MODE == MODE_CMP) fullw = (16 * (kbase + 31) + 31 <= qlo);
    else fullw = (kbase + 31 <= qlo) && (__builtin_amdgcn_ballot_w64(rs0 && rs1) == ~0ull);
    bf16x8 vf[2][2];
#pragma unroll
    for (int dt = 0; dt < 2; ++dt)
#pragma unroll
        for (int s = 0; s < 2; ++s) {
            vf[dt][s] = *(const bf16x8*)(VTb + (size_t)(32 * dt + r) * vpitch + (size_t)(kbase + 16 * s) * vks + 8 * h);
        }
#pragma unroll
    for (int rt = 0; rt < 2; ++rt) {
        f32x16 st;
#pragma unroll
        for (int i = 0; i < 16; ++i) st[i] = 0.f;
#pragma unroll
        for (int ks = 0; ks < 4; ++ks) st = MFMA32(kf[ks], qf[rt][ks], st);
        if (rt == 1) {
#pragma unroll
            for (int ks = 0; ks < 4; ++ks) kf[ks] = *(const bf16x8*)(knext + 16 * ks);
        }
        const int qp = qpos[rt]; const bool rs = rt == 0 ? rs0 : rs1;
        if (!fullw) {
#pragma unroll
            for (int i = 0; i < 16; ++i) {
                const int kpos = kbase + crow(i, h);
                bool valid;
                if (MODE == MODE_WIN) valid = (kpos <= qp) && (kpos > qp - W);
                else if (MODE == MODE_CMP) valid = (16 * kpos + 31 <= qp);
                else valid = rs && (kpos <= qp);
                st[i] = valid ? st[i] : -INFINITY;
            }
        }
        float mx = st[0];
#pragma unroll
        for (int i = 1; i < 16; ++i) mx = fmaxf(mx, st[i]);
        mx = xmax32(mx);
        const float cand = fmaxf(m[rt], mx * SC2);
        if (__builtin_amdgcn_ballot_w64((cand - m[rt]) > 8.0f) != 0ull) {
            const float alpha = __builtin_amdgcn_exp2f(m[rt] - cand);
            m[rt] = cand; ls[rt] *= alpha;
#pragma unroll
            for (int dt = 0; dt < 2; ++dt)
#pragma unroll
                for (int i = 0; i < 16; ++i) o[rt][dt][i] *= alpha;
        }
        const float mref = m[rt];
        float sum = 0.f;
#pragma unroll
        for (int i = 0; i < 16; ++i) { const float p = __builtin_amdgcn_exp2f(__builtin_fmaf(st[i], SC2, -mref)); st[i] = p; sum += p; }
        ls[rt] += sum;
        bf16x8 pf[2];
#pragma unroll
        for (int s = 0; s < 2; ++s) {
            u32x4 w; w.x = pk2(st[8 * s + 0], st[8 * s + 1]); w.y = pk2(st[8 * s + 2], st[8 * s + 3]); w.z = pk2(st[8 * s + 4], st[8 * s + 5]); w.w = pk2(st[8 * s + 6], st[8 * s + 7]);
            pf[s] = __builtin_bit_cast(bf16x8, w);
        }
#pragma unroll
        for (int dt = 0; dt < 2; ++dt)
#pragma unroll
            for (int s = 0; s < 2; ++s) o[rt][dt] = MFMA32(vf[dt][s], pf[s], o[rt][dt]);
    }
}
DI void kf_load(bf16x8 (&kf)[4], const bf16_t* kp) {
#pragma unroll
    for (int ks = 0; ks < 4; ++ks) kf[ks] = *(const bf16x8*)(kp + 16 * ks);
}
DI void fa_zero(f32x16 (&o)[2][2]) {
#pragma unroll
    for (int a = 0; a < 2; ++a)
#pragma unroll
        for (int b = 0; b < 2; ++b)
#pragma unroll
            for (int i = 0; i < 16; ++i) o[a][b][i] = 0.f;
}

DI unsigned long long topk_mask(float impv, int lane, int cur) {
    const bool valid = lane <= cur; const bool forced = (lane == 0) | (lane == cur) | (lane == cur - 1);
    if (cur + 1 <= 16) return __ballot(valid);
    const unsigned key = valid ? (forced ? 0x7f000000u : (__float_as_uint(fmaxf(impv, 0.f)) + 1u)) : 0u;
    unsigned t = 0;
    for (int bit = 30; bit >= 0; --bit) {
        const unsigned cand = t | (1u << bit);
        const int cnt = __popcll(__ballot(key >= cand));
        if (cnt >= 16) t = cand;
    }
    const unsigned long long gt = __ballot(key > t), eq = __ballot(key == t);
    const int need = 16 - __popcll(gt);
    const int below = __popcll(eq & ((1ull << lane) - 1ull));
    const bool sel = (key > t) || ((key == t) && (below < need));
    return __ballot(sel);
}

DI void attnA_unit(const bf16_t* proj, const bf16_t* kc, const bf16_t* vct, const bf16_t* VT, bf16_t* ya,
                   int b, int hkv, int q0, LAS unsigned char* wl, int lane) {
    asm volatile("" : "+v"(lane));
    int r = lane & 31, h = lane >> 5;
#define RELAUNDER() do { asm volatile("" : "+v"(lane)); r = lane & 31; h = lane >> 5; } while (0)
    const size_t tokbase = (size_t)b * SEQ;
    LAS float* ytot = (LAS float*)wl;
    LAS float* impscr = (LAS float*)(wl + 16384);
    LAS unsigned* mskscr = (LAS unsigned*)(wl + 16384 + 2048);
    int qpos[2]; bf16x8 qf[2][4];
#pragma unroll
    for (int rt = 0; rt < 2; ++rt) {
        const int R = 32 * rt + r, qi = R >> 2, gi = R & 3; qpos[rt] = q0 + qi;
        const bf16_t* qp = proj + (tokbase + qpos[rt]) * PP + C_QA + (hkv * 4 + gi) * 64 + 8 * h;
#pragma unroll
        for (int ks = 0; ks < 4; ++ks) qf[rt][ks] = *(const bf16x8*)(qp + 16 * ks);
    }
    f32x16 o[2][2]; float m[2], ls[2];
    const bf16_t* Kc = kc + (size_t)(b * 2 + hkv) * 256 * 64; const bf16_t* Vc = vct + (size_t)(b * 2 + hkv) * 64 * 256;
    const int nmax = (q0 + 15 - 31) >> 4; const int ntile = nmax >= 0 ? (nmax >> 5) + 1 : 0;
    fa_zero(o); m[0] = m[1] = -1e30f; ls[0] = ls[1] = 0.f;
    {
        bf16x8 kf[4]; const bf16_t* kl = Kc + (size_t)r * 64 + 8 * h; kf_load(kf, kl);
#pragma unroll 1
        for (int t = 0; t < ntile; ++t) { const int nb = (t + 1 < ntile) ? 32 * (t + 1) : 32 * t; fa_tile<MODE_CMP>(o, m, ls, qf, kf, kl + (size_t)nb * 64, Vc, 16, 64, 32 * t, r, h, qpos, 0, false, false, q0, q0 + 15); }
    }
    float mc[2], invc[2];
#pragma unroll
    for (int rt = 0; rt < 2; ++rt) {
        const float lt = xsum32(ls[rt]); const float inv = lt > 0.f ? __builtin_amdgcn_rcpf(lt) : 0.f; mc[rt] = m[rt]; invc[rt] = inv;
        const float gsc = bf2f(proj[(tokbase + qpos[rt]) * PP + C_GA + 0 + hkv * 4 + ((32 * rt + r) & 3)]) * inv;
#pragma unroll
        for (int dt = 0; dt < 2; ++dt)
#pragma unroll
            for (int i = 0; i < 16; ++i) ytot[((rt * 2 + dt) * 16 + i) * 64 + lane] = o[rt][dt][i] * gsc;
    }
    RELAUNDER();
    fa_zero(o);
#pragma unroll 1
    for (int t = 0; t < ntile; ++t) {
        const int kbase = 32 * t;
        const bf16_t* kp = Kc + (size_t)(kbase + r) * 64 + 8 * h;
        bf16x8 kf[4];
#pragma unroll
        for (int ks = 0; ks < 4; ++ks) kf[ks] = *(const bf16x8*)(kp + 16 * ks);
        bf16x8 cf[2][2];
#pragma unroll
        for (int jt = 0; jt < 2; ++jt)
#pragma unroll
            for (int s = 0; s < 2; ++s) {
                const int jj = 32 * jt + r;
#pragma unroll
                for (int j = 0; j < 8; ++j) {
                    const int n = kbase + 16 * s + 8 * (j >> 2) + 4 * h + (j & 3);
                    const int jn = n >> 2; const bool edge = (n & 3) == 3;
                    const unsigned short w = (jj == jn) ? (edge ? 0x3F00 : 0x3F80) : ((edge && jj == jn + 1) ? 0x3F00 : 0);
                    cf[jt][s][j] = (short)w;
                }
            }
#pragma unroll
        for (int rt = 0; rt < 2; ++rt) {
            f32x16 st;
#pragma unroll
            for (int i = 0; i < 16; ++i) st[i] = 0.f;
#pragma unroll
            for (int ks = 0; ks < 4; ++ks) st = MFMA32(kf[ks], qf[rt][ks], st);
#pragma unroll
            for (int i = 0; i < 16; ++i) {
                const int kpos = kbase + crow(i, h);
                const bool valid = (16 * kpos + 31 <= qpos[rt]);
                st[i] = valid ? __builtin_amdgcn_exp2f(st[i] * SC2 - mc[rt]) * invc[rt] : 0.f;
            }
            bf16x8 pf[2];
#pragma unroll
            for (int s = 0; s < 2; ++s) {
                u32x4 w; w.x = pk2(st[8 * s + 0], st[8 * s + 1]); w.y = pk2(st[8 * s + 2], st[8 * s + 3]); w.z = pk2(st[8 * s + 4], st[8 * s + 5]); w.w = pk2(st[8 * s + 6], st[8 * s + 7]);
                pf[s] = __builtin_bit_cast(bf16x8, w);
            }
#pragma unroll
            for (int jt = 0; jt < 2; ++jt)
#pragma unroll
                for (int s = 0; s < 2; ++s) o[rt][jt] = MFMA32(cf[jt][s], pf[s], o[rt][jt]);
        }
    }
    RELAUNDER();
    const int cur = q0 >> 6;
    unsigned long long uni = 0ull; unsigned mlo[2], mhi[2];
#pragma unroll
    for (int rt = 0; rt < 2; ++rt) {
#pragma unroll
        for (int jt = 0; jt < 2; ++jt)
#pragma unroll
            for (int i = 0; i < 16; ++i) {
                float v = o[rt][jt][i]; v += shx(v, 1, lane); v += shx(v, 2, lane);
                if ((r & 3) == 0) impscr[(r >> 2) * 64 + 32 * jt + crow(i, h)] = v;
            }
        asm volatile("s_waitcnt lgkmcnt(0)" ::: "memory");
        for (int qi = 0; qi < 8; ++qi) {
            const float v = impscr[qi * 64 + lane];
            const unsigned long long mk = topk_mask(v, lane, cur);
            uni |= mk;
            if (lane == 0) { mskscr[qi * 2] = (unsigned)mk; mskscr[qi * 2 + 1] = (unsigned)(mk >> 32); }
        }
        asm volatile("s_waitcnt lgkmcnt(0)" ::: "memory");
        mlo[rt] = mskscr[(r >> 2) * 2]; mhi[rt] = mskscr[(r >> 2) * 2 + 1];
        asm volatile("s_waitcnt lgkmcnt(0)" ::: "memory");
    }
    RELAUNDER();
    {
        const bf16_t* Ks = proj + tokbase * PP + C_KVA + 256 + hkv * 64;
        const bf16_t* Vs = VT + (size_t)((0 + hkv) * 8 + b) * 64 * SEQ;
        fa_zero(o); m[0] = m[1] = -1e30f; ls[0] = ls[1] = 0.f;
        {
            const unsigned long long vm = uni & ((2ull << cur) - 1ull);
            const bf16_t* kl = Ks + (size_t)r * PP + 8 * h;
            int j = __builtin_ctzll(vm), hf = 0; bool has = true;
            bf16x8 kf[4]; kf_load(kf, kl + (size_t)(64 * j) * PP);
#pragma unroll 1
            while (has) {
                int nj = j, nhf = hf; bool hasn = false;
                if (hf == 0 && 64 * j + 32 <= q0 + 15) { nhf = 1; hasn = true; }
                else { const unsigned long long rem = (j < 63) ? (vm & (~0ull << (j + 1))) : 0ull; if (rem) { nj = __builtin_ctzll(rem); nhf = 0; hasn = true; } }
                const bool rs0 = ((j < 32 ? mlo[0] : mhi[0]) >> (j & 31)) & 1u, rs1 = ((j < 32 ? mlo[1] : mhi[1]) >> (j & 31)) & 1u;
                fa_tile<MODE_SEL>(o, m, ls, qf, kf, kl + (size_t)(64 * nj + 32 * nhf) * PP, Vs, 16, 64, 64 * j + 32 * hf, r, h, qpos, 0, rs0, rs1, q0, q0 + 15);
                j = nj; hf = nhf; has = hasn;
            }
        }
#pragma unroll
        for (int rt = 0; rt < 2; ++rt) {
            const float lt = xsum32(ls[rt]); const float inv = lt > 0.f ? __builtin_amdgcn_rcpf(lt) : 0.f;
            const float gsc = bf2f(proj[(tokbase + qpos[rt]) * PP + C_GA + 8 + hkv * 4 + ((32 * rt + r) & 3)]) * inv;
#pragma unroll
            for (int dt = 0; dt < 2; ++dt)
#pragma unroll
                for (int i = 0; i < 16; ++i) ytot[((rt * 2 + dt) * 16 + i) * 64 + lane] += o[rt][dt][i] * gsc;
        }
    }
    RELAUNDER();
    {
        const bf16_t* Kw = proj + tokbase * PP + C_KVA + 512 + hkv * 64;
        const bf16_t* Vw = VT + (size_t)((2 + hkv) * 8 + b) * 64 * SEQ;
        fa_zero(o); m[0] = m[1] = -1e30f; ls[0] = ls[1] = 0.f;
        int kb0 = (q0 - 511) & ~31; if (kb0 < 0) kb0 = 0;
        {
            const bf16_t* kl = Kw + (size_t)r * PP + 8 * h; bf16x8 kf[4]; kf_load(kf, kl + (size_t)kb0 * PP);
#pragma unroll 1
            for (int kbase = kb0; kbase <= q0 + 15; kbase += 32) { const int nb = (kbase + 32 <= q0 + 15) ? kbase + 32 : kbase; fa_tile<MODE_WIN>(o, m, ls, qf, kf, kl + (size_t)nb * PP, Vw, 16, 64, kbase, r, h, qpos, 512, false, false, q0, q0 + 15); }
        }
#pragma unroll
        for (int rt = 0; rt < 2; ++rt) {
            const float lt = xsum32(ls[rt]); const float inv = lt > 0.f ? __builtin_amdgcn_rcpf(lt) : 0.f;
            const float gsc = bf2f(proj[(tokbase + qpos[rt]) * PP + C_GA + 16 + hkv * 4 + ((32 * rt + r) & 3)]) * inv;
            const int R = 32 * rt + r, gi = R & 3;
            bf16_t* yp = ya + (tokbase + qpos[rt]) * 512 + (hkv * 4 + gi) * 64;
#pragma unroll
            for (int dt = 0; dt < 2; ++dt)
#pragma unroll
                for (int a = 0; a < 4; ++a) {
                    float v[4];
#pragma unroll
                    for (int bb = 0; bb < 4; ++bb) { const int i = 4 * a + bb; v[bb] = ytot[((rt * 2 + dt) * 16 + i) * 64 + lane] + o[rt][dt][i] * gsc; }
                    u32x2 w; w.x = pk2(v[0], v[1]); w.y = pk2(v[2], v[3]);
                    *(u32x2*)(yp + 32 * dt + 8 * a + 4 * h) = w;
                }
        }
    }
    asm volatile("s_waitcnt lgkmcnt(0)" ::: "memory");
}

DI void attnB_unit(const bf16_t* proj, const bf16_t* VT, const float* sinks, bf16_t* yb, int b, int q0, int lane) {
    asm volatile("" : "+v"(lane));
    const int r = lane & 31, h = lane >> 5;
    const size_t tokbase = (size_t)b * SEQ;
    int qpos[2]; bf16x8 qf[2][4]; f32x16 o[2][2]; float m[2], ls[2];
#pragma unroll
    for (int rt = 0; rt < 2; ++rt) {
        const int R = 32 * rt + r, qi = R >> 3, gi = R & 7; qpos[rt] = q0 + qi;
        const bf16_t* qp = proj + (tokbase + qpos[rt]) * PP + C_QB + gi * 64 + 8 * h;
#pragma unroll
        for (int ks = 0; ks < 4; ++ks) qf[rt][ks] = *(const bf16x8*)(qp + 16 * ks);
        m[rt] = sinks[gi] * LOG2E; ls[rt] = (h == 0) ? 1.0f : 0.f;
    }
    fa_zero(o);
    const bf16_t* Kb = proj + tokbase * PP + C_KB;
    const bf16_t* Vb = VT + (size_t)(4 * 8 + b) * 64 * SEQ;
    int kb0 = (q0 - 127) & ~31; if (kb0 < 0) kb0 = 0;
    {
        const bf16_t* kl = Kb + (size_t)r * PP + 8 * h; bf16x8 kf[4]; kf_load(kf, kl + (size_t)kb0 * PP);
#pragma unroll 1
        for (int kbase = kb0; kbase <= q0 + 7; kbase += 32) { const int nb = (kbase + 32 <= q0 + 7) ? kbase + 32 : kbase; fa_tile<MODE_WIN>(o, m, ls, qf, kf, kl + (size_t)nb * PP, Vb, 16, 64, kbase, r, h, qpos, 128, false, false, q0, q0 + 7); }
    }
#pragma unroll
    for (int rt = 0; rt < 2; ++rt) {
        const float lt = xsum32(ls[rt]); const float inv = __builtin_amdgcn_rcpf(lt);
        const int R = 32 * rt + r, gi = R & 7;
        bf16_t* yp = yb + (tokbase + qpos[rt]) * 512 + gi * 64;
#pragma unroll
        for (int dt = 0; dt < 2; ++dt)
#pragma unroll
            for (int a = 0; a < 4; ++a) {
                u32x2 w; w.x = pk2(o[rt][dt][4 * a] * inv, o[rt][dt][4 * a + 1] * inv); w.y = pk2(o[rt][dt][4 * a + 2] * inv, o[rt][dt][4 * a + 3] * inv);
                *(u32x2*)(yp + 32 * dt + 8 * a + 4 * h) = w;
            }
    }
}

DI void compress_unit(const bf16_t* proj, const bf16_t* W1T, const bf16_t* W2T, const float* cb, const float* rope, bf16_t* kc, bf16_t* vct,
                      int j, int b, int hkv, int nch, int kpart, LAS unsigned char* ldsb, int wave, int lane) {
    asm volatile("" : "+v"(lane));
    const int fr = lane & 15, fq = lane >> 4;
    const int n0 = nch * 16; const int n = n0 + fr; const int nl = n > 254 ? 254 : n;
    const bf16_t* src = proj + ((size_t)b * SEQ + (size_t)nl * 16) * PP + C_KVA + j * 128 + hkv * 64 + fq * 8;
    const bf16_t* w1 = W1T + (size_t)j * 128 * 2048 + (size_t)fr * 2048 + fq * 8;
    f32x4 acc1[8];
#pragma unroll
    for (int ht = 0; ht < 8; ++ht) acc1[ht] = (f32x4){0.f, 0.f, 0.f, 0.f};
    const float* rp = rope + (((size_t)b * SEQ + (size_t)nl * 16) * 32 + fq * 8) * 2;
#pragma unroll 2
    for (int l = kpart * 8; l < kpart * 8 + 8; ++l) {
        bf16x8 b0 = *(const bf16x8*)(src + (size_t)l * PP), b1 = *(const bf16x8*)(src + (size_t)l * PP + 32);
        if (j == 0) {
            f32x4 x0, x1, y0, y1; pg8::unpack8(__builtin_bit_cast(u32x4, b0), x0, x1); pg8::unpack8(__builtin_bit_cast(u32x4, b1), y0, y1);
            const f32x4 cs0 = *(const f32x4*)(rp + (size_t)l * 64), cs1 = *(const f32x4*)(rp + (size_t)l * 64 + 4), cs2 = *(const f32x4*)(rp + (size_t)l * 64 + 8), cs3 = *(const f32x4*)(rp + (size_t)l * 64 + 12);
            f32x4 o0, o1, q0, q1;
            o0[0] = x0[0] * cs0[0] - y0[0] * cs0[1]; q0[0] = y0[0] * cs0[0] + x0[0] * cs0[1];
            o0[1] = x0[1] * cs0[2] - y0[1] * cs0[3]; q0[1] = y0[1] * cs0[2] + x0[1] * cs0[3];
            o0[2] = x0[2] * cs1[0] - y0[2] * cs1[1]; q0[2] = y0[2] * cs1[0] + x0[2] * cs1[1];
            o0[3] = x0[3] * cs1[2] - y0[3] * cs1[3]; q0[3] = y0[3] * cs1[2] + x0[3] * cs1[3];
            o1[0] = x1[0] * cs2[0] - y1[0] * cs2[1]; q1[0] = y1[0] * cs2[0] + x1[0] * cs2[1];
            o1[1] = x1[1] * cs2[2] - y1[1] * cs2[3]; q1[1] = y1[1] * cs2[2] + x1[1] * cs2[3];
            o1[2] = x1[2] * cs3[0] - y1[2] * cs3[1]; q1[2] = y1[2] * cs3[0] + x1[2] * cs3[1];
            o1[3] = x1[3] * cs3[2] - y1[3] * cs3[3]; q1[3] = y1[3] * cs3[2] + x1[3] * cs3[3];
            b0 = __builtin_bit_cast(bf16x8, pg8::pack8(o0, o1)); b1 = __builtin_bit_cast(bf16x8, pg8::pack8(q0, q1));
        }
#pragma unroll
        for (int ht = 0; ht < 8; ++ht) {
            const bf16x8 a0 = *(const bf16x8*)(w1 + (size_t)ht * 16 * 2048 + (2 * l) * 32);
            const bf16x8 a1 = *(const bf16x8*)(w1 + (size_t)ht * 16 * 2048 + (2 * l + 1) * 32);
            acc1[ht] = MFMA16(a0, b0, acc1[ht]);
            acc1[ht] = MFMA16(a1, b1, acc1[ht]);
        }
    }
    {
        LAS float* mine = (LAS float*)(ldsb + wave * LDS_WAVE);
#pragma unroll
        for (int ht = 0; ht < 8; ++ht)
#pragma unroll
            for (int i = 0; i < 4; ++i) mine[(ht * 4 + i) * 64 + lane] = acc1[ht][i];
    }
    __syncthreads();
    if (kpart == 0) {
#pragma unroll
    for (int p = 1; p < 4; ++p) {
        const LAS float* oth = (const LAS float*)(ldsb + (wave + p) * LDS_WAVE);
#pragma unroll
        for (int ht = 0; ht < 8; ++ht)
#pragma unroll
            for (int i = 0; i < 4; ++i) acc1[ht][i] += oth[(ht * 4 + i) * 64 + lane];
    }
    const float* cbj = cb + j * 128;
#pragma unroll
    for (int ht = 0; ht < 8; ++ht)
#pragma unroll
        for (int i = 0; i < 4; ++i) acc1[ht][i] = gelu_tanh(acc1[ht][i] + cbj[16 * ht + 4 * fq + i]);
    f32x4 acc2[4];
#pragma unroll
    for (int ot = 0; ot < 4; ++ot) acc2[ot] = (f32x4){0.f, 0.f, 0.f, 0.f};
    const bf16_t* w2 = W2T + (size_t)j * 64 * 128;
#pragma unroll
    for (int s = 0; s < 4; ++s) {
        u32x4 w; w.x = pk2(acc1[2 * s][0], acc1[2 * s][1]); w.y = pk2(acc1[2 * s][2], acc1[2 * s][3]); w.z = pk2(acc1[2 * s + 1][0], acc1[2 * s + 1][1]); w.w = pk2(acc1[2 * s + 1][2], acc1[2 * s + 1][3]);
        const bf16x8 bfr = __builtin_bit_cast(bf16x8, w);
#pragma unroll
        for (int ot = 0; ot < 4; ++ot) {
            const bf16_t* ap = w2 + (size_t)(ot * 16 + fr) * 128 + 32 * s + 4 * fq;
            const s16x4 lo = *(const s16x4*)ap, hi = *(const s16x4*)(ap + 16);
            const bf16x8 afr = (bf16x8){lo[0], lo[1], lo[2], lo[3], hi[0], hi[1], hi[2], hi[3]};
            acc2[ot] = MFMA16(afr, bfr, acc2[ot]);
        }
    }
    const bool live = n <= 254;
    if (j == 0) {
        bf16_t* dst = kc + ((size_t)(b * 2 + hkv) * 256 + n) * 64;
#pragma unroll
        for (int ot = 0; ot < 4; ++ot) { u32x2 w; w.x = live ? pk2(acc2[ot][0], acc2[ot][1]) : 0u; w.y = live ? pk2(acc2[ot][2], acc2[ot][3]) : 0u; *(u32x2*)(dst + 16 * ot + 4 * fq) = w; }
    } else {
        bf16_t* dst = vct + (size_t)(b * 2 + hkv) * 64 * 256 + (size_t)nch * 1024 + perm16(fr);
#pragma unroll
        for (int ot = 0; ot < 4; ++ot)
#pragma unroll
            for (int i = 0; i < 4; ++i) dst[(16 * ot + 4 * fq + i) * 16] = live ? (bf16_t)(pk2(acc2[ot][i], 0.f) & 0xffffu) : (bf16_t)0;
    }
    }
    __syncthreads();
}

struct S5In { const float *a_re, *a_im, *log_dt, *b_re, *b_im, *c_re, *c_im, *d; };
DI void cplx_abar(const S5In& P, int g, int p, float dt, float& abr, float& abi, float& cfr, float& cfi) {
    const float ar = P.a_re[g * 64 + p], ai = P.a_im[g * 64 + p];
    const float mag = expf(dt * ar); abr = mag * cosf(dt * ai); abi = mag * sinf(dt * ai);
    const float den = ar * ar + ai * ai, nr = abr - 1.0f, ni = abi;
    cfr = (nr * ar + ni * ai) / den; cfi = (ni * ar - nr * ai) / den;
}
template <bool OUT>
DI void s5_unit(const S5In& P, bf16_t* proj, float* states, int b, int g, int c, int nsc, LAS unsigned char* wl, int lane) {
    asm volatile("" : "+v"(lane));
    const int r = lane & 31, h = lane >> 5, fr = lane & 15, fq = lane >> 4;
    const float dt = expf(P.log_dt[g]);
    float abr, abi, t0, t1; cplx_abar(P, g, lane, dt, abr, abi, t0, t1);
    bf16x8 bfrag[4];
#pragma unroll
    for (int hs = 0; hs < 2; ++hs) {
        const int p = r + 32 * hs; float a0, a1, cr, ci; cplx_abar(P, g, p, dt, a0, a1, cr, ci);
        const float* br = P.b_re + ((size_t)g * 64 + p) * 16 + 8 * h; const float* bi = P.b_im + ((size_t)g * 64 + p) * 16 + 8 * h;
        float re[8], im[8];
#pragma unroll
        for (int j = 0; j < 8; ++j) { re[j] = cr * br[j] - ci * bi[j]; im[j] = cr * bi[j] + ci * br[j]; }
        u32x4 wr_, wi_; wr_.x = pk2(re[0], re[1]); wr_.y = pk2(re[2], re[3]); wr_.z = pk2(re[4], re[5]); wr_.w = pk2(re[6], re[7]);
        wi_.x = pk2(im[0], im[1]); wi_.y = pk2(im[2], im[3]); wi_.z = pk2(im[4], im[5]); wi_.w = pk2(im[6], im[7]);
        bfrag[hs] = __builtin_bit_cast(bf16x8, wr_); bfrag[2 + hs] = __builtin_bit_cast(bf16x8, wi_);
    }
    bf16x8 cfrag[4]; float dch = 0.f;
    if (OUT) {
#pragma unroll
        for (int ks = 0; ks < 4; ++ks) {
            const float* cr = P.c_re + ((size_t)g * 16 + fr) * 64 + 16 * ks + 4 * fq; const float* ci = P.c_im + ((size_t)g * 16 + fr) * 64 + 16 * ks + 4 * fq;
            u32x4 w; w.x = pk2(cr[0], -ci[0]); w.y = pk2(cr[1], -ci[1]); w.z = pk2(cr[2], -ci[2]); w.w = pk2(cr[3], -ci[3]);
            cfrag[ks] = __builtin_bit_cast(bf16x8, w);
        }
        dch = P.d[g * 16 + fr];
    }
    float xr = 0.f, xi = 0.f;
    if (OUT) {
        float pr = abr, pi = abi;
#pragma unroll
        for (int q = 0; q < 9; ++q) { const float nr = pr * pr - pi * pi, ni = 2.0f * pr * pi; pr = nr; pi = ni; }
#ifndef DBG_NOSTATE
        for (int cc = 0; cc < c; ++cc) {
            const float* sp = states + ((((size_t)b * 32 + g) * 8 + cc) * 64 + lane) * 2;
            const float sr = sp[0], si = sp[1];
            const float nr = pr * xr - pi * xi + sr, ni = pr * xi + pi * xr + si; xr = nr; xi = ni;
        }
#endif
    }
    LAS float* bu = (LAS float*)wl;
    bf16_t* ucol = proj + ((size_t)b * SEQ + (size_t)c * 512) * PP + C_U + g * 16;
    bf16x8 ufr_n = *(const bf16x8*)(ucol + (size_t)r * PP + 8 * h);
    LAS bf16_t* uimg = (LAS bf16_t*)(wl + 16896);
#pragma unroll 1
    for (int sc = 0; sc < nsc; ++sc) {
        bf16_t* ub = ucol + (size_t)sc * 32 * PP;
        const bf16x8 ufr = ufr_n;
        if (OUT) *(LAS bf16x8*)(uimg + r * 16 + 8 * h) = ufr;
        {
            const bf16_t* un = ucol + (size_t)(sc + 1 < nsc ? sc + 1 : sc) * 32 * PP;
            ufr_n = *(const bf16x8*)(un + (size_t)r * PP + 8 * h);
        }
        f32x16 re0, re1, im0, im1;
        {
            f32x16 z16;
#pragma unroll
            for (int i = 0; i < 16; ++i) z16[i] = 0.f;
            const f32x16 d0 = MFMA32(ufr, bfrag[0], z16), d1 = MFMA32(ufr, bfrag[1], z16), d2 = MFMA32(ufr, bfrag[2], z16), d3 = MFMA32(ufr, bfrag[3], z16);
#pragma unroll
            for (int i = 0; i < 16; ++i) {
                const u32x2s a = __builtin_amdgcn_permlane32_swap(__float_as_uint(d0[i]), __float_as_uint(d1[i]), false, false);
                const u32x2s c = __builtin_amdgcn_permlane32_swap(__float_as_uint(d2[i]), __float_as_uint(d3[i]), false, false);
                re0[i] = __uint_as_float(a[0]); re1[i] = __uint_as_float(a[1]); im0[i] = __uint_as_float(c[0]); im1[i] = __uint_as_float(c[1]);
            }
        }
#pragma unroll
        for (int a4 = 0; a4 < 4; ++a4)
#pragma unroll
            for (int st_ = 0; st_ < 2; ++st_)
#pragma unroll
                for (int b4 = 0; b4 < 4; ++b4) {
                    const int i = 4 * a4 + b4, t = 8 * a4 + 4 * st_ + b4;
                    const float br_ = st_ ? re1[i] : re0[i], bi_ = st_ ? im1[i] : im0[i];
                    const float nr = abr * xr - abi * xi + br_, ni = abr * xi + abi * xr + bi_; xr = nr; xi = ni;
                    if (OUT) ((LAS unsigned*)(bu + t * 132))[lane] = pk2(xr, xi);
                }
        if (OUT) {
            asm volatile("s_waitcnt lgkmcnt(0)" ::: "memory");
#pragma unroll
            for (int mt = 0; mt < 2; ++mt) {
                f32x4 y = (f32x4){0.f, 0.f, 0.f, 0.f};
#pragma unroll
                for (int ks = 0; ks < 4; ++ks) {
                    const bf16x8 xa = *(const LAS bf16x8*)((LAS unsigned char*)bu + (mt * 16 + fr) * 528 + ks * 64 + fq * 16);
                    y = MFMA16(xa, cfrag[ks], y);
                }
#pragma unroll
                for (int i = 0; i < 4; ++i) {
                    LAS bf16_t* e = uimg + (mt * 16 + 4 * fq + i) * 16 + fr;
                    const float yy = y[i] + dch * bf2f(*e);
                    *e = (bf16_t)(pk2(gelu_tanh(yy), 0.f) & 0xffffu);
                }
            }
            asm volatile("s_waitcnt lgkmcnt(0)" ::: "memory");
            {
                const bf16x8 zv = *(const LAS bf16x8*)(uimg + lane * 8);
                *(bf16x8*)(ub + (size_t)(lane >> 1) * PP + 8 * (lane & 1)) = zv;
            }
            asm volatile("s_waitcnt lgkmcnt(0)" ::: "memory");
        }
    }
    if (!OUT) { float* sp = states + ((((size_t)b * 32 + g) * 8 + c) * 64 + lane) * 2; sp[0] = xr; sp[1] = xi; }
}

template <bool OUT_F32>
DI void rmsnorm_rows(const float* src, const float* gain, bf16_t* dstb, float* dstf, float* copy, int gw, int nw, int lane) {
    f32x4 gv[4];
#pragma unroll
    for (int i = 0; i < 4; ++i) gv[i] = *(const f32x4*)(gain + 256 * i + 4 * lane);
#pragma unroll 2
    for (int row = gw; row < T; row += nw) {
        const float* xp = src + (size_t)row * DM + 4 * lane;
        f32x4 v[4]; float ss = 0.f;
#pragma unroll
        for (int i = 0; i < 4; ++i) { v[i] = *(const f32x4*)(xp + 256 * i); ss += v[i][0] * v[i][0] + v[i][1] * v[i][1] + v[i][2] * v[i][2] + v[i][3] * v[i][3]; }
        ss = wave_sum(ss, lane);
        const float rs = rsqrtf(ss * (1.0f / 1024.0f) + NORM_EPS);
#pragma unroll
        for (int i = 0; i < 4; ++i) {
            if (copy) *(f32x4*)(copy + (size_t)row * DM + 256 * i + 4 * lane) = v[i];
            const f32x4 y = v[i] * rs * gv[i];
            if (OUT_F32) *(f32x4*)(dstf + (size_t)row * DM + 256 * i + 4 * lane) = y;
            else { u32x2 w; w.x = pk2(y[0], y[1]); w.y = pk2(y[2], y[3]); *(u32x2*)(dstb + (size_t)row * DM + 256 * i + 4 * lane) = w; }
        }
    }
}

DI int in_srccol(int n) { return n < 1280 ? n : (n < 2432 ? n + 24 : (n < 2456 ? n - 1152 : (n < 2560 ? -1 : n - 104))); }

#define XB_TMO      128
#define XB_XCNT(j)  (256  + 64 * (j))
#define XB_XSUB(j)  (1280 + 64 * (j))
#define XB_XGEN(j)  (2304 + 64 * (j))
#define XB_TOP      3328
#define XB_TOPGEN   3392
#define XB_SPIN_CAP (1u << 18)
DI unsigned xb_ld(unsigned* p)              { return __hip_atomic_load(p, __ATOMIC_RELAXED, __HIP_MEMORY_SCOPE_AGENT); }
DI unsigned xb_add(unsigned* p, unsigned v) { return __hip_atomic_fetch_add(p, v, __ATOMIC_RELAXED, __HIP_MEMORY_SCOPE_AGENT); }
DI unsigned xb_xcc_id() { return (unsigned)__builtin_amdgcn_s_getreg((3 << 11) | 20) & 0xFu; }
#define XB_SPIN(cond, bar) do { unsigned _sp = 0; while (cond) { __builtin_amdgcn_s_sleep(1); \
    if ((++_sp & 255u) == 0u) { if (xb_ld(&(bar)[XB_TMO])) break; if (_sp > XB_SPIN_CAP) { atomicAdd(&(bar)[XB_TMO], 1u); break; } } } } while (0)
DI void xcd_barrier_complete(unsigned* bar, unsigned x, unsigned G, unsigned& nloc, unsigned& nx) {
    unsigned sum, cnt, mine, sp = 0u;
    for (;;) {
        sum = 0u; cnt = 0u; mine = 0u;
#pragma unroll
        for (unsigned j = 0; j < 16; ++j) { const unsigned c = xb_ld(&bar[XB_XCNT(j)]); sum += c; cnt += (c > 0u) ? 1u : 0u; mine = (j == x) ? c : mine; }
        if (sum == G) break;
        __builtin_amdgcn_s_sleep(1);
        if ((++sp & 255u) == 0u) { if (xb_ld(&bar[XB_TMO])) break; if (sp > XB_SPIN_CAP) { atomicAdd(&bar[XB_TMO], 1u); break; } }
    }
    nloc = mine > 0u ? mine : 1u; nx = cnt > 0u ? cnt : 1u;
}
DI void xcd_barrier(unsigned* bar, volatile LAS unsigned* st, bool t0, unsigned G) {
    asm volatile("s_waitcnt vmcnt(0)" ::: "memory");
    __syncthreads();
    if (t0) {
        const unsigned x = xb_xcc_id();
        __builtin_amdgcn_s_waitcnt(0);
        unsigned nloc = st[0], nx = st[1];
        if (nloc == 0u) { xcd_barrier_complete(bar, x, G, nloc, nx); st[0] = nloc; st[1] = nx; }
        const unsigned old = xb_add(&bar[XB_XSUB(x)], 1u);
        const unsigned gen = old / nloc;
        if (old + 1u == (gen + 1u) * nloc) {
            __builtin_amdgcn_fence(__ATOMIC_RELEASE, "agent");
            asm volatile("s_waitcnt vmcnt(0)" ::: "memory");
            const unsigned og = xb_add(&bar[XB_TOP], 1u);
            const unsigned tg = og / nx;
            if (og + 1u == (tg + 1u) * nx) xb_add(&bar[XB_TOPGEN], 1u);
            else XB_SPIN(xb_ld(&bar[XB_TOPGEN]) == tg, bar);
            __builtin_amdgcn_fence(__ATOMIC_ACQUIRE, "agent");
            xb_add(&bar[XB_XGEN(x)], 1u);
            asm volatile("s_waitcnt vmcnt(0)" ::: "memory");
        } else {
            XB_SPIN(xb_ld(&bar[XB_XGEN(x)]) == gen, bar);
            __builtin_amdgcn_fence(__ATOMIC_ACQUIRE, "agent");
            asm volatile("s_waitcnt vmcnt(0)" ::: "memory");
        }
    }
    __syncthreads();
}

struct Args { const float* in[26]; float* out; unsigned char* ws; int ph_lo, ph_hi; };
constexpr int NPH = DEPTH * 11 + 1;

__global__ void __launch_bounds__(512, 2) mega_fwd(Args a) {
    extern __shared__ __attribute__((aligned(16))) unsigned char lds_raw[];
    LAS unsigned char* lds = (LAS unsigned char*)lds_raw;
    cg::grid_group grid = cg::this_grid();
    const int G = gridDim.x, bx = blockIdx.x;
    const int ph_lo = a.ph_lo, ph_hi = a.ph_hi;
    const int wave0 = __builtin_amdgcn_readfirstlane(threadIdx.x >> 6);
    {
        int ln0; asm volatile("v_mbcnt_lo_u32_b32 %0, -1, 0\n\tv_mbcnt_hi_u32_b32 %0, -1, %0" : "=v"(ln0));
        if (wave0 == 0 && ln0 == 0) {
            volatile LAS unsigned* xst = (volatile LAS unsigned*)(lds + LDS_XB); xst[0] = 0u; xst[1] = 0u;
            (void)xb_add(&((unsigned*)(a.ws + OFF_BAR))[XB_XCNT(xb_xcc_id())], 1u);
        }
        __syncthreads();
    }
#define PH_LOCALS \
    int lane_v; asm volatile("v_mbcnt_lo_u32_b32 %0, -1, 0\n\tv_mbcnt_hi_u32_b32 %0, -1, %0" : "=v"(lane_v)); int wave_s = wave0; asm volatile("" : "+s"(wave_s)); \
    const int lane = lane_v, wave = wave_s, tid = wave * 64 + lane; \
    const int gw = bx * 8 + wave, nw = G * 8; (void)gw; (void)nw; (void)lane; \
    const Args* ap = (const Args*)__builtin_amdgcn_kernarg_segment_ptr(); asm volatile("" : "+s"(ap)); \
    unsigned char* ws = as_global(ap->ws); float* X = as_global(ap->out); (void)X; \
    bf16_t* WIN = (bf16_t*)(ws + OFF_WIN); bf16_t* WUP = (bf16_t*)(ws + OFF_WUP); bf16_t* WDN = (bf16_t*)(ws + OFF_WDN); bf16_t* WOUT = (bf16_t*)(ws + OFF_WOUT); \
    bf16_t* WBR = (bf16_t*)(ws + OFF_WBR); bf16_t* WGLU = (bf16_t*)(ws + OFF_WGLU); bf16_t* WC1 = (bf16_t*)(ws + OFF_WC1); bf16_t* WC2 = (bf16_t*)(ws + OFF_WC2); \
    float* CB = (float*)(ws + OFF_CB); float* S5S = (float*)(ws + OFF_S5S); bf16_t* KC = (bf16_t*)(ws + OFF_KC); bf16_t* VCT = (bf16_t*)(ws + OFF_VCT); \
    float* ROPE = (float*)(ws + OFF_ROPE); \
    bf16_t* Hb = (bf16_t*)(ws + OFF_HY); bf16_t* YA = (bf16_t*)(ws + OFF_HY); bf16_t* YB = (bf16_t*)(ws + OFF_HY + YSZ); bf16_t* YC = (bf16_t*)(ws + OFF_HY + 2 * YSZ); \
    bf16_t* VT = YC; bf16_t* PROJ = (bf16_t*)(ws + OFF_PROJ); bf16_t* GG = (bf16_t*)(ws + OFF_G); bf16_t* MG = PROJ; bf16_t* HID = PROJ; \
    LAS unsigned char* wl = lds + wave * LDS_WAVE; \
    (void)WIN; (void)WUP; (void)WDN; (void)WOUT; (void)WBR; (void)WGLU; (void)WC1; (void)WC2; (void)CB; (void)S5S; (void)KC; (void)VCT; (void)ROPE; (void)Hb; (void)YA; (void)YB; (void)YC; (void)VT; (void)PROJ; (void)GG; (void)MG; (void)HID; (void)wl;

#define INP(k) as_global(ap->in[k])
#define PH_BEGIN(p) if (ph_lo <= (p) && (p) < ph_hi) { PH_LOCALS
#define PH_SYNC_CG do { asm volatile("s_waitcnt vmcnt(0)" ::: "memory"); __syncthreads(); if (wave0 == 0) { __builtin_amdgcn_fence(__ATOMIC_RELEASE, "agent"); asm volatile("s_waitcnt vmcnt(0)" ::: "memory"); } __syncthreads(); grid.sync(); if (wave0 == 0) { __builtin_amdgcn_fence(__ATOMIC_ACQUIRE, "agent"); asm volatile("s_waitcnt vmcnt(0)" ::: "memory"); } __syncthreads(); } while (0)
#define PH_SYNC_XCD do { int ln_; asm volatile("v_mbcnt_lo_u32_b32 %0, -1, 0\n\tv_mbcnt_hi_u32_b32 %0, -1, %0" : "=v"(ln_)); const Args* ap_ = (const Args*)__builtin_amdgcn_kernarg_segment_ptr(); asm volatile("" : "+s"(ap_)); \
    xcd_barrier((unsigned*)(ap_->ws + OFF_BAR), (volatile LAS unsigned*)(lds + LDS_XB), wave0 == 0 && ln_ == 0, (unsigned)G); } while (0)
#define PH_END(p) } if (ph_lo <= (p) && (p) + 1 < ph_hi) { PH_SYNC_XCD; }

    if (ph_hi - ph_lo > 1) grid.sync();
#pragma unroll 1
    for (int l = 0; l < DEPTH; ++l) {
        const int pb = l * 11;
        PH_BEGIN(pb + 0)
            LAS float* scr = (LAS float*)lds;
            for (int j = bx; j < 2; j += G) {
                const int hid = tid & 127, part = tid >> 7;
                const float* pos = INP(4) + (size_t)(l * 2 + j) * 2048; const float* w1 = INP(5) + (size_t)(l * 2 + j) * 2048 * 128;
                float s = 0.f;
                for (int kk = part * 512; kk < part * 512 + 512; ++kk) s += pos[kk] * w1[(size_t)kk * 128 + hid];
                scr[part * 128 + hid] = s;
                __syncthreads();
                if (tid < 128) CB[j * 128 + tid] = scr[tid] + scr[128 + tid] + scr[256 + tid] + scr[384 + tid];
                __syncthreads();
            }
#pragma unroll 1
            for (int it = gw; it < 4292; it += nw) {
                int rr = it; const float* W; bf16_t* WT; int K, N, tn; bool remap = false;
                if (rr < 1408) { W = INP(3) + (size_t)l * 1024 * 5528; WT = WIN; K = 1024; N = 5528; tn = 88; remap = true; }
                else if ((rr -= 1408) < 1024) { W = INP(23) + (size_t)l * 1024 * 4096; WT = WUP; K = 1024; N = 4096; tn = 64; }
                else if ((rr -= 1024) < 1024) { W = INP(24) + (size_t)l * 4096 * 1024; WT = WDN; K = 4096; N = 1024; tn = 16; }
                else if ((rr -= 1024) < 256) { W = INP(21) + (size_t)l * 1024 * 1024; WT = WOUT; K = 1024; N = 1024; tn = 16; }
                else if ((rr -= 256) < 384) { const int br = rr / 128; rr %= 128; W = INP(18 + br) + (size_t)l * 512 * 1024; WT = WBR + (size_t)br * 1024 * 512; K = 512; N = 1024; tn = 16; }
                else if ((rr -= 384) < 64) { W = INP(16) + (size_t)l * 512 * 512; WT = WGLU; K = 512; N = 512; tn = 8; }
                else if ((rr -= 64) < 128) { const int j = rr / 64; rr %= 64; W = INP(5) + (size_t)(l * 2 + j) * 2048 * 128; WT = WC1 + (size_t)j * 128 * 2048; K = 2048; N = 128; tn = 2; }
                else { rr -= 128; const int j = rr / 2; rr %= 2; W = INP(6) + (size_t)(l * 2 + j) * 128 * 64; WT = WC2 + (size_t)j * 64 * 128; K = 128; N = 64; tn = 1; }
                const int k0 = (rr / tn) * 64, n0 = (rr % tn) * 64;
                const int nn = n0 + lane; const int sc = remap ? in_srccol(nn) : nn;
                const float* wp = W + (size_t)k0 * N + (sc >= 0 ? sc : 0);
                bf16_t* dst = WT + (size_t)nn * K + k0;
#pragma unroll
                for (int kb = 0; kb < 8; ++kb) {
                    f32x4 v0, v1;
#pragma unroll
                    for (int q = 0; q < 4; ++q) { v0[q] = wp[(size_t)(kb * 8 + q) * N]; v1[q] = wp[(size_t)(kb * 8 + 4 + q) * N]; }
                    if (sc < 0) { v0 = (f32x4){0.f, 0.f, 0.f, 0.f}; v1 = v0; }
                    *(u32x4*)(dst + kb * 8) = pg8::pack8(v0, v1);
                }
            }
            if (l == 0 && bx == 0 && tid < 64) ((unsigned*)(ws + OFF_CB + 2048))[tid] = 0u;
            if (l == 0) {
                const int* positions = (const int*)INP(1);
                for (int idx = bx * 512 + tid; idx < T * 32; idx += 131072) {
                    const int t = idx >> 5, i = idx & 31;
                    const float invf = exp2f(-(float)i * 0.41524101186092029f);
                    const float ang = (float)positions[t] * invf;
                    ROPE[2 * idx] = cosf(ang); ROPE[2 * idx + 1] = sinf(ang);
                }
                rmsnorm_rows<false>(INP(0), INP(2), Hb, nullptr, X, gw, nw, lane);
            } else {
                rmsnorm_rows<false>(X, INP(2) + (size_t)l * DM, Hb, nullptr, nullptr, gw, nw, lane);
            }
        PH_END(pb + 0)
        PH_BEGIN(pb + 1)
            pg8::Gemm g{Hb, WIN, T, NIN, DM, DM, 0, 0}; pg8::StaticOrder S; S.init(T, NIN, G, bx);
            pg8::EpiIn E{PROJ, GG};
            pg8::gemm_phase(lds, g, S, E, tid);
        PH_END(pb + 1)
        PH_BEGIN(pb + 2)
            { const int u = bx * 2 + (wave >> 2); compress_unit(PROJ, WC1, WC2, CB, ROPE, KC, VCT, u >> 8, (u >> 5) & 7, (u >> 4) & 1, u & 15, wave & 3, lds, wave, lane); }
            {
                LAS bf16_t* tile = (LAS bf16_t*)lds;
                for (int it = bx; it < 5 * 8 * 64; it += G) {
                    const int slot = it / 512, b = (it / 64) % 8, st = it % 64;
                    const int vcol = slot < 4 ? C_KVA + (1 + (slot >> 1)) * 256 + 128 + (slot & 1) * 64 : C_VB;
                    {
                        const int tok = tid >> 3, dc = (tid & 7) * 8;
                        const bf16x8 v = *(const bf16x8*)(PROJ + ((size_t)b * SEQ + st * 64 + tok) * PP + vcol + dc);
#pragma unroll
                        for (int j = 0; j < 8; ++j) tile[(dc + j) * 72 + perm16(tok)] = (bf16_t)v[j];
                    }
                    __syncthreads();
                    {
                        const int d = tid >> 3, tc = (tid & 7) * 8;
                        const bf16x8 v = *(const LAS bf16x8*)(tile + d * 72 + tc);
                        *(bf16x8*)(VT + (size_t)(slot * 8 + b) * 64 * SEQ + (size_t)(st * 4 + (tc >> 4)) * 1024 + d * 16 + (tc & 8)) = v;
                    }
                    __syncthreads();
                }
            }
            for (int idx = bx * 512 + tid; idx < T * 84; idx += 131072) {
                const int t = idx / 84, rem = idx % 84, head = rem >> 2, ch = rem & 3;
                int col;
                if (head < 8) col = C_QA + head * 64; else if (head < 12) { const int hh = head - 8; col = C_KVA + (1 + (hh >> 1)) * 256 + (hh & 1) * 64; }
                else if (head < 20) col = C_QB + (head - 12) * 64; else col = C_KB;
                bf16_t* p = PROJ + (size_t)t * PP + col + 8 * ch;
                f32x4 a0, a1, b0, b1; pg8::unpack8(*(const u32x4*)p, a0, a1); pg8::unpack8(*(const u32x4*)(p + 32), b0, b1);
                const float* cs = ROPE + ((size_t)t * 32 + 8 * ch) * 2;
                f32x4 o0, o1, q0, q1;
#pragma unroll
                for (int j = 0; j < 4; ++j) {
                    const float c0 = cs[2 * j], s0 = cs[2 * j + 1], c1 = cs[2 * (j + 4)], s1 = cs[2 * (j + 4) + 1];
                    o0[j] = a0[j] * c0 - b0[j] * s0; q0[j] = b0[j] * c0 + a0[j] * s0;
                    o1[j] = a1[j] * c1 - b1[j] * s1; q1[j] = b1[j] * c1 + a1[j] * s1;
                }
                *(u32x4*)p = pg8::pack8(o0, o1); *(u32x4*)(p + 32) = pg8::pack8(q0, q1);
            }
            {
                const S5In P{INP(8) + (size_t)l * 2048, INP(9) + (size_t)l * 2048, INP(10) + (size_t)l * 32, INP(11) + (size_t)l * 32768, INP(12) + (size_t)l * 32768,
                             INP(13) + (size_t)l * 32768, INP(14) + (size_t)l * 32768, INP(15) + (size_t)l * 512};
            }
        PH_END(pb + 2)
        PH_BEGIN(pb + 4)
            {
                const S5In P{INP(8) + (size_t)l * 2048, INP(9) + (size_t)l * 2048, INP(10) + (size_t)l * 32, INP(11) + (size_t)l * 32768, INP(12) + (size_t)l * 32768,
                             INP(13) + (size_t)l * 32768, INP(14) + (size_t)l * 32768, INP(15) + (size_t)l * 512};
                if (bx < 64 && wave < 4) s5_unit<true>(P, PROJ, S5S, bx >> 3, 4 * (bx & 7) + wave, 0, 128, wl, lane);
            }
            {
                unsigned* xbw = (unsigned*)(ws + OFF_BAR);
                const unsigned xme = xb_xcc_id(); unsigned rk = 0, nx = 0;
#pragma unroll
                for (unsigned j = 0; j < 16; ++j) { const unsigned c = xb_ld(&xbw[XB_XCNT(j)]); if (c) { rk += (j < xme) ? 1u : 0u; ++nx; } }
                rk = __builtin_amdgcn_readfirstlane(rk); nx = __builtin_amdgcn_readfirstlane(nx); if (nx == 0u) nx = 1u;
                const unsigned nbA = rk < 16u ? (16u - rk + nx - 1u) / nx : 0u, nbB = rk < 8u ? (8u - rk + nx - 1u) / nx : 0u;
                const unsigned totA = nbA * 256u, totB = nbB * 512u;
                unsigned* ctr = (unsigned*)(ws + OFF_CB + 2048) + l * 16 + rk;
                for (;;) {
                    unsigned i = 0;
                    if (lane == 0) i = atomicAdd(ctr, 1u);
                    i = __builtin_amdgcn_readfirstlane(i);
                    if (i >= totA + totB) break;
                    if (i < totA) {
                        const unsigned g8 = i >> 3, bl = g8 % nbA, q8 = g8 / nbA;
                        const int bh = (int)(rk + nx * bl), qt = (31 - (int)q8) * 8 + (int)(i & 7u);
                        attnA_unit(PROJ, KC, VCT, VT, YA, bh >> 1, bh & 1, qt * 16, wl, lane);
                    } else {
                        const unsigned u = i - totA; const int b = (int)(rk + nx * (u >> 9));
                        attnB_unit(PROJ, VT, INP(7) + (size_t)l * 8, YB, b, (int)(u & 511u) * 8, lane);
                    }
                }
            }
        PH_END(pb + 4)
        PH_BEGIN(pb + 5)
            pg8::Gemm g{PROJ + C_U, WGLU, T, 512, 512, PP, 0, 0}; pg8::StaticOrder S; S.init(T, 512, G, bx);
            pg8::EpiGlu E{PROJ + C_U, INP(17) + (size_t)l * 512, YC};
            pg8::gemm_phase(lds, g, S, E, tid);
        PH_END(pb + 5)
        PH_BEGIN(pb + 6)
            pg8::Gemm g{YA, WBR, T, DM, 512, 512, YSZ, (size_t)DM * 512 * 2}; pg8::Z3Order S; S.init(T, DM, G, bx);
            pg8::EpiMerge E{GG, MG};
            pg8::gemm_phase(lds, g, S, E, tid);
        PH_END(pb + 6)
        PH_BEGIN(pb + 7)
            pg8::Gemm g{MG, WOUT, T, DM, DM, DM, 0, 0}; pg8::StaticOrder S; S.init(T, DM, G, bx);
            pg8::EpiResid E{X};
            pg8::gemm_phase(lds, g, S, E, tid);
        PH_END(pb + 7)
        PH_BEGIN(pb + 8)
            rmsnorm_rows<false>(X, INP(22) + (size_t)l * DM, Hb, nullptr, nullptr, gw, nw, lane);
        PH_END(pb + 8)
        PH_BEGIN(pb + 9)
            pg8::Gemm g{Hb, WUP, T, DFF, DM, DM, 0, 0}; pg8::StaticOrder S; S.init(T, DFF, G, bx);
            pg8::EpiUp E{HID};
            pg8::gemm_phase(lds, g, S, E, tid);
        PH_END(pb + 9)
        PH_BEGIN(pb + 10)
            pg8::Gemm g{HID, WDN, T, DM, DFF, DFF, 0, 0}; pg8::StaticOrder S; S.init(T, DM, G, bx);
            pg8::EpiResid E{X};
            pg8::gemm_phase(lds, g, S, E, tid);
        PH_END(pb + 10)
    }
    PH_BEGIN(NPH - 1)
        rmsnorm_rows<true>(X, INP(25), nullptr, X, nullptr, gw, nw, lane);
    }
}

extern "C" void kernel_launch(void* const* d_in, const int* in_sizes, int n_in, void* d_out, int out_size, void* d_ws, size_t ws_size, hipStream_t stream) {
    static int ready = 0;
    if (ready == 0) {
        if (n_in != 26 || out_size != T * DM || ws_size < WS_END + BAR_BYTES) { fprintf(stderr, "kernel_launch: unexpected shapes (n_in %d out %d ws %zu need %zu)\n", n_in, out_size, ws_size, (size_t)WS_END); ready = -1; return; }
        if (hipFuncSetAttribute((const void*)mega_fwd, hipFuncAttributeMaxDynamicSharedMemorySize, LDS_BYTES) != hipSuccess) { fprintf(stderr, "kernel_launch: hipFuncSetAttribute failed\n"); ready = -1; return; }
        ready = 1;
    }
    if (ready < 0) return;
#ifdef DBG_MEMSET
    hipMemsetAsync(d_ws, 0xAA, WS_END, stream); hipMemsetAsync(d_out, 0xAA, (size_t)T * DM * 4, stream);
#endif
    if (hipMemsetAsync((unsigned char*)d_ws + OFF_BAR, 0, BAR_BYTES, stream) != hipSuccess) { fprintf(stderr, "kernel_launch: barrier memset failed\n"); return; }
    Args a{};
    for (int i = 0; i < 26; ++i) a.in[i] = (const float*)d_in[i];
    a.out = (float*)d_out; a.ws = (unsigned char*)d_ws;
#if MK_MULTI
    for (int p = 0; p < NPH; ++p) { a.ph_lo = p; a.ph_hi = p + 1; hipLaunchKernelGGL(mega_fwd, dim3(256), dim3(512), LDS_BYTES, stream, a); }
#else
    a.ph_lo = 0; a.ph_hi = NPH;
    void* args[] = {&a};
    hipError_t e = hipLaunchCooperativeKernel((const void*)mega_fwd, dim3(256), dim3(512), args, LDS_BYTES, stream);
    if (e != hipSuccess) fprintf(stderr, "cooperative launch failed: %s\n", hipGetErrorString(e));
#endif
}
```

```cpp
#include <hip/hip_runtime.h>
#include <hip/hip_cooperative_groups.h>
#include <cstdio>
#include <cstdint>
namespace cg = cooperative_groups;

typedef unsigned short bf16_t;
typedef short bf16x8 __attribute__((ext_vector_type(8)));
typedef short s16x4 __attribute__((ext_vector_type(4)));
typedef float f32x4 __attribute__((ext_vector_type(4)));
typedef float f32x16 __attribute__((ext_vector_type(16)));
typedef unsigned u32x4 __attribute__((ext_vector_type(4)));
typedef unsigned u32x2 __attribute__((ext_vector_type(2)));
typedef __bf16 bf16x2_t __attribute__((ext_vector_type(2)));
typedef float f32x2_t __attribute__((ext_vector_type(2)));
#define LAS __attribute__((address_space(3)))
#define DI __device__ __forceinline__

#ifndef MK_MULTI
#define MK_MULTI 0
#endif
#ifndef DBG_MASK
#define DBG_MASK 7
#endif

constexpr int T = 32768, SEQ = 4096, NBATCH = 8, DM = 1024, PP = 2560, NGM = 3072, NIN = 5632, DFF = 4096, DEPTH = 4;
constexpr int C_QA = 0, C_KVA = 512, C_QB = 1280, C_KB = 1792, C_VB = 1856, C_U = 1920, C_GA = 2432;
constexpr float NORM_EPS = 1e-6f;
constexpr float SC2 = 0.125f * 1.4426950408889634f;
constexpr float LOG2E = 1.4426950408889634f;

constexpr size_t OFF_WIN = 0;
constexpr size_t OFF_WUP = OFF_WIN + (size_t)NIN * DM * 2;
constexpr size_t OFF_WDN = OFF_WUP + (size_t)DFF * DM * 2;
constexpr size_t OFF_WOUT = OFF_WDN + (size_t)DFF * DM * 2;
constexpr size_t OFF_WBR = OFF_WOUT + (size_t)DM * DM * 2;
constexpr size_t OFF_WGLU = OFF_WBR + (size_t)3 * DM * 512 * 2;
constexpr size_t OFF_WC1 = OFF_WGLU + (size_t)512 * 512 * 2;
constexpr size_t OFF_WC2 = OFF_WC1 + (size_t)2 * 128 * 2048 * 2;
constexpr size_t OFF_CB = OFF_WC2 + (size_t)2 * 64 * 128 * 2;
constexpr size_t OFF_S5S = OFF_CB + 4096;
constexpr size_t OFF_KC = OFF_S5S + (size_t)8 * 32 * 8 * 64 * 8;
constexpr size_t OFF_VCT = OFF_KC + (size_t)8 * 2 * 256 * 64 * 2;
constexpr size_t OFF_ROPE = OFF_VCT + (size_t)8 * 2 * 256 * 64 * 2;
constexpr size_t OFF_HY = OFF_ROPE + (size_t)T * 32 * 8;
constexpr size_t YSZ = (size_t)T * 512 * 2;
constexpr size_t OFF_PROJ = OFF_HY + 3 * YSZ;
constexpr size_t OFF_G = OFF_PROJ + (size_t)T * PP * 2;
constexpr size_t WS_END = OFF_G + (size_t)T * NGM * 2;
constexpr size_t OFF_BAR = WS_END;
constexpr size_t BAR_BYTES = 3456 * 4;
static_assert(WS_END + BAR_BYTES <= (size_t)512 * 1024 * 1024, "workspace too large");
static_assert((size_t)T * DFF * 2 <= WS_END - OFF_PROJ, "hidden overlay");
constexpr int LDS_WAVE = 18688;
constexpr int LDS_XB = 8 * LDS_WAVE;
constexpr int LDS_BYTES = 8 * LDS_WAVE + 16;

template <class Tp> DI Tp* as_global(Tp* p) { return p; }
DI float bf2f(bf16_t v) { return __uint_as_float((unsigned)v << 16); }
DI unsigned pk2(float lo, float hi) { f32x2_t v = {lo, hi}; bf16x2_t b = __builtin_convertvector(v, bf16x2_t); return __builtin_bit_cast(unsigned, b); }
DI float sigmoidf_(float x) { return __builtin_amdgcn_rcpf(1.0f + __expf(-x)); }
DI float gelu_tanh(float x) { const float u = 0.7978845608028654f * (x + 0.044715f * x * x * x); const float e = __expf(2.0f * u); const float th = 1.0f - 2.0f * __builtin_amdgcn_rcpf(e + 1.0f); return 0.5f * x * (1.0f + th); }
DI int perm16(int x) { return (x & ~12) | ((x & 4) << 1) | ((x & 8) >> 1); }
DI int crow(int reg, int h) { return (reg & 3) + 8 * (reg >> 2) + 4 * h; }
DI float shx(float v, int m, int lane) { return __int_as_float(__builtin_amdgcn_ds_bpermute((lane ^ m) << 2, __float_as_int(v))); }
typedef unsigned u32x2s __attribute__((ext_vector_type(2)));
DI float xmax32(float v) { const u32x2s r = __builtin_amdgcn_permlane32_swap(__float_as_uint(v), __float_as_uint(v), false, false); return fmaxf(__uint_as_float(r[0]), __uint_as_float(r[1])); }
DI float xsum32(float v) { const u32x2s r = __builtin_amdgcn_permlane32_swap(__float_as_uint(v), __float_as_uint(v), false, false); return __uint_as_float(r[0]) + __uint_as_float(r[1]); }
DI float wave_sum(float v, int lane) {
#pragma unroll
    for (int o = 32; o >= 1; o >>= 1) v += shx(v, o, lane);
    return v;
}
#define MFMA32(a, b, c) __builtin_amdgcn_mfma_f32_32x32x16_bf16((a), (b), (c), 0, 0, 0)
#define MFMA16(a, b, c) __builtin_amdgcn_mfma_f32_16x16x32_bf16((a), (b), (c), 0, 0, 0)

namespace pg8 {
constexpr int BM = 256, BK = 64, HALF = 128, HTB = HALF * BK * 2, STAGE_BYTES = 8 * HTB, NXCD = 8, WGM = 8;
__host__ __device__ __forceinline__ int lds_byte(int r, int c) { const int st = (r >> 4) * 2 + (c >> 5), rr = r & 15, cc = c & 31, ob = rr * 64 + cc * 2; return st * 1024 + (ob ^ (((ob >> 9) & 1) << 5)); }
__host__ __device__ __forceinline__ void stage_rc(int b, int& R, int& C) { const int st = b / 1024, sb = b % 1024, swz = sb ^ (((sb >> 9) & 1) << 5); R = (st >> 1) * 16 + swz / 64; C = (st & 1) * 32 + (swz % 64) / 2; }
__host__ __device__ __forceinline__ int perm32(int rho) { const int n = rho >> 4, i = rho & 15; return 8 * (i >> 2) + 4 * n + (i & 3); }

struct Unit { int pm, pn, z; };
struct Gemm { const bf16_t* A; const bf16_t* Bt; int M, N, K, lda; size_t zA, zB; };

DI void tile_of(int wgid, int nwg, int nM, int nN, int& pm, int& pn) {
    { const int q = nwg / NXCD, r = nwg % NXCD, xcd = wgid % NXCD, off = wgid / NXCD; wgid = (xcd < r ? xcd * (q + 1) : r * (q + 1) + (xcd - r) * q) + off; }
    const int nig = WGM * nN, gid = wgid / nig, fm = gid * WGM, gsz = (nM - fm) < WGM ? (nM - fm) : WGM;
    pm = fm + ((wgid % nig) % gsz); pn = (wgid % nig) / gsz;
}
struct StaticOrder {
    int nM, nN, nwg, G, c;
    DI void init(int M, int N, int G_, int c_) { nM = M / BM; nN = N / BM; nwg = nM * nN; G = G_; c = c_; }
    DI bool next(int i, Unit& u) const { const long L = (long)i * G + c; if (L >= nwg) return false; tile_of((int)L, nwg, nM, nN, u.pm, u.pn); u.z = 0; return true; }
};
struct Z3Order {
    int nM, nN, nwg, G, c;
    DI void init(int M, int N, int G_, int c_) { nM = M / BM; nN = N / BM; nwg = nM * nN; G = G_; c = c_; }
    DI bool next(int i, Unit& u) const { const long L = (long)(i / 3) * G + c; if (L >= nwg) return false; tile_of((int)L, nwg, nM, nN, u.pm, u.pn); u.z = i % 3; return true; }
};

template <class Epi, class Sched>
DI void gemm_phase(LAS unsigned char* lds, const Gemm g, const Sched& S, const Epi& E, int tid_l) {
    asm volatile("" : "+v"(tid_l));
    const int tid = tid_l, wid = __builtin_amdgcn_readfirstlane(tid >> 6), lane = tid & 63, wr = wid >> 2, wc = wid & 3, fr = lane & 15, fq = lane >> 4;
    const int K = g.K, nt = K / BK;
    unsigned voffA[2], voffB[2];
#pragma unroll
    for (int i = 0; i < 2; ++i) { int R, C; stage_rc(tid * 16 + i * 8192, R, C); const int Rb = (R & ~31) + perm32(R & 31);
        voffA[i] = (unsigned)(R * g.lda + C) * 2u; voffB[i] = (unsigned)(Rb * K + C) * 2u; }
    const size_t kstep = (size_t)(BK * 2);
    const size_t hstepA = (size_t)HALF * g.lda * 2, hstepB = (size_t)HALF * K * 2;
    const size_t tstepA = 2 * hstepA, tstepB = 2 * hstepB;
    const unsigned ldsw = (unsigned)wid * 1024u;
    const int aoff = lds_byte(wr * 64 + fr, fq * 8), boff = lds_byte(wc * 32 + fr, fq * 8);
#define PG8_SA(b, h) (((b) * 2 + (h)) * HTB)
#define PG8_SB(b, h) ((4 + (b) * 2 + (h)) * HTB)
#define PG8_STAGE(bufoff, gbase, voff) do { _Pragma("unroll") for (int _i = 0; _i < 2; ++_i) \
        __builtin_amdgcn_global_load_lds((const unsigned*)((const char*)(gbase) + (voff)[_i]), (LAS unsigned*)(lds + (bufoff) + ldsw + _i * 8192), 16, 0, 0); } while (0)
#define PG8_LDA(dst, b, h) do { _Pragma("unroll") for (int m = 0; m < 4; ++m) _Pragma("unroll") for (int k = 0; k < 2; ++k) dst[m][k] = *(const LAS bf16x8*)(lds + PG8_SA(b, h) + aoff + m * 2048 + k * 1024); } while (0)
#define PG8_LDB(dst, b, h) do { _Pragma("unroll") for (int n = 0; n < 2; ++n) _Pragma("unroll") for (int k = 0; k < 2; ++k) dst[n][k] = *(const LAS bf16x8*)(lds + PG8_SB(b, h) + boff + n * 2048 + k * 1024); } while (0)
#define PG8_MMA(ai, bj, At, Bt) do { __builtin_amdgcn_s_setprio(1); _Pragma("unroll") for (int m = 0; m < 4; ++m) _Pragma("unroll") for (int n = 0; n < 2; ++n) _Pragma("unroll") for (int k = 0; k < 2; ++k) \
        acc[ai][bj][m][n] = __builtin_amdgcn_mfma_f32_16x16x32_bf16(Bt[n][k], At[m][k], acc[ai][bj][m][n], 0, 0, 0); __builtin_amdgcn_s_setprio(0); } while (0)
#define PG8_WAIT_V(n) asm volatile("s_waitcnt vmcnt(" #n ")" ::: "memory")
#define PG8_WAIT_L(n) asm volatile("s_waitcnt lgkmcnt(" #n ")" ::: "memory")
#define PG8_BAR __builtin_amdgcn_s_barrier()
#define PG8_SCHED __builtin_amdgcn_sched_barrier(0)
    Unit cur, nxt; int ui = 0;
    if (!S.next(0, cur)) return;
    f32x4 acc[2][2][4][2];
#pragma unroll
    for (int a = 0; a < 2; ++a)
#pragma unroll
        for (int b = 0; b < 2; ++b)
#pragma unroll
            for (int m = 0; m < 4; ++m)
#pragma unroll
                for (int n = 0; n < 2; ++n) acc[a][b][m][n] = (f32x4){0.f, 0.f, 0.f, 0.f};
    bf16x8 At[4][2], B0[2][2], B1[2][2];
    const char* cA = (const char*)g.A + (size_t)cur.z * g.zA + (size_t)cur.pm * tstepA; const char* cB = (const char*)g.Bt + (size_t)cur.z * g.zB + (size_t)cur.pn * tstepB;
    PG8_STAGE(PG8_SB(0, 0), cB, voffB); PG8_STAGE(PG8_SB(0, 1), cB + hstepB, voffB); PG8_STAGE(PG8_SA(0, 0), cA, voffA); PG8_STAGE(PG8_SA(0, 1), cA + hstepA, voffA);
    if (wr == 1) PG8_BAR;
    PG8_WAIT_V(2); PG8_BAR;
    PG8_STAGE(PG8_SB(1, 0), cB + kstep, voffB); PG8_STAGE(PG8_SA(1, 0), cA + kstep, voffA); PG8_STAGE(PG8_SB(1, 1), cB + hstepB + kstep, voffB);
    PG8_WAIT_V(6); PG8_BAR;
    for (;;) {
        const bool has_next = S.next(ui + 1, nxt);
        const char* nA = has_next ? (const char*)g.A + (size_t)nxt.z * g.zA + (size_t)nxt.pm * tstepA : cA; const char* nB = has_next ? (const char*)g.Bt + (size_t)nxt.z * g.zB + (size_t)nxt.pn * tstepB : cB;
        for (int t = 0; t < nt; t += 2) {
            const bool last = (t == nt - 2);
            const char* a1 = cA + (size_t)(t + 1) * kstep;
            const char* a2 = last ? nA : cA + (size_t)(t + 2) * kstep; const char* b2 = last ? nB : cB + (size_t)(t + 2) * kstep;
            const char* a3 = a2 + kstep; const char* b3 = b2 + kstep;
            PG8_LDB(B0, 0, 0); PG8_LDB(B1, 0, 1); PG8_SCHED; PG8_LDA(At, 0, 0); PG8_STAGE(PG8_SA(1, 1), a1 + hstepA, voffA);
            PG8_WAIT_V(8); PG8_WAIT_L(0); PG8_BAR; PG8_MMA(0, 0, At, B0); PG8_MMA(0, 1, At, B1); PG8_BAR; PG8_SCHED;
            PG8_LDA(At, 0, 1); PG8_STAGE(PG8_SB(0, 0), b2, voffB); PG8_STAGE(PG8_SB(0, 1), b2 + hstepB, voffB); PG8_STAGE(PG8_SA(0, 0), a2, voffA);
            PG8_WAIT_V(8); PG8_WAIT_L(0); PG8_BAR; PG8_MMA(1, 0, At, B0); PG8_MMA(1, 1, At, B1); PG8_BAR; PG8_SCHED;
            PG8_LDB(B0, 1, 0); PG8_LDB(B1, 1, 1); PG8_SCHED; PG8_LDA(At, 1, 0); PG8_STAGE(PG8_SA(0, 1), a2 + hstepA, voffA);
            PG8_WAIT_V(8); PG8_WAIT_L(0); PG8_BAR; PG8_MMA(0, 0, At, B0); PG8_MMA(0, 1, At, B1); PG8_BAR; PG8_SCHED;
            PG8_LDA(At, 1, 1); PG8_STAGE(PG8_SB(1, 0), b3, voffB); PG8_STAGE(PG8_SB(1, 1), b3 + hstepB, voffB); PG8_STAGE(PG8_SA(1, 0), a3, voffA);
            PG8_WAIT_V(8); PG8_WAIT_L(0); PG8_BAR; PG8_MMA(1, 0, At, B0); PG8_MMA(1, 1, At, B1); PG8_BAR; PG8_SCHED;
        }
        if (wr == 0) PG8_BAR;
        E(acc, cur, wr, wc, fr, fq);
        if (!has_next) break;
#pragma unroll
        for (int a = 0; a < 2; ++a)
#pragma unroll
            for (int b = 0; b < 2; ++b)
#pragma unroll
                for (int m = 0; m < 4; ++m)
#pragma unroll
                    for (int n = 0; n < 2; ++n) acc[a][b][m][n] = (f32x4){0.f, 0.f, 0.f, 0.f};
        cur = nxt; cA = nA; cB = nB; ++ui;
        if (wr == 1) PG8_BAR;
    }
    PG8_WAIT_V(0);
    PG8_BAR;
#undef PG8_SA
#undef PG8_SB
#undef PG8_STAGE
#undef PG8_LDA
#undef PG8_LDB
#undef PG8_MMA
#undef PG8_WAIT_V
#undef PG8_WAIT_L
#undef PG8_BAR
#undef PG8_SCHED
}

#define EPI_LOOP_BEGIN \
    const int row0 = u.pm * BM + wr * 64 + fr; \
    _Pragma("unroll") for (int ai = 0; ai < 2; ++ai) _Pragma("unroll") for (int m = 0; m < 4; ++m) { const size_t row = (size_t)(row0 + ai * HALF + m * 16); \
    _Pragma("unroll") for (int bj = 0; bj < 2; ++bj) { const int col = u.pn * BM + bj * HALF + wc * 32 + 8 * fq; f32x4 v0 = acc[ai][bj][m][0], v1 = acc[ai][bj][m][1];
#define EPI_LOOP_END } }
DI u32x4 pack8(f32x4 v0, f32x4 v1) { u32x4 w; w.x = pk2(v0[0], v0[1]); w.y = pk2(v0[2], v0[3]); w.z = pk2(v1[0], v1[1]); w.w = pk2(v1[2], v1[3]); return w; }
DI void unpack8(u32x4 w, f32x4& a, f32x4& b) {
    a[0] = __uint_as_float(w.x << 16); a[1] = __uint_as_float(w.x & 0xffff0000u); a[2] = __uint_as_float(w.y << 16); a[3] = __uint_as_float(w.y & 0xffff0000u);
    b[0] = __uint_as_float(w.z << 16); b[1] = __uint_as_float(w.z & 0xffff0000u); b[2] = __uint_as_float(w.w << 16); b[3] = __uint_as_float(w.w & 0xffff0000u);
}
struct EpiIn {
    bf16_t* proj; bf16_t* G;
    DI void operator()(const f32x4 (&acc)[2][2][4][2], const Unit& u, int wr, int wc, int fr, int fq) const {
        EPI_LOOP_BEGIN
            if (col >= C_GA) {
#pragma unroll
                for (int j = 0; j < 4; ++j) { v0[j] = sigmoidf_(v0[j]); v1[j] = sigmoidf_(v1[j]); }
            }
            bf16_t* dst = (col < PP) ? proj + row * PP + col : G + row * NGM + (col - PP);
            *(u32x4*)dst = pack8(v0, v1);
        EPI_LOOP_END
    }
};
struct EpiGlu {
    const bf16_t* z; const float* bias; bf16_t* yc;
    DI void operator()(const f32x4 (&acc)[2][2][4][2], const Unit& u, int wr, int wc, int fr, int fq) const {
        const int row0 = u.pm * BM + wr * 64 + fr; const int colb = u.pn * BM + wc * 32 + 8 * fq;
        f32x4 b0[2], b1[2];
#pragma unroll
        for (int bj = 0; bj < 2; ++bj) { b0[bj] = *(const f32x4*)(bias + colb + bj * HALF); b1[bj] = *(const f32x4*)(bias + colb + bj * HALF + 4); }
#pragma unroll
        for (int ai = 0; ai < 2; ++ai) {
            u32x4 zq[4][2];
#pragma unroll
            for (int m = 0; m < 4; ++m)
#pragma unroll
                for (int bj = 0; bj < 2; ++bj) zq[m][bj] = *(const u32x4*)(z + (size_t)(row0 + ai * HALF + m * 16) * PP + colb + bj * HALF);
#pragma unroll
            for (int m = 0; m < 4; ++m)
#pragma unroll
                for (int bj = 0; bj < 2; ++bj) {
                    f32x4 z0, z1; unpack8(zq[m][bj], z0, z1); f32x4 v0 = acc[ai][bj][m][0], v1 = acc[ai][bj][m][1];
#pragma unroll
                    for (int j = 0; j < 4; ++j) { v0[j] = z0[j] * sigmoidf_(v0[j] + b0[bj][j]); v1[j] = z1[j] * sigmoidf_(v1[j] + b1[bj][j]); }
                    *(u32x4*)(yc + (size_t)(row0 + ai * HALF + m * 16) * 512 + colb + bj * HALF) = pack8(v0, v1);
                }
        }
    }
};
struct EpiMerge {
    const bf16_t* G; bf16_t* mg;
    DI void operator()(const f32x4 (&acc)[2][2][4][2], const Unit& u, int wr, int wc, int fr, int fq) const {
        const int row0 = u.pm * BM + wr * 64 + fr; const int colb = u.pn * BM + wc * 32 + 8 * fq;
#pragma unroll
        for (int ai = 0; ai < 2; ++ai) {
            u32x4 gq[4][2], pq[4][2];
#pragma unroll
            for (int m = 0; m < 4; ++m)
#pragma unroll
                for (int bj = 0; bj < 2; ++bj) {
                    const size_t row = (size_t)(row0 + ai * HALF + m * 16); const int col = colb + bj * HALF;
                    gq[m][bj] = *(const u32x4*)(G + row * NGM + u.z * DM + col);
                    pq[m][bj] = (u.z > 0) ? *(const u32x4*)(mg + row * DM + col) : (u32x4){0u, 0u, 0u, 0u};
                }
#pragma unroll
            for (int m = 0; m < 4; ++m)
#pragma unroll
                for (int bj = 0; bj < 2; ++bj) {
                    const size_t row = (size_t)(row0 + ai * HALF + m * 16); const int col = colb + bj * HALF;
                    f32x4 g0, g1, p0, p1; unpack8(gq[m][bj], g0, g1); unpack8(pq[m][bj], p0, p1);
                    const f32x4 v0 = acc[ai][bj][m][0] * g0 + p0, v1 = acc[ai][bj][m][1] * g1 + p1;
                    *(u32x4*)(mg + row * DM + col) = pack8(v0, v1);
                }
        }
    }
};
struct EpiResid {
    float* x;
    DI void operator()(const f32x4 (&acc)[2][2][4][2], const Unit& u, int wr, int wc, int fr, int fq) const {
        const int row0 = u.pm * BM + wr * 64 + fr; const int colb = u.pn * BM + wc * 32 + 8 * fq;
#pragma unroll
        for (int ai = 0; ai < 2; ++ai) {
            f32x4 xa[4][2], xb[4][2];
#pragma unroll
            for (int m = 0; m < 4; ++m)
#pragma unroll
                for (int bj = 0; bj < 2; ++bj) {
                    const float* p = x + (size_t)(row0 + ai * HALF + m * 16) * DM + colb + bj * HALF;
                    xa[m][bj] = *(const f32x4*)p; xb[m][bj] = *(const f32x4*)(p + 4);
                }
#pragma unroll
            for (int m = 0; m < 4; ++m)
#pragma unroll
                for (int bj = 0; bj < 2; ++bj) {
                    float* p = x + (size_t)(row0 + ai * HALF + m * 16) * DM + colb + bj * HALF;
                    *(f32x4*)p = xa[m][bj] + acc[ai][bj][m][0]; *(f32x4*)(p + 4) = xb[m][bj] + acc[ai][bj][m][1];
                }
        }
    }
};
struct EpiUp {
    bf16_t* hid;
    DI void operator()(const f32x4 (&acc)[2][2][4][2], const Unit& u, int wr, int wc, int fr, int fq) const {
        EPI_LOOP_BEGIN
#pragma unroll
            for (int j = 0; j < 4; ++j) { const float a = fmaxf(v0[j], 0.f), b = fmaxf(v1[j], 0.f); v0[j] = a * a; v1[j] = b * b; }
            *(u32x4*)(hid + row * DFF + col) = pack8(v0, v1);
        EPI_LOOP_END
    }
};
}

enum { MODE_WIN = 0, MODE_CMP = 1, MODE_SEL = 2 };
template <int MODE>
DI void fa_tile(f32x16 (&o)[2][2], float (&m)[2], float (&ls)[2], const bf16x8 (&qf)[2][4],
                bf16x8 (&kf)[4], const bf16_t* knext, const bf16_t* VTb, int vpitch, int vks, int kbase, int r, int h,
                const int (&qpos)[2], int W, bool rs0, bool rs1, int qlo, int qhi) {
    bool fullw;
    if (MODE == MODE_WIN) fullw = (kbase + 31 <= qlo) && (kbase > qhi - W);
    else if (MODE == MODE_CMP) fullw = (16 * (kbase + 31) + 31 <= qlo);
    else fullw = (kbase + 31 <= qlo) && (__builtin_amdgcn_ballot_w64(rs0 && rs1) == ~0ull);
    bf16x8 vf[2][2];
#pragma unroll
    for (int dt = 0; dt < 2; ++dt)
#pragma unroll
        for (int s = 0; s < 2; ++s) {
            vf[dt][s] = *(const bf16x8*)(VTb + (size_t)(32 * dt + r) * vpitch + (size_t)(kbase + 16 * s) * vks + 8 * h);
        }
#pragma unroll
    for (int rt = 0; rt < 2; ++rt) {
        f32x16 st;
#pragma unroll
        for (int i = 0; i < 16; ++i) st[i] = 0.f;
#pragma unroll
        for (int ks = 0; ks < 4; ++ks) st = MFMA32(kf[ks], qf[rt][ks], st);
        if (rt == 1) {
#pragma unroll
            for (int ks = 0; ks < 4; ++ks) kf[ks] = *(const bf16x8*)(knext + 16 * ks);
        }
        const int qp = qpos[rt]; const bool rs = rt == 0 ? rs0 : rs1;
        if (!fullw) {
#pragma unroll
            for (int i = 0; i < 16; ++i) {
                const int kpos = kbase + crow(i, h);
                bool valid;
                if (MODE == MODE_WIN) valid = (kpos <= qp) && (kpos > qp - W);
                else if (MODE == MODE_CMP) valid = (16 * kpos + 31 <= qp);
                else valid = rs && (kpos <= qp);
                st[i] = valid ? st[i] : -INFINITY;
            }
        }
        float mx = st[0];
#pragma unroll
        for (int i = 1; i < 16; ++i) mx = fmaxf(mx, st[i]);
        mx = xmax32(mx);
        const float cand = fmaxf(m[rt], mx * SC2);
        if (__builtin_amdgcn_ballot_w64((cand - m[rt]) > 8.0f) != 0ull) {
            const float alpha = __builtin_amdgcn_exp2f(m[rt] - cand);
            m[rt] = cand; ls[rt] *= alpha;
#pragma unroll
            for (int dt = 0; dt < 2; ++dt)
#pragma unroll
                for (int i = 0; i < 16; ++i) o[rt][dt][i] *= alpha;
        }
        const float mref = m[rt];
        float sum = 0.f;
#pragma unroll
        for (int i = 0; i < 16; ++i) { const float p = __builtin_amdgcn_exp2f(__builtin_fmaf(st[i], SC2, -mref)); st[i] = p; sum += p; }
        ls[rt] += sum;
        bf16x8 pf[2];
#pragma unroll
        for (int s = 0; s < 2; ++s) {
            u32x4 w; w.x = pk2(st[8 * s + 0], st[8 * s + 1]); w.y = pk2(st[8 * s + 2], st[8 * s + 3]); w.z = pk2(st[8 * s + 4], st[8 * s + 5]); w.w = pk2(st[8 * s + 6], st[8 * s + 7]);
            pf[s] = __builtin_bit_cast(bf16x8, w);
        }
#pragma unroll
        for (int dt = 0; dt < 2; ++dt)
#pragma unroll
            for (int s = 0; s < 2; ++s) o[rt][dt] = MFMA32(vf[dt][s], pf[s], o[rt][dt]);
    }
}
DI void kf_load(bf16x8 (&kf)[4], const bf16_t* kp) {
#pragma unroll
    for (int ks = 0; ks < 4; ++ks) kf[ks] = *(const bf16x8*)(kp + 16 * ks);
}
DI void fa_zero(f32x16 (&o)[2][2]) {
#pragma unroll
    for (int a = 0; a < 2; ++a)
#pragma unroll
        for (int b = 0; b < 2; ++b)
#pragma unroll
            for (int i = 0; i < 16; ++i) o[a][b][i] = 0.f;
}

DI unsigned long long topk_mask(float impv, int lane, int cur) {
    const bool valid = lane <= cur; const bool forced = (lane == 0) | (lane == cur) | (lane == cur - 1);
    if (cur + 1 <= 16) return __ballot(valid);
    const unsigned key = valid ? (forced ? 0x7f000000u : (__float_as_uint(fmaxf(impv, 0.f)) + 1u)) : 0u;
    unsigned t = 0;
    for (int bit = 30; bit >= 0; --bit) {
        const unsigned cand = t | (1u << bit);
        const int cnt = __popcll(__ballot(key >= cand));
        if (cnt >= 16) t = cand;
    }
    const unsigned long long gt = __ballot(key > t), eq = __ballot(key == t);
    const int need = 16 - __popcll(gt);
    const int below = __popcll(eq & ((1ull << lane) - 1ull));
    const bool sel = (key > t) || ((key == t) && (below < need));
    return __ballot(sel);
}

DI void attnA_unit(const bf16_t* proj, const bf16_t* kc, const bf16_t* vct, const bf16_t* VT, bf16_t* ya,
                   int b, int hkv, int q0, LAS unsigned char* wl, int lane) {
    asm volatile("" : "+v"(lane));
    int r = lane & 31, h = lane >> 5;
#define RELAUNDER() do { asm volatile("" : "+v"(lane)); r = lane & 31; h = lane >> 5; } while (0)
    const size_t tokbase = (size_t)b * SEQ;
    LAS float* ytot = (LAS float*)wl;
    LAS float* impscr = (LAS float*)(wl + 16384);
    LAS unsigned* mskscr = (LAS unsigned*)(wl + 16384 + 2048);
    int qpos[2]; bf16x8 qf[2][4];
#pragma unroll
    for (int rt = 0; rt < 2; ++rt) {
        const int R = 32 * rt + r, qi = R >> 2, gi = R & 3; qpos[rt] = q0 + qi;
        const bf16_t* qp = proj + (tokbase + qpos[rt]) * PP + C_QA + (hkv * 4 + gi) * 64 + 8 * h;
#pragma unroll
        for (int ks = 0; ks < 4; ++ks) qf[rt][ks] = *(const bf16x8*)(qp + 16 * ks);
    }
    f32x16 o[2][2]; float m[2], ls[2];
    const bf16_t* Kc = kc + (size_t)(b * 2 + hkv) * 256 * 64; const bf16_t* Vc = vct + (size_t)(b * 2 + hkv) * 64 * 256;
    const int nmax = (q0 + 15 - 31) >> 4; const int ntile = nmax >= 0 ? (nmax >> 5) + 1 : 0;
    fa_zero(o); m[0] = m[1] = -1e30f; ls[0] = ls[1] = 0.f;
    {
        bf16x8 kf[4]; const bf16_t* kl = Kc + (size_t)r * 64 + 8 * h; kf_load(kf, kl);
#pragma unroll 1
        for (int t = 0; t < ntile; ++t) { const int nb = (t + 1 < ntile) ? 32 * (t + 1) : 32 * t; fa_tile<MODE_CMP>(o, m, ls, qf, kf, kl + (size_t)nb * 64, Vc, 16, 64, 32 * t, r, h, qpos, 0, false, false, q0, q0 + 15); }
    }
    float mc[2], invc[2];
#pragma unroll
    for (int rt = 0; rt < 2; ++rt) {
        const float lt = xsum32(ls[rt]); const float inv = lt > 0.f ? __builtin_amdgcn_rcpf(lt) : 0.f; mc[rt] = m[rt]; invc[rt] = inv;
        const float gsc = bf2f(proj[(tokbase + qpos[rt]) * PP + C_GA + 0 + hkv * 4 + ((32 * rt + r) & 3)]) * inv;
#pragma unroll
        for (int dt = 0; dt < 2; ++dt)
#pragma unroll
            for (int i = 0; i < 16; ++i) ytot[((rt * 2 + dt) * 16 + i) * 64 + lane] = o[rt][dt][i] * gsc;
    }
    RELAUNDER();
    fa_zero(o);
#pragma unroll 1
    for (int t = 0; t < ntile; ++t) {
        const int kbase = 32 * t;
        const bf16_t* kp = Kc + (size_t)(kbase + r) * 64 + 8 * h;
        bf16x8 kf[4];
#pragma unroll
        for (int ks = 0; ks < 4; ++ks) kf[ks] = *(const bf16x8*)(kp + 16 * ks);
        bf16x8 cf[2][2];
#pragma unroll
        for (int jt = 0; jt < 2; ++jt)
#pragma unroll
            for (int s = 0; s < 2; ++s) {
                const int jj = 32 * jt + r;
#pragma unroll
                for (int j = 0; j < 8; ++j) {
                    const int n = kbase + 16 * s + 8 * (j >> 2) + 4 * h + (j & 3);
                    const int jn = n >> 2; const bool edge = (n & 3) == 3;
                    const unsigned short w = (jj == jn) ? (edge ? 0x3F00 : 0x3F80) : ((edge && jj == jn + 1) ? 0x3F00 : 0);
                    cf[jt][s][j] = (short)w;
                }
            }
#pragma unroll
        for (int rt = 0; rt < 2; ++rt) {
            f32x16 st;
#pragma unroll
            for (int i = 0; i < 16; ++i) st[i] = 0.f;
#pragma unroll
            for (int ks = 0; ks < 4; ++ks) st = MFMA32(kf[ks], qf[rt][ks], st);
#pragma unroll
            for (int i = 0; i < 16; ++i) {
                const int kpos = kbase + crow(i, h);
                const bool valid = (16 * kpos + 31 <= qpos[rt]);
                st[i] = valid ? __builtin_amdgcn_exp2f(st[i] * SC2 - mc[rt]) * invc[rt] : 0.f;
            }
            bf16x8 pf[2];
#pragma unroll
            for (int s = 0; s < 2; ++s) {
                u32x4 w; w.x = pk2(st[8 * s + 0], st[8 * s + 1]); w.y = pk2(st[8 * s + 2], st[8 * s + 3]); w.z = pk2(st[8 * s + 4], st[8 * s + 5]); w.w = pk2(st[8 * s + 6], st[8 * s + 7]);
                pf[s] = __builtin_bit_cast(bf16x8, w);
            }
#pragma unroll
            for (int jt = 0; jt < 2; ++jt)
#pragma unroll
                for (int s = 0; s < 2; ++s) o[rt][jt] = MFMA32(cf[jt][s], pf[s], o[rt][jt]);
        }
    }
    RELAUNDER();
    const int cur = q0 >> 6;
    unsigned long long uni = 0ull; unsigned mlo[2], mhi[2];
#pragma unroll
    for (int rt = 0; rt < 2; ++rt) {
#pragma unroll
        for (int jt = 0; jt < 2; ++jt)
#pragma unroll
            for (int i = 0; i < 16; ++i) {
                float v = o[rt][jt][i]; v += shx(v, 1, lane); v += shx(v, 2, lane);
                if ((r & 3) == 0) impscr[(r >> 2) * 64 + 32 * jt + crow(i, h)] = v;
            }
        asm volatile("s_waitcnt lgkmcnt(0)" ::: "memory");
        for (int qi = 0; qi < 8; ++qi) {
            const float v = impscr[qi * 64 + lane];
            const unsigned long long mk = topk_mask(v, lane, cur);
            uni |= mk;
            if (lane == 0) { mskscr[qi * 2] = (unsigned)mk; mskscr[qi * 2 + 1] = (unsigned)(mk >> 32); }
        }
        asm volatile("s_waitcnt lgkmcnt(0)" ::: "memory");
        mlo[rt] = mskscr[(r >> 2) * 2]; mhi[rt] = mskscr[(r >> 2) * 2 + 1];
        asm volatile("s_waitcnt lgkmcnt(0)" ::: "memory");
    }
    RELAUNDER();
    {
        const bf16_t* Ks = proj + tokbase * PP + C_KVA + 256 + hkv * 64;
        const bf16_t* Vs = VT + (size_t)((0 + hkv) * 8 + b) * 64 * SEQ;
        fa_zero(o); m[0] = m[1] = -1e30f; ls[0] = ls[1] = 0.f;
        {
            const unsigned long long vm = uni & ((2ull << cur) - 1ull);
            const bf16_t* kl = Ks + (size_t)r * PP + 8 * h;
            int j = __builtin_ctzll(vm), hf = 0; bool has = true;
            bf16x8 kf[4]; kf_load(kf, kl + (size_t)(64 * j) * PP);
#pragma unroll 1
            while (has) {
                int nj = j, nhf = hf; bool hasn = false;
                if (hf == 0 && 64 * j + 32 <= q0 + 15) { nhf = 1; hasn = true; }
                else { const unsigned long long rem = (j < 63) ? (vm & (~0ull << (j + 1))) : 0ull; if (rem) { nj = __builtin_ctzll(rem); nhf = 0; hasn = true; } }
                const bool rs0 = ((j < 32 ? mlo[0] : mhi[0]) >> (j & 31)) & 1u, rs1 = ((j < 32 ? mlo[1] : mhi[1]) >> (j & 31)) & 1u;
                fa_tile<MODE_SEL>(o, m, ls, qf, kf, kl + (size_t)(64 * nj + 32 * nhf) * PP, Vs, 16, 64, 64 * j + 32 * hf, r, h, qpos, 0, rs0, rs1, q0, q0 + 15);
                j = nj; hf = nhf; has = hasn;
            }
        }
#pragma unroll
        for (int rt = 0; rt < 2; ++rt) {
            const float lt = xsum32(ls[rt]); const float inv = lt > 0.f ? __builtin_amdgcn_rcpf(lt) : 0.f;
            const float gsc = bf2f(proj[(tokbase + qpos[rt]) * PP + C_GA + 8 + hkv * 4 + ((32 * rt + r) & 3)]) * inv;
#pragma unroll
            for (int dt = 0; dt < 2; ++dt)
#pragma unroll
                for (int i = 0; i < 16; ++i) ytot[((rt * 2 + dt) * 16 + i) * 64 + lane] += o[rt][dt][i] * gsc;
        }
    }
    RELAUNDER();
    {
        const bf16_t* Kw = proj + tokbase * PP + C_KVA + 512 + hkv * 64;
        const bf16_t* Vw = VT + (size_t)((2 + hkv) * 8 + b) * 64 * SEQ;
        fa_zero(o); m[0] = m[1] = -1e30f; ls[0] = ls[1] = 0.f;
        int kb0 = (q0 - 511) & ~31; if (kb0 < 0) kb0 = 0;
        {
            const bf16_t* kl = Kw + (size_t)r * PP + 8 * h; bf16x8 kf[4]; kf_load(kf, kl + (size_t)kb0 * PP);
#pragma unroll 1
            for (int kbase = kb0; kbase <= q0 + 15; kbase += 32) { const int nb = (kbase + 32 <= q0 + 15) ? kbase + 32 : kbase; fa_tile<MODE_WIN>(o, m, ls, qf, kf, kl + (size_t)nb * PP, Vw, 16, 64, kbase, r, h, qpos, 512, false, false, q0, q0 + 15); }
        }
#pragma unroll
        for (int rt = 0; rt < 2; ++rt) {
            const float lt = xsum32(ls[rt]); const float inv = lt > 0.f ? __builtin_amdgcn_rcpf(lt) : 0.f;
            const float gsc = bf2f(proj[(tokbase + qpos[rt]) * PP + C_GA + 16 + hkv * 4 + ((32 * rt + r) & 3)]) * inv;
            const int R = 32 * rt + r, gi = R & 3;
            bf16_t* yp = ya + (tokbase + qpos[rt]) * 512 + (hkv * 4 + gi) * 64;
#pragma unroll
            for (int dt = 0; dt < 2; ++dt)
#pragma unroll
                for (int a = 0; a < 4; ++a) {
                    float v[4];
#pragma unroll
                    for (int bb = 0; bb < 4; ++bb) { const int i = 4 * a + bb; v[bb] = ytot[((rt * 2 + dt) * 16 + i) * 64 + lane] + o[rt][dt][i] * gsc; }
                    u32x2 w; w.x = pk2(v[0], v[1]); w.y = pk2(v[2], v[3]);
                    *(u32x2*)(yp + 32 * dt + 8 * a + 4 * h) = w;
                }
        }
    }
    asm volatile("s_waitcnt lgkmcnt(0)" ::: "memory");
}

DI void attnB_unit(const bf16_t* proj, const bf16_t* VT, const float* sinks, bf16_t* yb, int b, int q0, int lane) {
    asm volatile("" : "+v"(lane));
    const int r = lane & 31, h = lane >> 5;
    const size_t tokbase = (size_t)b * SEQ;
    int qpos[2]; bf16x8 qf[2][4]; f32x16 o[2][2]; float m[2], ls[2];
#pragma unroll
    for (int rt = 0; rt < 2; ++rt) {
        const int R = 32 * rt + r, qi = R >> 3, gi = R & 7; qpos[rt] = q0 + qi;
        const bf16_t* qp = proj + (tokbase + qpos[rt]) * PP + C_QB + gi * 64 + 8 * h;
#pragma unroll
        for (int ks = 0; ks < 4; ++ks) qf[rt][ks] = *(const bf16x8*)(qp + 16 * ks);
        m[rt] = sinks[gi] * LOG2E; ls[rt] = (h == 0) ? 1.0f : 0.f;
    }
    fa_zero(o);
    const bf16_t* Kb = proj + tokbase * PP + C_KB;
    const bf16_t* Vb = VT + (size_t)(4 * 8 + b) * 64 * SEQ;
    int kb0 = (q0 - 127) & ~31; if (kb0 < 0) kb0 = 0;
    {
        const bf16_t* kl = Kb + (size_t)r * PP + 8 * h; bf16x8 kf[4]; kf_load(kf, kl + (size_t)kb0 * PP);
#pragma unroll 1
        for (int kbase = kb0; kbase <= q0 + 7; kbase += 32) { const int nb = (kbase + 32 <= q0 + 7) ? kbase + 32 : kbase; fa_tile<MODE_WIN>(o, m, ls, qf, kf, kl + (size_t)nb * PP, Vb, 16, 64, kbase, r, h, qpos, 128, false, false, q0, q0 + 7); }
    }
#pragma unroll
    for (int rt = 0; rt < 2; ++rt) {
        const float lt = xsum32(ls[rt]); const float inv = __builtin_amdgcn_rcpf(lt);
        const int R = 32 * rt + r, gi = R & 7;
        bf16_t* yp = yb + (tokbase + qpos[rt]) * 512 + gi * 64;
#pragma unroll
        for (int dt = 0; dt < 2; ++dt)
#pragma unroll
            for (int a = 0; a < 4; ++a) {
                u32x2 w; w.x = pk2(o[rt][dt][4 * a] * inv, o[rt][dt][4 * a + 1] * inv); w.y = pk2(o[rt][dt][4 * a + 2] * inv, o[rt][dt][4 * a + 3] * inv);
                *(u32x2*)(yp + 32 * dt + 8 * a + 4 * h) = w;
            }
    }
}

DI void compress_unit(const bf16_t* proj, const bf16_t* W1T, const bf16_t* W2T, const float* cb, const float* rope, bf16_t* kc, bf16_t* vct,
                      int j, int b, int hkv, int nch, int kpart, LAS unsigned char* ldsb, int wave, int lane) {
    asm volatile("" : "+v"(lane));
    const int fr = lane & 15, fq = lane >> 4;
    const int n0 = nch * 16; const int n = n0 + fr; const int nl = n > 254 ? 254 : n;
    const bf16_t* src = proj + ((size_t)b * SEQ + (size_t)nl * 16) * PP + C_KVA + j * 128 + hkv * 64 + fq * 8;
    const bf16_t* w1 = W1T + (size_t)j * 128 * 2048 + (size_t)fr * 2048 + fq * 8;
    f32x4 acc1[8];
#pragma unroll
    for (int ht = 0; ht < 8; ++ht) acc1[ht] = (f32x4){0.f, 0.f, 0.f, 0.f};
    const float* rp = rope + (((size_t)b * SEQ + (size_t)nl * 16) * 32 + fq * 8) * 2;
#pragma unroll 2
    for (int l = kpart * 8; l < kpart * 8 + 8; ++l) {
        bf16x8 b0 = *(const bf16x8*)(src + (size_t)l * PP), b1 = *(const bf16x8*)(src + (size_t)l * PP + 32);
        if (j == 0) {
            f32x4 x0, x1, y0, y1; pg8::unpack8(__builtin_bit_cast(u32x4, b0), x0, x1); pg8::unpack8(__builtin_bit_cast(u32x4, b1), y0, y1);
            const f32x4 cs0 = *(const f32x4*)(rp + (size_t)l * 64), cs1 = *(const f32x4*)(rp + (size_t)l * 64 + 4), cs2 = *(const f32x4*)(rp + (size_t)l * 64 + 8), cs3 = *(const f32x4*)(rp + (size_t)l * 64 + 12);
            f32x4 o0, o1, q0, q1;
            o0[0] = x0[0] * cs0[0] - y0[0] * cs0[1]; q0[0] = y0[0] * cs0[0] + x0[0] * cs0[1];
            o0[1] = x0[1] * cs0[2] - y0[1] * cs0[3]; q0[1] = y0[1] * cs0[2] + x0[1] * cs0[3];
            o0[2] = x0[2] * cs1[0] - y0[2] * cs1[1]; q0[2] = y0[2] * cs1[0] + x0[2] * cs1[1];
            o0[3] = x0[3] * cs1[2] - y0[3] * cs1[3]; q0[3] = y0[3] * cs1[2] + x0[3] * cs1[3];
            o1[0] = x1[0] * cs2[0] - y1[0] * cs2[1]; q1[0] = y1[0] * cs2[0] + x1[0] * cs2[1];
            o1[1] = x1[1] * cs2[2] - y1[1] * cs2[3]; q1[1] = y1[1] * cs2[2] + x1[1] * cs2[3];
            o1[2] = x1[2] * cs3[0] - y1[2] * cs3[1]; q1[2] = y1[2] * cs3[0] + x1[2] * cs3[1];
            o1[3] = x1[3] * cs3[2] - y1[3] * cs3[3]; q1[3] = y1[3] * cs3[2] + x1[3] * cs3[3];
            b0 = __builtin_bit_cast(bf16x8, pg8::pack8(o0, o1)); b1 = __builtin_bit_cast(bf16x8, pg8::pack8(q0, q1));
        }
#pragma unroll
        for (int ht = 0; ht < 8; ++ht) {
            const bf16x8 a0 = *(const bf16x8*)(w1 + (size_t)ht * 16 * 2048 + (2 * l) * 32);
            const bf16x8 a1 = *(const bf16x8*)(w1 + (size_t)ht * 16 * 2048 + (2 * l + 1) * 32);
            acc1[ht] = MFMA16(a0, b0, acc1[ht]);
            acc1[ht] = MFMA16(a1, b1, acc1[ht]);
        }
    }
    {
        LAS float* mine = (LAS float*)(ldsb + wave * LDS_WAVE);
#pragma unroll
        for (int ht = 0; ht < 8; ++ht)
#pragma unroll
            for (int i = 0; i < 4; ++i) mine[(ht * 4 + i) * 64 + lane] = acc1[ht][i];
    }
    __syncthreads();
    if (kpart == 0) {
#pragma unroll
    for (int p = 1; p < 4; ++p) {
        const LAS float* oth = (const LAS float*)(ldsb + (wave + p) * LDS_WAVE);
#pragma unroll
        for (int ht = 0; ht < 8; ++ht)
#pragma unroll
            for (int i = 0; i < 4; ++i) acc1[ht][i] += oth[(ht * 4 + i) * 64 + lane];
    }
    const float* cbj = cb + j * 128;
#pragma unroll
    for (int ht = 0; ht < 8; ++ht)
#pragma unroll
        for (int i = 0; i < 4; ++i) acc1[ht][i] = gelu_tanh(acc1[ht][i] + cbj[16 * ht + 4 * fq + i]);
    f32x4 acc2[4];
#pragma unroll
    for (int ot = 0; ot < 4; ++ot) acc2[ot] = (f32x4){0.f, 0.f, 0.f, 0.f};
    const bf16_t* w2 = W2T + (size_t)j * 64 * 128;
#pragma unroll
    for (int s = 0; s < 4; ++s) {
        u32x4 w; w.x = pk2(acc1[2 * s][0], acc1[2 * s][1]); w.y = pk2(acc1[2 * s][2], acc1[2 * s][3]); w.z = pk2(acc1[2 * s + 1][0], acc1[2 * s + 1][1]); w.w = pk2(acc1[2 * s + 1][2], acc1[2 * s + 1][3]);
        const bf16x8 bfr = __builtin_bit_cast(bf16x8, w);
#pragma unroll
        for (int ot = 0; ot < 4; ++ot) {
            const bf16_t* ap = w2 + (size_t)(ot * 16 + fr) * 128 + 32 * s + 4 * fq;
            const s16x4 lo = *(const s16x4*)ap, hi = *(const s16x4*)(ap + 16);
            const bf16x8 afr = (bf16x8){lo[0], lo[1], lo[2], lo[3], hi[0], hi[1], hi[2], hi[3]};
            acc2[ot] = MFMA16(afr, bfr, acc2[ot]);
        }
    }
    const bool live = n <= 254;
    if (j == 0) {
        bf16_t* dst = kc + ((size_t)(b * 2 + hkv) * 256 + n) * 64;
#pragma unroll
        for (int ot = 0; ot < 4; ++ot) { u32x2 w; w.x = live ? pk2(acc2[ot][0], acc2[ot][1]) : 0u; w.y = live ? pk2(acc2[ot][2], acc2[ot][3]) : 0u; *(u32x2*)(dst + 16 * ot + 4 * fq) = w; }
    } else {
        bf16_t* dst = vct + (size_t)(b * 2 + hkv) * 64 * 256 + (size_t)nch * 1024 + perm16(fr);
#pragma unroll
        for (int ot = 0; ot < 4; ++ot)
#pragma unroll
            for (int i = 0; i < 4; ++i) dst[(16 * ot + 4 * fq + i) * 16] = live ? (bf16_t)(pk2(acc2[ot][i], 0.f) & 0xffffu) : (bf16_t)0;
    }
    }
    __syncthreads();
}

struct S5In { const float *a_re, *a_im, *log_dt, *b_re, *b_im, *c_re, *c_im, *d; };
DI void cplx_abar(const S5In& P, int g, int p, float dt, float& abr, float& abi, float& cfr, float& cfi) {
    const float ar = P.a_re[g * 64 + p], ai = P.a_im[g * 64 + p];
    const float mag = expf(dt * ar); abr = mag * cosf(dt * ai); abi = mag * sinf(dt * ai);
    const float den = ar * ar + ai * ai, nr = abr - 1.0f, ni = abi;
    cfr = (nr * ar + ni * ai) / den; cfi = (ni * ar - nr * ai) / den;
}
template <bool OUT>
DI void s5_unit(const S5In& P, bf16_t* proj, float* states, int b, int g, int c, int nsc, LAS unsigned char* wl, int lane) {
    asm volatile("" : "+v"(lane));
    const int r = lane & 31, h = lane >> 5, fr = lane & 15, fq = lane >> 4;
    const float dt = expf(P.log_dt[g]);
    float abr, abi, t0, t1; cplx_abar(P, g, lane, dt, abr, abi, t0, t1);
    bf16x8 bfrag[4];
#pragma unroll
    for (int hs = 0; hs < 2; ++hs) {
        const int p = r + 32 * hs; float a0, a1, cr, ci; cplx_abar(P, g, p, dt, a0, a1, cr, ci);
        const float* br = P.b_re + ((size_t)g * 64 + p) * 16 + 8 * h; const float* bi = P.b_im + ((size_t)g * 64 + p) * 16 + 8 * h;
        float re[8], im[8];
#pragma unroll
        for (int j = 0; j < 8; ++j) { re[j] = cr * br[j] - ci * bi[j]; im[j] = cr * bi[j] + ci * br[j]; }
        u32x4 wr_, wi_; wr_.x = pk2(re[0], re[1]); wr_.y = pk2(re[2], re[3]); wr_.z = pk2(re[4], re[5]); wr_.w = pk2(re[6], re[7]);
        wi_.x = pk2(im[0], im[1]); wi_.y = pk2(im[2], im[3]); wi_.z = pk2(im[4], im[5]); wi_.w = pk2(im[6], im[7]);
        bfrag[hs] = __builtin_bit_cast(bf16x8, wr_); bfrag[2 + hs] = __builtin_bit_cast(bf16x8, wi_);
    }
    bf16x8 cfrag[4]; float dch = 0.f;
    if (OUT) {
#pragma unroll
        for (int ks = 0; ks < 4; ++ks) {
            const float* cr = P.c_re + ((size_t)g * 16 + fr) * 64 + 16 * ks + 4 * fq; const float* ci = P.c_im + ((size_t)g * 16 + fr) * 64 + 16 * ks + 4 * fq;
            u32x4 w; w.x = pk2(cr[0], -ci[0]); w.y = pk2(cr[1], -ci[1]); w.z = pk2(cr[2], -ci[2]); w.w = pk2(cr[3], -ci[3]);
            cfrag[ks] = __builtin_bit_cast(bf16x8, w);
        }
        dch = P.d[g * 16 + fr];
    }
    float xr = 0.f, xi = 0.f;
    if (OUT) {
        float pr = abr, pi = abi;
#pragma unroll
        for (int q = 0; q < 9; ++q) { const float nr = pr * pr - pi * pi, ni = 2.0f * pr * pi; pr = nr; pi = ni; }
#ifndef DBG_NOSTATE
        for (int cc = 0; cc < c; ++cc) {
            const float* sp = states + ((((size_t)b * 32 + g) * 8 + cc) * 64 + lane) * 2;
            const float sr = sp[0], si = sp[1];
            const float nr = pr * xr - pi * xi + sr, ni = pr * xi + pi * xr + si; xr = nr; xi = ni;
        }
#endif
    }
    LAS float* bu = (LAS float*)wl;
    bf16_t* ucol = proj + ((size_t)b * SEQ + (size_t)c * 512) * PP + C_U + g * 16;
    bf16x8 ufr_n = *(const bf16x8*)(ucol + (size_t)r * PP + 8 * h);
    LAS bf16_t* uimg = (LAS bf16_t*)(wl + 16896);
#pragma unroll 1
    for (int sc = 0; sc < nsc; ++sc) {
        bf16_t* ub = ucol + (size_t)sc * 32 * PP;
        const bf16x8 ufr = ufr_n;
        if (OUT) *(LAS bf16x8*)(uimg + r * 16 + 8 * h) = ufr;
        {
            const bf16_t* un = ucol + (size_t)(sc + 1 < nsc ? sc + 1 : sc) * 32 * PP;
            ufr_n = *(const bf16x8*)(un + (size_t)r * PP + 8 * h);
        }
        f32x16 re0, re1, im0, im1;
        {
            f32x16 z16;
#pragma unroll
            for (int i = 0; i < 16; ++i) z16[i] = 0.f;
            const f32x16 d0 = MFMA32(ufr, bfrag[0], z16), d1 = MFMA32(ufr, bfrag[1], z16), d2 = MFMA32(ufr, bfrag[2], z16), d3 = MFMA32(ufr, bfrag[3], z16);
#pragma unroll
            for (int i = 0; i < 16; ++i) {
                const u32x2s a = __builtin_amdgcn_permlane32_swap(__float_as_uint(d0[i]), __float_as_uint(d1[i]), false, false);
                const u32x2s c = __builtin_amdgcn_permlane32_swap(__float_as_uint(d2[i]), __float_as_uint(d3[i]), false, false);
                re0[i] = __uint_as_float(a[0]); re1[i] = __uint_as_float(a[1]); im0[i] = __uint_as_float(c[0]); im1[i] = __uint_as_float(c[1]);
            }
        }
#pragma unroll
        for (int a4 = 0; a4 < 4; ++a4)
#pragma unroll
            for (int st_ = 0; st_ < 2; ++st_)
#pragma unroll
                for (int b4 = 0; b4 < 4; ++b4) {
                    const int i = 4 * a4 + b4, t = 8 * a4 + 4 * st_ + b4;
                    const float br_ = st_ ? re1[i] : re0[i], bi_ = st_ ? im1[i] : im0[i];
                    const float nr = abr * xr - abi * xi + br_, ni = abr * xi + abi * xr + bi_; xr = nr; xi = ni;
                    if (OUT) ((LAS unsigned*)(bu + t * 132))[lane] = pk2(xr, xi);
                }
        if (OUT) {
            asm volatile("s_waitcnt lgkmcnt(0)" ::: "memory");
#pragma unroll
            for (int mt = 0; mt < 2; ++mt) {
                f32x4 y = (f32x4){0.f, 0.f, 0.f, 0.f};
#pragma unroll
                for (int ks = 0; ks < 4; ++ks) {
                    const bf16x8 xa = *(const LAS bf16x8*)((LAS unsigned char*)bu + (mt * 16 + fr) * 528 + ks * 64 + fq * 16);
                    y = MFMA16(xa, cfrag[ks], y);
                }
#pragma unroll
                for (int i = 0; i < 4; ++i) {
                    LAS bf16_t* e = uimg + (mt * 16 + 4 * fq + i) * 16 + fr;
                    const float yy = y[i] + dch * bf2f(*e);
                    *e = (bf16_t)(pk2(gelu_tanh(yy), 0.f) & 0xffffu);
                }
            }
            asm volatile("s_waitcnt lgkmcnt(0)" ::: "memory");
            {
                const bf16x8 zv = *(const LAS bf16x8*)(uimg + lane * 8);
                *(bf16x8*)(ub + (size_t)(lane >> 1) * PP + 8 * (lane & 1)) = zv;
            }
            asm volatile("s_waitcnt lgkmcnt(0)" ::: "memory");
        }
    }
    if (!OUT) { float* sp = states + ((((size_t)b * 32 + g) * 8 + c) * 64 + lane) * 2; sp[0] = xr; sp[1] = xi; }
}

template <bool OUT_F32>
DI void rmsnorm_rows(const float* src, const float* gain, bf16_t* dstb, float* dstf, float* copy, int gw, int nw, int lane) {
    f32x4 gv[4];
#pragma unroll
    for (int i = 0; i < 4; ++i) gv[i] = *(const f32x4*)(gain + 512 * (i >> 1) + 8 * lane + 4 * (i & 1));
#pragma unroll 2
    for (int row = gw; row < T; row += nw) {
        const float* xp = src + (size_t)row * DM + 8 * lane;
        f32x4 v[4]; float ss = 0.f;
#pragma unroll
        for (int i = 0; i < 4; ++i) { v[i] = *(const f32x4*)(xp + 512 * (i >> 1) + 4 * (i & 1)); ss += v[i][0] * v[i][0] + v[i][1] * v[i][1] + v[i][2] * v[i][2] + v[i][3] * v[i][3]; }
        ss = wave_sum(ss, lane);
        const float rs = rsqrtf(ss * (1.0f / 1024.0f) + NORM_EPS);
#pragma unroll
        for (int g2 = 0; g2 < 2; ++g2) {
            const size_t off = (size_t)row * DM + 512 * g2 + 8 * lane;
            if (copy) { *(f32x4*)(copy + off) = v[2 * g2]; *(f32x4*)(copy + off + 4) = v[2 * g2 + 1]; }
            const f32x4 y0 = v[2 * g2] * rs * gv[2 * g2], y1 = v[2 * g2 + 1] * rs * gv[2 * g2 + 1];
            if (OUT_F32) { *(f32x4*)(dstf + off) = y0; *(f32x4*)(dstf + off + 4) = y1; }
            else *(u32x4*)(dstb + off) = pg8::pack8(y0, y1);
        }
    }
}

DI int in_srccol(int n) { return n < 1280 ? n : (n < 2432 ? n + 24 : (n < 2456 ? n - 1152 : (n < 2560 ? -1 : n - 104))); }

#define XB_TMO      128
#define XB_XCNT(j)  (256  + 64 * (j))
#define XB_XSUB(j)  (1280 + 64 * (j))
#define XB_XGEN(j)  (2304 + 64 * (j))
#define XB_TOP      3328
#define XB_TOPGEN   3392
#define XB_SPIN_CAP (1u << 18)
DI unsigned xb_ld(unsigned* p)              { return __hip_atomic_load(p, __ATOMIC_RELAXED, __HIP_MEMORY_SCOPE_AGENT); }
DI unsigned xb_add(unsigned* p, unsigned v) { return __hip_atomic_fetch_add(p, v, __ATOMIC_RELAXED, __HIP_MEMORY_SCOPE_AGENT); }
DI unsigned xb_xcc_id() { return (unsigned)__builtin_amdgcn_s_getreg((3 << 11) | 20) & 0xFu; }
#define XB_SPIN(cond, bar) do { unsigned _sp = 0; while (cond) { __builtin_amdgcn_s_sleep(1); \
    if ((++_sp & 255u) == 0u) { if (xb_ld(&(bar)[XB_TMO])) break; if (_sp > XB_SPIN_CAP) { atomicAdd(&(bar)[XB_TMO], 1u); break; } } } } while (0)
DI void xcd_barrier_complete(unsigned* bar, unsigned x, unsigned G, unsigned& nloc, unsigned& nx) {
    unsigned sum, cnt, mine, sp = 0u;
    for (;;) {
        sum = 0u; cnt = 0u; mine = 0u;
#pragma unroll
        for (unsigned j = 0; j < 16; ++j) { const unsigned c = xb_ld(&bar[XB_XCNT(j)]); sum += c; cnt += (c > 0u) ? 1u : 0u; mine = (j == x) ? c : mine; }
        if (sum == G) break;
        __builtin_amdgcn_s_sleep(1);
        if ((++sp & 255u) == 0u) { if (xb_ld(&bar[XB_TMO])) break; if (sp > XB_SPIN_CAP) { atomicAdd(&bar[XB_TMO], 1u); break; } }
    }
    nloc = mine > 0u ? mine : 1u; nx = cnt > 0u ? cnt : 1u;
}
DI void xcd_barrier(unsigned* bar, volatile LAS unsigned* st, bool t0, unsigned G) {
    asm volatile("s_waitcnt vmcnt(0)" ::: "memory");
    __syncthreads();
    if (t0) {
        const unsigned x = xb_xcc_id();
        __builtin_amdgcn_s_waitcnt(0);
        unsigned nloc = st[0], nx = st[1];
        if (nloc == 0u) { xcd_barrier_complete(bar, x, G, nloc, nx); st[0] = nloc; st[1] = nx; }
        const unsigned old = xb_add(&bar[XB_XSUB(x)], 1u);
        const unsigned gen = old / nloc;
        if (old + 1u == (gen + 1u) * nloc) {
            __builtin_amdgcn_fence(__ATOMIC_RELEASE, "agent");
            asm volatile("s_waitcnt vmcnt(0)" ::: "memory");
            const unsigned og = xb_add(&bar[XB_TOP], 1u);
            const unsigned tg = og / nx;
            if (og + 1u == (tg + 1u) * nx) xb_add(&bar[XB_TOPGEN], 1u);
            else XB_SPIN(xb_ld(&bar[XB_TOPGEN]) == tg, bar);
            __builtin_amdgcn_fence(__ATOMIC_ACQUIRE, "agent");
            xb_add(&bar[XB_XGEN(x)], 1u);
            asm volatile("s_waitcnt vmcnt(0)" ::: "memory");
        } else {
            XB_SPIN(xb_ld(&bar[XB_XGEN(x)]) == gen, bar);
            __builtin_amdgcn_fence(__ATOMIC_ACQUIRE, "agent");
            asm volatile("s_waitcnt vmcnt(0)" ::: "memory");
        }
    }
    __syncthreads();
}

struct Args { const float* in[26]; float* out; unsigned char* ws; int ph_lo, ph_hi; };
constexpr int NPH = DEPTH * 11 + 1;

__global__ void __launch_bounds__(512, 2) mega_fwd(Args a) {
    extern __shared__ __attribute__((aligned(16))) unsigned char lds_raw[];
    LAS unsigned char* lds = (LAS unsigned char*)lds_raw;
    cg::grid_group grid = cg::this_grid();
    const int G = gridDim.x, bx = blockIdx.x;
    const int ph_lo = a.ph_lo, ph_hi = a.ph_hi;
    const int wave0 = __builtin_amdgcn_readfirstlane(threadIdx.x >> 6);
    {
        int ln0; asm volatile("v_mbcnt_lo_u32_b32 %0, -1, 0\n\tv_mbcnt_hi_u32_b32 %0, -1, %0" : "=v"(ln0));
        if (wave0 == 0 && ln0 == 0) {
            volatile LAS unsigned* xst = (volatile LAS unsigned*)(lds + LDS_XB); xst[0] = 0u; xst[1] = 0u;
            (void)xb_add(&((unsigned*)(a.ws + OFF_BAR))[XB_XCNT(xb_xcc_id())], 1u);
        }
        __syncthreads();
    }
#define PH_LOCALS \
    int lane_v; asm volatile("v_mbcnt_lo_u32_b32 %0, -1, 0\n\tv_mbcnt_hi_u32_b32 %0, -1, %0" : "=v"(lane_v)); int wave_s = wave0; asm volatile("" : "+s"(wave_s)); \
    const int lane = lane_v, wave = wave_s, tid = wave * 64 + lane; \
    const int gw = bx * 8 + wave, nw = G * 8; (void)gw; (void)nw; (void)lane; \
    const Args* ap = (const Args*)__builtin_amdgcn_kernarg_segment_ptr(); asm volatile("" : "+s"(ap)); \
    unsigned char* ws = as_global(ap->ws); float* X = as_global(ap->out); (void)X; \
    bf16_t* WIN = (bf16_t*)(ws + OFF_WIN); bf16_t* WUP = (bf16_t*)(ws + OFF_WUP); bf16_t* WDN = (bf16_t*)(ws + OFF_WDN); bf16_t* WOUT = (bf16_t*)(ws + OFF_WOUT); \
    bf16_t* WBR = (bf16_t*)(ws + OFF_WBR); bf16_t* WGLU = (bf16_t*)(ws + OFF_WGLU); bf16_t* WC1 = (bf16_t*)(ws + OFF_WC1); bf16_t* WC2 = (bf16_t*)(ws + OFF_WC2); \
    float* CB = (float*)(ws + OFF_CB); float* S5S = (float*)(ws + OFF_S5S); bf16_t* KC = (bf16_t*)(ws + OFF_KC); bf16_t* VCT = (bf16_t*)(ws + OFF_VCT); \
    float* ROPE = (float*)(ws + OFF_ROPE); \
    bf16_t* Hb = (bf16_t*)(ws + OFF_HY); bf16_t* YA = (bf16_t*)(ws + OFF_HY); bf16_t* YB = (bf16_t*)(ws + OFF_HY + YSZ); bf16_t* YC = (bf16_t*)(ws + OFF_HY + 2 * YSZ); \
    bf16_t* VT = YC; bf16_t* PROJ = (bf16_t*)(ws + OFF_PROJ); bf16_t* GG = (bf16_t*)(ws + OFF_G); bf16_t* MG = PROJ; bf16_t* HID = PROJ; \
    LAS unsigned char* wl = lds + wave * LDS_WAVE; \
    (void)WIN; (void)WUP; (void)WDN; (void)WOUT; (void)WBR; (void)WGLU; (void)WC1; (void)WC2; (void)CB; (void)S5S; (void)KC; (void)VCT; (void)ROPE; (void)Hb; (void)YA; (void)YB; (void)YC; (void)VT; (void)PROJ; (void)GG; (void)MG; (void)HID; (void)wl;

#define INP(k) as_global(ap->in[k])
#define PH_BEGIN(p) if (ph_lo <= (p) && (p) < ph_hi) { PH_LOCALS
#define PH_SYNC_CG do { asm volatile("s_waitcnt vmcnt(0)" ::: "memory"); __syncthreads(); if (wave0 == 0) { __builtin_amdgcn_fence(__ATOMIC_RELEASE, "agent"); asm volatile("s_waitcnt vmcnt(0)" ::: "memory"); } __syncthreads(); grid.sync(); if (wave0 == 0) { __builtin_amdgcn_fence(__ATOMIC_ACQUIRE, "agent"); asm volatile("s_waitcnt vmcnt(0)" ::: "memory"); } __syncthreads(); } while (0)
#define PH_SYNC_XCD do { int ln_; asm volatile("v_mbcnt_lo_u32_b32 %0, -1, 0\n\tv_mbcnt_hi_u32_b32 %0, -1, %0" : "=v"(ln_)); const Args* ap_ = (const Args*)__builtin_amdgcn_kernarg_segment_ptr(); asm volatile("" : "+s"(ap_)); \
    xcd_barrier((unsigned*)(ap_->ws + OFF_BAR), (volatile LAS unsigned*)(lds + LDS_XB), wave0 == 0 && ln_ == 0, (unsigned)G); } while (0)
#define PH_END(p) } if (ph_lo <= (p) && (p) + 1 < ph_hi) { PH_SYNC_XCD; }

    if (ph_hi - ph_lo > 1) grid.sync();
#pragma unroll 1
    for (int l = 0; l < DEPTH; ++l) {
        const int pb = l * 11;
        PH_BEGIN(pb + 0)
            LAS float* scr = (LAS float*)lds;
            for (int j = bx; j < 2; j += G) {
                const int hid = tid & 127, part = tid >> 7;
                const float* pos = INP(4) + (size_t)(l * 2 + j) * 2048; const float* w1 = INP(5) + (size_t)(l * 2 + j) * 2048 * 128;
                float s = 0.f;
                for (int kk = part * 512; kk < part * 512 + 512; ++kk) s += pos[kk] * w1[(size_t)kk * 128 + hid];
                scr[part * 128 + hid] = s;
                __syncthreads();
                if (tid < 128) CB[j * 128 + tid] = scr[tid] + scr[128 + tid] + scr[256 + tid] + scr[384 + tid];
                __syncthreads();
            }
#pragma unroll 1
            for (int it = gw; it < 4292; it += nw) {
                int rr = it; const float* W; bf16_t* WT; int K, N, tn; bool remap = false;
                if (rr < 1408) { W = INP(3) + (size_t)l * 1024 * 5528; WT = WIN; K = 1024; N = 5528; tn = 88; remap = true; }
                else if ((rr -= 1408) < 1024) { W = INP(23) + (size_t)l * 1024 * 4096; WT = WUP; K = 1024; N = 4096; tn = 64; }
                else if ((rr -= 1024) < 1024) { W = INP(24) + (size_t)l * 4096 * 1024; WT = WDN; K = 4096; N = 1024; tn = 16; }
                else if ((rr -= 1024) < 256) { W = INP(21) + (size_t)l * 1024 * 1024; WT = WOUT; K = 1024; N = 1024; tn = 16; }
                else if ((rr -= 256) < 384) { const int br = rr / 128; rr %= 128; W = INP(18 + br) + (size_t)l * 512 * 1024; WT = WBR + (size_t)br * 1024 * 512; K = 512; N = 1024; tn = 16; }
                else if ((rr -= 384) < 64) { W = INP(16) + (size_t)l * 512 * 512; WT = WGLU; K = 512; N = 512; tn = 8; }
                else if ((rr -= 64) < 128) { const int j = rr / 64; rr %= 64; W = INP(5) + (size_t)(l * 2 + j) * 2048 * 128; WT = WC1 + (size_t)j * 128 * 2048; K = 2048; N = 128; tn = 2; }
                else { rr -= 128; const int j = rr / 2; rr %= 2; W = INP(6) + (size_t)(l * 2 + j) * 128 * 64; WT = WC2 + (size_t)j * 64 * 128; K = 128; N = 64; tn = 1; }
                const int k0 = (rr / tn) * 64, n0 = (rr % tn) * 64;
                const int nn = n0 + lane; const int sc = remap ? in_srccol(nn) : nn;
                const float* wp = W + (size_t)k0 * N + (sc >= 0 ? sc : 0);
                bf16_t* dst = WT + (size_t)nn * K + k0;
#pragma unroll
                for (int kb = 0; kb < 8; ++kb) {
                    f32x4 v0, v1;
#pragma unroll
                    for (int q = 0; q < 4; ++q) { v0[q] = wp[(size_t)(kb * 8 + q) * N]; v1[q] = wp[(size_t)(kb * 8 + 4 + q) * N]; }
                    if (sc < 0) { v0 = (f32x4){0.f, 0.f, 0.f, 0.f}; v1 = v0; }
                    *(u32x4*)(dst + kb * 8) = pg8::pack8(v0, v1);
                }
            }
            if (l == 0 && bx == 0 && tid < 64) ((unsigned*)(ws + OFF_CB + 2048))[tid] = 0u;
            if (l == 0) {
                const int* positions = (const int*)INP(1);
                for (int idx = bx * 512 + tid; idx < T * 32; idx += 131072) {
                    const int t = idx >> 5, i = idx & 31;
                    const float invf = exp2f(-(float)i * 0.41524101186092029f);
                    const float ang = (float)positions[t] * invf;
                    ROPE[2 * idx] = cosf(ang); ROPE[2 * idx + 1] = sinf(ang);
                }
                rmsnorm_rows<false>(INP(0), INP(2), Hb, nullptr, X, gw, nw, lane);
            } else {
                rmsnorm_rows<false>(X, INP(2) + (size_t)l * DM, Hb, nullptr, nullptr, gw, nw, lane);
            }
        PH_END(pb + 0)
        PH_BEGIN(pb + 1)
            pg8::Gemm g{Hb, WIN, T, NIN, DM, DM, 0, 0}; pg8::StaticOrder S; S.init(T, NIN, G, bx);
            pg8::EpiIn E{PROJ, GG};
            pg8::gemm_phase(lds, g, S, E, tid);
        PH_END(pb + 1)
        PH_BEGIN(pb + 2)
            { const int u = bx * 2 + (wave >> 2); compress_unit(PROJ, WC1, WC2, CB, ROPE, KC, VCT, u >> 8, (u >> 5) & 7, (u >> 4) & 1, u & 15, wave & 3, lds, wave, lane); }
            {
                LAS bf16_t* tile = (LAS bf16_t*)lds;
                for (int it = bx; it < 5 * 8 * 64; it += G) {
                    const int slot = it / 512, b = (it / 64) % 8, st = it % 64;
                    const int vcol = slot < 4 ? C_KVA + (1 + (slot >> 1)) * 256 + 128 + (slot & 1) * 64 : C_VB;
                    {
                        const int tok = tid >> 3, dc = (tid & 7) * 8;
                        const bf16x8 v = *(const bf16x8*)(PROJ + ((size_t)b * SEQ + st * 64 + tok) * PP + vcol + dc);
#pragma unroll
                        for (int j = 0; j < 8; ++j) tile[(dc + j) * 72 + perm16(tok)] = (bf16_t)v[j];
                    }
                    __syncthreads();
                    {
                        const int d = tid >> 3, tc = (tid & 7) * 8;
                        const bf16x8 v = *(const LAS bf16x8*)(tile + d * 72 + tc);
                        *(bf16x8*)(VT + (size_t)(slot * 8 + b) * 64 * SEQ + (size_t)(st * 4 + (tc >> 4)) * 1024 + d * 16 + (tc & 8)) = v;
                    }
                    __syncthreads();
                }
            }
            for (int gid = bx * 512 + tid; gid < T * 4; gid += 131072) {
                const int t = gid >> 2, ch = gid & 3;
                const float* cs = ROPE + ((size_t)t * 32 + 8 * ch) * 2;
                const f32x4 cs0 = *(const f32x4*)cs, cs1 = *(const f32x4*)(cs + 4), cs2 = *(const f32x4*)(cs + 8), cs3 = *(const f32x4*)(cs + 12);
                bf16_t* prow = PROJ + (size_t)t * PP + 8 * ch;
#pragma unroll 3
                for (int head = 0; head < 21; ++head) {
                    int col;
                    if (head < 8) col = C_QA + head * 64; else if (head < 12) { const int hh = head - 8; col = C_KVA + (1 + (hh >> 1)) * 256 + (hh & 1) * 64; }
                    else if (head < 20) col = C_QB + (head - 12) * 64; else col = C_KB;
                    bf16_t* p = prow + col;
                    f32x4 a0, a1, b0, b1; pg8::unpack8(*(const u32x4*)p, a0, a1); pg8::unpack8(*(const u32x4*)(p + 32), b0, b1);
                    f32x4 o0, o1, q0, q1;
                    o0[0] = a0[0] * cs0[0] - b0[0] * cs0[1]; q0[0] = b0[0] * cs0[0] + a0[0] * cs0[1];
                    o0[1] = a0[1] * cs0[2] - b0[1] * cs0[3]; q0[1] = b0[1] * cs0[2] + a0[1] * cs0[3];
                    o0[2] = a0[2] * cs1[0] - b0[2] * cs1[1]; q0[2] = b0[2] * cs1[0] + a0[2] * cs1[1];
                    o0[3] = a0[3] * cs1[2] - b0[3] * cs1[3]; q0[3] = b0[3] * cs1[2] + a0[3] * cs1[3];
                    o1[0] = a1[0] * cs2[0] - b1[0] * cs2[1]; q1[0] = b1[0] * cs2[0] + a1[0] * cs2[1];
                    o1[1] = a1[1] * cs2[2] - b1[1] * cs2[3]; q1[1] = b1[1] * cs2[2] + a1[1] * cs2[3];
                    o1[2] = a1[2] * cs3[0] - b1[2] * cs3[1]; q1[2] = b1[2] * cs3[0] + a1[2] * cs3[1];
                    o1[3] = a1[3] * cs3[2] - b1[3] * cs3[3]; q1[3] = b1[3] * cs3[2] + a1[3] * cs3[3];
                    *(u32x4*)p = pg8::pack8(o0, o1); *(u32x4*)(p + 32) = pg8::pack8(q0, q1);
                }
            }
            {
                const S5In P{INP(8) + (size_t)l * 2048, INP(9) + (size_t)l * 2048, INP(10) + (size_t)l * 32, INP(11) + (size_t)l * 32768, INP(12) + (size_t)l * 32768,
                             INP(13) + (size_t)l * 32768, INP(14) + (size_t)l * 32768, INP(15) + (size_t)l * 512};
            }
        PH_END(pb + 2)
        PH_BEGIN(pb + 4)
            {
                const S5In P{INP(8) + (size_t)l * 2048, INP(9) + (size_t)l * 2048, INP(10) + (size_t)l * 32, INP(11) + (size_t)l * 32768, INP(12) + (size_t)l * 32768,
                             INP(13) + (size_t)l * 32768, INP(14) + (size_t)l * 32768, INP(15) + (size_t)l * 512};
                if (bx < 64 && wave < 4) s5_unit<true>(P, PROJ, S5S, bx >> 3, 4 * (bx & 7) + wave, 0, 128, wl, lane);
            }
            {
                unsigned* xbw = (unsigned*)(ws + OFF_BAR);
                const unsigned xme = xb_xcc_id(); unsigned rk = 0, nx = 0;
#pragma unroll
                for (unsigned j = 0; j < 16; ++j) { const unsigned c = xb_ld(&xbw[XB_XCNT(j)]); if (c) { rk += (j < xme) ? 1u : 0u; ++nx; } }
                rk = __builtin_amdgcn_readfirstlane(rk); nx = __builtin_amdgcn_readfirstlane(nx); if (nx == 0u) nx = 1u;
                const unsigned nbA = rk < 16u ? (16u - rk + nx - 1u) / nx : 0u, nbB = rk < 8u ? (8u - rk + nx - 1u) / nx : 0u;
                const unsigned totA = nbA * 256u, totB = nbB * 512u;
                unsigned* ctr = (unsigned*)(ws + OFF_CB + 2048) + l * 16 + rk;
                for (;;) {
                    unsigned i = 0;
                    if (lane == 0) i = atomicAdd(ctr, 1u);
                    i = __builtin_amdgcn_readfirstlane(i);
                    if (i >= totA + totB) break;
                    if (i < totA) {
                        const unsigned g8 = i >> 3, bl = g8 % nbA, q8 = g8 / nbA;
                        const int bh = (int)(rk + nx * bl), qt = (31 - (int)q8) * 8 + (int)(i & 7u);
                        attnA_unit(PROJ, KC, VCT, VT, YA, bh >> 1, bh & 1, qt * 16, wl, lane);
                    } else {
                        const unsigned u = i - totA; const int b = (int)(rk + nx * (u >> 9));
                        attnB_unit(PROJ, VT, INP(7) + (size_t)l * 8, YB, b, (int)(u & 511u) * 8, lane);
                    }
                }
            }
        PH_END(pb + 4)
        PH_BEGIN(pb + 5)
            pg8::Gemm g{PROJ + C_U, WGLU, T, 512, 512, PP, 0, 0}; pg8::StaticOrder S; S.init(T, 512, G, bx);
            pg8::EpiGlu E{PROJ + C_U, INP(17) + (size_t)l * 512, YC};
            pg8::gemm_phase(lds, g, S, E, tid);
        PH_END(pb + 5)
        PH_BEGIN(pb + 6)
            pg8::Gemm g{YA, WBR, T, DM, 512, 512, YSZ, (size_t)DM * 512 * 2}; pg8::Z3Order S; S.init(T, DM, G, bx);
            pg8::EpiMerge E{GG, MG};
            pg8::gemm_phase(lds, g, S, E, tid);
        PH_END(pb + 6)
        PH_BEGIN(pb + 7)
            pg8::Gemm g{MG, WOUT, T, DM, DM, DM, 0, 0}; pg8::StaticOrder S; S.init(T, DM, G, bx);
            pg8::EpiResid E{X};
            pg8::gemm_phase(lds, g, S, E, tid);
        PH_END(pb + 7)
        PH_BEGIN(pb + 8)
            rmsnorm_rows<false>(X, INP(22) + (size_t)l * DM, Hb, nullptr, nullptr, gw, nw, lane);
        PH_END(pb + 8)
        PH_BEGIN(pb + 9)
            pg8::Gemm g{Hb, WUP, T, DFF, DM, DM, 0, 0}; pg8::StaticOrder S; S.init(T, DFF, G, bx);
            pg8::EpiUp E{HID};
            pg8::gemm_phase(lds, g, S, E, tid);
        PH_END(pb + 9)
        PH_BEGIN(pb + 10)
            pg8::Gemm g{HID, WDN, T, DM, DFF, DFF, 0, 0}; pg8::StaticOrder S; S.init(T, DM, G, bx);
            pg8::EpiResid E{X};
            pg8::gemm_phase(lds, g, S, E, tid);
        PH_END(pb + 10)
    }
    PH_BEGIN(NPH - 1)
        rmsnorm_rows<true>(X, INP(25), nullptr, X, nullptr, gw, nw, lane);
    }
}

extern "C" void kernel_launch(void* const* d_in, const int* in_sizes, int n_in, void* d_out, int out_size, void* d_ws, size_t ws_size, hipStream_t stream) {
    static int ready = 0;
    if (ready == 0) {
        if (n_in != 26 || out_size != T * DM || ws_size < WS_END + BAR_BYTES) { fprintf(stderr, "kernel_launch: unexpected shapes (n_in %d out %d ws %zu need %zu)\n", n_in, out_size, ws_size, (size_t)WS_END); ready = -1; return; }
        if (hipFuncSetAttribute((const void*)mega_fwd, hipFuncAttributeMaxDynamicSharedMemorySize, LDS_BYTES) != hipSuccess) { fprintf(stderr, "kernel_launch: hipFuncSetAttribute failed\n"); ready = -1; return; }
        ready = 1;
    }
    if (ready < 0) return;
#ifdef DBG_MEMSET
    hipMemsetAsync(d_ws, 0xAA, WS_END, stream); hipMemsetAsync(d_out, 0xAA, (size_t)T * DM * 4, stream);
#endif
    if (hipMemsetAsync((unsigned char*)d_ws + OFF_BAR, 0, BAR_BYTES, stream) != hipSuccess) { fprintf(stderr, "kernel_launch: barrier memset failed\n"); return; }
    Args a{};
    for (int i = 0; i < 26; ++i) a.in[i] = (const float*)d_in[i];
    a.out = (float*)d_out; a.ws = (unsigned char*)d_ws;
#if MK_MULTI
    for (int p = 0; p < NPH; ++p) { a.ph_lo = p; a.ph_hi = p + 1; hipLaunchKernelGGL(mega_fwd, dim3(256), dim3(512), LDS_BYTES, stream, a); }
#else
    a.ph_lo = 0; a.ph_hi = NPH;
    void* args[] = {&a};
    hipError_t e = hipLaunchCooperativeKernel((const void*)mega_fwd, dim3(256), dim3(512), args, LDS_BYTES, stream);
    if (e != hipSuccess) fprintf(stderr, "cooperative launch failed: %s\n", hipGetErrorString(e));
#endif
}
```
